# Optimizing an MI355X kernel written in HIP

```python
import math
import jax, jax.numpy as jnp
from jax import lax
import numpy as np

D_MODEL = 2048
BATCH = 1
SEQ = 16384
DEPTH = 2

GRID_W = 64
CTX_LEN = 256
Q_BLOCK = 128
ROPE_THETA = 10000.0
RMS_EPS = 1e-6
N_MOD = 6

DIFF_HEADS = 8
DIFF_DIM = 64
GQA_HEADS = 8
GQA_KV_HEADS = 2
GQA_DIM = 128
A_QK = DIFF_HEADS * 2 * DIFF_DIM
A_V = DIFF_HEADS * 2 * DIFF_DIM
B_Q = GQA_HEADS * GQA_DIM
B_KV = GQA_KV_HEADS * GQA_DIM
ATTN_SPLITS = (A_QK, 2 * A_QK, 2 * A_QK + A_V, 2 * A_QK + A_V + B_Q, 2 * A_QK + A_V + B_Q + B_KV)
ATTN_IN = 2 * A_QK + A_V + B_Q + 2 * B_KV
ATTN_OUT = A_V + B_Q

MLSTM_HEADS = 8
MLSTM_DIM = D_MODEL // MLSTM_HEADS
MLSTM_INNER = MLSTM_HEADS * MLSTM_DIM
MLSTM_CHUNK = 128
CONV_WIDTH = 3
MLSTM_IN = 4 * MLSTM_INNER + 4 * MLSTM_HEADS

N_EXPERTS = 16
EXPERT_FF = D_MODEL
EC_CAPACITY_FACTOR = 2

kernel_name = "hybrid_diffattn_gqa_mlstm_ecmoe_dit"


def rms_norm(x, g):
    xf = x.astype(jnp.float32)
    y = xf * lax.rsqrt(jnp.mean(xf * xf, axis=-1, keepdims=True) + RMS_EPS)
    return (y * g.astype(jnp.float32)).astype(x.dtype)


def modulate(h, shift, scale):
    return h * (1 + scale) + shift


def axial_rope_tables(n_tokens, dim):
    n_rows = n_tokens // GRID_W
    rows = jnp.repeat(jnp.arange(n_rows, dtype=jnp.float32), GRID_W)
    cols = jnp.tile(jnp.arange(GRID_W, dtype=jnp.float32), n_rows)
    axis_dim = dim // 2
    inv_freq = ROPE_THETA ** (-jnp.arange(0, axis_dim, 2, dtype=jnp.float32) / axis_dim)
    ang = jnp.concatenate([rows[:, None] * inv_freq, cols[:, None] * inv_freq], axis=-1)
    return jnp.cos(ang), jnp.sin(ang)


def apply_rope(x, cos, sin):
    half = x.shape[-1] // 2
    c = cos[None, :, None, :].astype(x.dtype)
    s = sin[None, :, None, :].astype(x.dtype)
    x1, x2 = x[..., :half], x[..., half:]
    return jnp.concatenate([x1 * c - x2 * s, x2 * c + x1 * s], axis=-1)


def map_query_blocks(fn, *qs):
    b, n = qs[0].shape[:2]
    nb = n // Q_BLOCK
    blocks = tuple(jnp.moveaxis(q.reshape(b, nb, Q_BLOCK, *q.shape[2:]), 1, 0) for q in qs)
    out = lax.map(lambda blk: fn(*blk), blocks)
    out = jnp.moveaxis(out, 0, 1)
    return out.reshape(b, n, *out.shape[3:])


def diff_attention(q1, q2, k1, k2, v, lam):
    scale = DIFF_DIM ** -0.5

    def block(q1b, q2b):
        s1 = jnp.einsum('bqhd,bkhd->bhqk', q1b, k1).astype(jnp.float32) * scale
        s2 = jnp.einsum('bqhd,bkhd->bhqk', q2b, k2).astype(jnp.float32) * scale
        w = jax.nn.softmax(s1, axis=-1) - lam * jax.nn.softmax(s2, axis=-1)
        return jnp.einsum('bhqk,bkhe->bqhe', w.astype(v.dtype), v)

    return map_query_blocks(block, q1, q2)


def gqa_attention(q, k, v):
    b, n = q.shape[:2]
    scale = GQA_DIM ** -0.5
    qg = q.reshape(b, n, GQA_KV_HEADS, GQA_HEADS // GQA_KV_HEADS, GQA_DIM)

    def block(qb):
        s = jnp.einsum('bqhgd,bkhd->bhgqk', qb, k).astype(jnp.float32) * scale
        p = jax.nn.softmax(s, axis=-1)
        return jnp.einsum('bhgqk,bkhd->bqhgd', p.astype(v.dtype), v)

    return map_query_blocks(block, qg).reshape(b, n, GQA_HEADS, GQA_DIM)


def attention_mixer(h, hc, p, layer, last):
    def project(u):
        b, n = u.shape[:2]
        qa, ka, va, qb, kb, vb = jnp.split(u @ p['w_in'], ATTN_SPLITS, axis=-1)
        qa = qa.reshape(b, n, DIFF_HEADS, 2, DIFF_DIM)
        ka = ka.reshape(b, n, DIFF_HEADS, 2, DIFF_DIM)
        return {
            'q1': qa[..., 0, :], 'q2': qa[..., 1, :], 'k1': ka[..., 0, :], 'k2': ka[..., 1, :],
            'va': va.reshape(b, n, DIFF_HEADS, 2 * DIFF_DIM),
            'qb': rms_norm(qb.reshape(b, n, GQA_HEADS, GQA_DIM), p['g_q']),
            'kb': rms_norm(kb.reshape(b, n, GQA_KV_HEADS, GQA_DIM), p['g_k']),
            'vb': vb.reshape(b, n, GQA_KV_HEADS, GQA_DIM),
        }

    lat = project(h)
    cx = project(hc)
    cos_a, sin_a = axial_rope_tables(h.shape[1], DIFF_DIM)
    cos_b, sin_b = axial_rope_tables(h.shape[1], GQA_DIM)
    for name in ('q1', 'q2', 'k1', 'k2'):
        lat[name] = apply_rope(lat[name], cos_a, sin_a)
    for name in ('qb', 'kb'):
        lat[name] = apply_rope(lat[name], cos_b, sin_b)

    lam_init = 0.8 - 0.6 * math.exp(-0.3 * layer)
    lam = (jnp.exp(jnp.sum(p['lambda_q1'].astype(jnp.float32) * p['lambda_k1'].astype(jnp.float32)))
           - jnp.exp(jnp.sum(p['lambda_q2'].astype(jnp.float32) * p['lambda_k2'].astype(jnp.float32)))
           + lam_init)

    def with_ctx(name):
        return jnp.concatenate([cx[name], lat[name]], axis=1)

    def merge(o_a, o_b):
        b, n = o_a.shape[:2]
        o_a = rms_norm(o_a, p['g_subln']) * (1 - lam_init)
        o = jnp.concatenate([o_a.reshape(b, n, A_V), o_b.reshape(b, n, B_Q)], axis=-1)
        return o @ p['w_out']

    y_lat = merge(
        diff_attention(lat['q1'], lat['q2'], with_ctx('k1'), with_ctx('k2'), with_ctx('va'), lam),
        gqa_attention(lat['qb'], with_ctx('kb'), with_ctx('vb')))
    if last:
        return y_lat, None
    y_ctx = merge(
        diff_attention(cx['q1'], cx['q2'], cx['k1'], cx['k2'], cx['va'], lam),
        gqa_attention(cx['qb'], cx['kb'], cx['vb']))
    return y_lat, y_ctx


def short_conv(x, w, b):
    k, ch = w.shape
    y = lax.conv_general_dilated(x, w[:, None, :].astype(x.dtype), window_strides=(1,),
                                 padding=[(k // 2, k // 2)], dimension_numbers=('NWC', 'WIO', 'NWC'),
                                 feature_group_count=ch)
    return y + b.astype(x.dtype)


def mlstm_chunk_step(carry, xs):
    C, n, m = carry
    q, k, v, ig, lf = xs
    L = q.shape[2]
    b = jnp.cumsum(lf, axis=-1)
    scan_order = jnp.tril(jnp.ones((L, L), dtype=bool))
    log_d = jnp.where(scan_order, b[..., :, None] - b[..., None, :] + ig[..., None, :], -jnp.inf)
    log_inter = b + m[..., None]
    m_t = jnp.maximum(log_inter, jnp.max(log_d, axis=-1))
    w_intra = jnp.exp(log_d - m_t[..., None]) * jnp.einsum('bhtd,bhsd->bhts', q, k)
    w_inter = jnp.exp(log_inter - m_t)
    num = (w_inter[..., None] * jnp.einsum('bhtd,bhed->bhte', q, C)
           + jnp.einsum('bhts,bhse->bhte', w_intra, v))
    den = w_inter * jnp.einsum('bhtd,bhd->bht', q, n) + jnp.sum(w_intra, axis=-1)
    h = num / jnp.maximum(jnp.abs(den), jnp.exp(-m_t))[..., None]
    b_end = b[..., -1]
    log_w = b_end[..., None] - b + ig
    m_new = jnp.maximum(b_end + m, jnp.max(log_w, axis=-1))
    w = jnp.exp(log_w - m_new[..., None])
    decay = jnp.exp(b_end + m - m_new)
    C_new = decay[..., None, None] * C + jnp.einsum('bhs,bhse,bhsd->bhed', w, v, k)
    n_new = decay[..., None] * n + jnp.einsum('bhs,bhsd->bhd', w, k)
    return (C_new, n_new, m_new), h


def mlstm_scan(q, k, v, ig, lf, state):
    b, hh, n = q.shape[:3]
    nc = n // MLSTM_CHUNK

    def chunks(a):
        return jnp.moveaxis(a.reshape(b, hh, nc, MLSTM_CHUNK, *a.shape[3:]), 2, 0)

    state, h = lax.scan(mlstm_chunk_step, state, tuple(chunks(a) for a in (q, k, v, ig, lf)))
    h = jnp.moveaxis(h, 0, 2).reshape(b, hh, n, h.shape[-1])
    return h, state


def mlstm_mixer(h, hc, p, last):
    def project(u):
        b, n = u.shape[:2]
        qk, v, o, g = jnp.split(u @ p['w_in'], (2 * MLSTM_INNER, 3 * MLSTM_INNER, 4 * MLSTM_INNER), axis=-1)
        qk = jax.nn.silu(short_conv(qk, p['w_conv'], p['b_conv']))
        q, k = jnp.split(qk, 2, axis=-1)

        def heads(a):
            return a.reshape(b, n, MLSTM_HEADS, MLSTM_DIM).transpose(0, 2, 1, 3).astype(jnp.float32)

        g = (g + p['b_gate']).astype(jnp.float32).reshape(b, n, 2, 2, MLSTM_HEADS).transpose(2, 3, 0, 4, 1)
        gates = [(g[d, 0], jax.nn.log_sigmoid(g[d, 1])) for d in range(2)]
        return heads(q), heads(k) * (MLSTM_DIM ** -0.5), heads(v), o, gates

    q, k, v, o, gates = project(h)
    qc, kc, vc, oc, gates_c = project(hc)
    b = h.shape[0]
    zero = (jnp.zeros((b, MLSTM_HEADS, MLSTM_DIM, MLSTM_DIM), jnp.float32),
            jnp.zeros((b, MLSTM_HEADS, MLSTM_DIM), jnp.float32),
            jnp.zeros((b, MLSTM_HEADS), jnp.float32))

    def flip(a):
        return jnp.flip(a, axis=2)

    hf_c, st_f = mlstm_scan(qc, kc, vc, gates_c[0][0], gates_c[0][1], zero)
    hf, _ = mlstm_scan(q, k, v, gates[0][0], gates[0][1], st_f)
    hb_c, st_b = mlstm_scan(flip(qc), flip(kc), flip(vc), flip(gates_c[1][0]), flip(gates_c[1][1]), zero)
    hb, _ = mlstm_scan(flip(q), flip(k), flip(v), flip(gates[1][0]), flip(gates[1][1]), st_b)

    def readout(hsum, og):
        bb, n = og.shape[:2]
        hn = rms_norm(hsum.transpose(0, 2, 1, 3), p['g_head'].reshape(MLSTM_HEADS, MLSTM_DIM))
        y = jax.nn.sigmoid(og.astype(jnp.float32)) * hn.reshape(bb, n, MLSTM_INNER)
        return y.astype(og.dtype) @ p['w_out']

    y_lat = readout(hf + flip(hb), o)
    if last:
        return y_lat, None
    return y_lat, readout(hf_c + flip(hb_c), oc)


def expert_choice_ffn(u, p):
    b, n, d = u.shape
    cap = EC_CAPACITY_FACTOR * n // N_EXPERTS
    aff = jax.nn.softmax((u @ p['w_router']).astype(jnp.float32), axis=-1)
    gate, idx = lax.top_k(jnp.swapaxes(aff, 1, 2), cap)
    xe = jax.vmap(lambda ub, ib: ub[ib])(u, idx)
    hid = (jax.nn.silu(jnp.einsum('becd,edf->becf', xe, p['w_gate']))
           * jnp.einsum('becd,edf->becf', xe, p['w_up']))
    ye = jnp.einsum('becf,efd->becd', hid, p['w_down']) * gate[..., None].astype(u.dtype)
    return jax.vmap(lambda yb, ib: jnp.zeros((n, d), u.dtype).at[ib.reshape(-1)].add(yb.reshape(-1, d)))(ye, idx)


def setup_inputs(seed: int = 0) -> dict:
    key = jax.random.key(seed)
    keys = jax.random.split(key, 64)
    counter = [0]

    def nk():
        counter[0] += 1
        return keys[counter[0] - 1]

    def nrm(shape, scale=1.0):
        return jax.random.normal(nk(), shape, jnp.float32) * scale

    def gain(n):
        return 1.0 + 0.1 * nrm((n,))

    D = D_MODEL
    inp = {}
    inp['x'] = nrm((BATCH, SEQ, D))
    inp['c'] = nrm((BATCH, D))
    inp['ctx'] = nrm((BATCH, CTX_LEN, D))
    inp['c_ctx'] = nrm((D,))
    inp['w_mod_0'] = nrm((D, N_MOD * D), 0.5 * D ** -0.5)
    inp['b_mod_0'] = nrm((N_MOD * D,), 0.02)
    inp['g_pre_mix_0'] = gain(D)
    inp['g_post_mix_0'] = gain(D)
    inp['w_in_0'] = nrm((D, ATTN_IN), D ** -0.5)
    inp['lambda_q1_0'] = nrm((DIFF_DIM,), 0.1)
    inp['lambda_k1_0'] = nrm((DIFF_DIM,), 0.1)
    inp['lambda_q2_0'] = nrm((DIFF_DIM,), 0.1)
    inp['lambda_k2_0'] = nrm((DIFF_DIM,), 0.1)
    inp['g_subln_0'] = gain(2 * DIFF_DIM)
    inp['g_q_0'] = gain(GQA_DIM)
    inp['g_k_0'] = gain(GQA_DIM)
    inp['w_out_0'] = nrm((ATTN_OUT, D), ATTN_OUT ** -0.5)
    inp['g_pre_ffn_0'] = gain(D)
    inp['g_post_ffn_0'] = gain(D)
    inp['w_router_0'] = nrm((D, N_EXPERTS), D ** -0.5)
    inp['w_gate_0'] = nrm((N_EXPERTS, D, EXPERT_FF), D ** -0.5)
    inp['w_up_0'] = nrm((N_EXPERTS, D, EXPERT_FF), D ** -0.5)
    inp['w_down_0'] = nrm((N_EXPERTS, EXPERT_FF, D), EXPERT_FF ** -0.5)
    inp['w_mod_1'] = nrm((D, N_MOD * D), 0.5 * D ** -0.5)
    inp['b_mod_1'] = nrm((N_MOD * D,), 0.02)
    inp['g_pre_mix_1'] = gain(D)
    inp['g_post_mix_1'] = gain(D)
    inp['w_in_1'] = nrm((D, MLSTM_IN), D ** -0.5)
    ig_bias = nrm((2, 1, MLSTM_HEADS), 0.1)
    fg_bias = jax.random.uniform(nk(), (2, 1, MLSTM_HEADS), jnp.float32, 3.0, 6.0)
    inp['b_gate_1'] = jnp.concatenate([ig_bias, fg_bias], axis=1).reshape(-1)
    inp['w_conv_1'] = nrm((CONV_WIDTH, 2 * MLSTM_INNER), CONV_WIDTH ** -0.5)
    inp['b_conv_1'] = nrm((2 * MLSTM_INNER,), 0.01)
    inp['g_head_1'] = gain(MLSTM_INNER)
    inp['w_out_1'] = nrm((MLSTM_INNER, D), MLSTM_INNER ** -0.5)
    inp['g_pre_ffn_1'] = gain(D)
    inp['g_post_ffn_1'] = gain(D)
    inp['w_router_1'] = nrm((D, N_EXPERTS), D ** -0.5)
    inp['w_gate_1'] = nrm((N_EXPERTS, D, EXPERT_FF), D ** -0.5)
    inp['w_up_1'] = nrm((N_EXPERTS, D, EXPERT_FF), D ** -0.5)
    inp['w_down_1'] = nrm((N_EXPERTS, EXPERT_FF, D), EXPERT_FF ** -0.5)
    return inp


def reference(x, c, ctx, c_ctx,
              w_mod_0, b_mod_0, g_pre_mix_0, g_post_mix_0, w_in_0, lambda_q1_0, lambda_k1_0,
              lambda_q2_0, lambda_k2_0, g_subln_0, g_q_0, g_k_0, w_out_0, g_pre_ffn_0, g_post_ffn_0,
              w_router_0, w_gate_0, w_up_0, w_down_0,
              w_mod_1, b_mod_1, g_pre_mix_1, g_post_mix_1, w_in_1, b_gate_1, w_conv_1, b_conv_1,
              g_head_1, w_out_1, g_pre_ffn_1, g_post_ffn_1, w_router_1, w_gate_1, w_up_1, w_down_1):
    layers = [
        dict(w_mod=w_mod_0, b_mod=b_mod_0, g_pre_mix=g_pre_mix_0, g_post_mix=g_post_mix_0, w_in=w_in_0,
             lambda_q1=lambda_q1_0, lambda_k1=lambda_k1_0, lambda_q2=lambda_q2_0, lambda_k2=lambda_k2_0,
             g_subln=g_subln_0, g_q=g_q_0, g_k=g_k_0, w_out=w_out_0, g_pre_ffn=g_pre_ffn_0,
             g_post_ffn=g_post_ffn_0, w_router=w_router_0, w_gate=w_gate_0, w_up=w_up_0, w_down=w_down_0),
        dict(w_mod=w_mod_1, b_mod=b_mod_1, g_pre_mix=g_pre_mix_1, g_post_mix=g_post_mix_1, w_in=w_in_1,
             b_gate=b_gate_1, w_conv=w_conv_1, b_conv=b_conv_1, g_head=g_head_1, w_out=w_out_1,
             g_pre_ffn=g_pre_ffn_1, g_post_ffn=g_post_ffn_1, w_router=w_router_1, w_gate=w_gate_1,
             w_up=w_up_1, w_down=w_down_1),
    ]
    b, _, d = x.shape
    xc = ctx
    for layer in range(DEPTH):
        p = layers[layer]
        last = layer == DEPTH - 1
        mod_l = (jax.nn.silu(c) @ p['w_mod'] + p['b_mod']).reshape(b, N_MOD, 1, d)
        mod_c = (jax.nn.silu(c_ctx) @ p['w_mod'] + p['b_mod']).reshape(1, N_MOD, 1, d)

        hl = modulate(rms_norm(x, p['g_pre_mix']), mod_l[:, 0], mod_l[:, 1])
        hc = modulate(rms_norm(xc, p['g_pre_mix']), mod_c[:, 0], mod_c[:, 1])
        if layer % 2 == 0:
            y_lat, y_ctx = attention_mixer(hl, hc, p, layer, last)
        else:
            y_lat, y_ctx = mlstm_mixer(hl, hc, p, last)
        x = x + mod_l[:, 2] * rms_norm(y_lat, p['g_post_mix'])

        hl = modulate(rms_norm(x, p['g_pre_ffn']), mod_l[:, 3], mod_l[:, 4])
        x = x + mod_l[:, 5] * rms_norm(expert_choice_ffn(hl, p), p['g_post_ffn'])
        if not last:
            xc = xc + mod_c[:, 2] * rms_norm(y_ctx, p['g_post_mix'])
            hc = modulate(rms_norm(xc, p['g_pre_ffn']), mod_c[:, 3], mod_c[:, 4])
            xc = xc + mod_c[:, 5] * rms_norm(expert_choice_ffn(hc, p), p['g_post_ffn'])
    return x
```

```cpp
#include <hip/hip_runtime.h>
#include <cstdio>
#include <cstdint>

#define GAS __attribute__((address_space(1)))
#define LAS __attribute__((address_space(3)))
typedef unsigned short bf16_t;
typedef short bf16x8 __attribute__((ext_vector_type(8)));
typedef short s16x4 __attribute__((ext_vector_type(4)));
typedef float f32x2 __attribute__((ext_vector_type(2)));
typedef float f32x4 __attribute__((ext_vector_type(4)));
typedef float f32x16 __attribute__((ext_vector_type(16)));
typedef unsigned u32x2 __attribute__((ext_vector_type(2)));
typedef unsigned u32x4 __attribute__((ext_vector_type(4)));

constexpr int D = 2048, SEQ = 16384, CTXL = 256, T = SEQ + CTXL;
constexpr int NQKV = 4608, NQD = 3328, NOF = 3072, NPROJ = 8192, NPROJ_PAD = 8448;
constexpr int NE = 16, IDXS = 2304;
constexpr float EPS = 1e-6f;
constexpr int NTHREADS = 512, NWAVES = 8;
constexpr int NCH = 130;

constexpr size_t MiB = 1u << 20;
constexpr size_t WS_CTL = 0, CTL_BYTES = 1 * MiB;
constexpr size_t WS_MOD   = 1 * MiB;
constexpr size_t WS_AFFT  = 2 * MiB;
constexpr size_t WS_IDX   = 4 * MiB;
constexpr size_t WS_GATEV = 5 * MiB;
constexpr size_t WS_INV   = 6 * MiB;
constexpr size_t WS_GATES = 8 * MiB;
constexpr size_t WS_GB    = 11 * MiB;
constexpr size_t WS_GI    = 13 * MiB;
constexpr size_t WS_NST   = 15 * MiB;
constexpr size_t WS_WIN0  = 32 * MiB;
constexpr size_t WS_WOUT0 = 50 * MiB;
constexpr size_t WS_WIN1  = 58 * MiB;
constexpr size_t WS_WOUT1 = 91 * MiB;
constexpr size_t WS_WGU   = 100 * MiB;
constexpr size_t WS_WD    = 356 * MiB;
constexpr size_t WS_XC    = 484 * MiB;
constexpr size_t WS_XN    = 614 * MiB;
constexpr size_t WS_R     = 680 * MiB;
constexpr size_t WS_QKV   = WS_R;
constexpr size_t WS_QD    = WS_R + 148 * MiB;
constexpr size_t WS_AO    = WS_R + 256 * MiB;
constexpr size_t WS_Y     = WS_R + 322 * MiB;
constexpr size_t WS_OF    = WS_R + 454 * MiB;
constexpr size_t WS_XE    = WS_R;
constexpr size_t WS_HID   = WS_R + 144 * MiB;
constexpr size_t WS_YE    = WS_R + 288 * MiB;
constexpr size_t WS_PROJ  = WS_R;
constexpr size_t WS_QC    = WS_R + 260 * MiB;
constexpr size_t WS_KC    = WS_R + 325 * MiB;
constexpr size_t WS_CST   = WS_R + 390 * MiB;
constexpr size_t WS_HD    = WS_R + 650 * MiB;
constexpr size_t WS_RO    = WS_QC;
constexpr size_t WS_Y1    = WS_CST;
constexpr size_t WS_XC2   = WS_R + 910 * MiB;
constexpr size_t WS_END   = WS_R + 1040 * MiB;

constexpr int CW_BAR = 4096;
constexpr int CW_C0 = 8192, CW_C1A = 8256, CW_C1B = 8320, CW_DONE2 = 8384, CW_DONE5 = 8448, CW_DONE10 = 8512, CW_DONE12 = 8576;

constexpr int LDS_BYTES = 147456;
constexpr int MISC_OFF = LDS_BYTES - 256;

#define LDS_WAIT() asm volatile("s_waitcnt lgkmcnt(0)" ::: "memory")
#define VM_WAIT() asm volatile("s_waitcnt vmcnt(0)" ::: "memory")
#define SBAR() __builtin_amdgcn_sched_barrier(0)
__device__ __forceinline__ unsigned cvtpk(float lo, float hi) { unsigned r; asm volatile("v_cvt_pk_bf16_f32 %0, %1, %2" : "=v"(r) : "v"(lo), "v"(hi)); return r; }
typedef __bf16 bf16x2_t __attribute__((ext_vector_type(2)));
__device__ __forceinline__ unsigned cvtpk_s(float lo, float hi) { f32x2 v = {lo, hi}; bf16x2_t b = __builtin_convertvector(v, bf16x2_t); return __builtin_bit_cast(unsigned, b); }
__device__ __forceinline__ float bf2f(unsigned short b) { return __uint_as_float(((unsigned)b) << 16); }
__device__ __forceinline__ float bflo(unsigned w) { return __uint_as_float(w << 16); }
__device__ __forceinline__ float bfhi(unsigned w) { return __uint_as_float(w & 0xffff0000u); }
__device__ __forceinline__ int wave_id() { return __builtin_amdgcn_readfirstlane((int)threadIdx.x >> 6); }
__device__ __forceinline__ int lane_fresh() { unsigned m = ~0u; asm volatile("" : "+s"(m)); return (int)__builtin_amdgcn_mbcnt_hi(m, __builtin_amdgcn_mbcnt_lo(m, 0u)); }
__device__ __forceinline__ int tid_fresh(int wave) { return wave * 64 + lane_fresh(); }
__device__ __forceinline__ float wave_sum_bp(float v) {
#pragma unroll
    for (int o = 1; o < 64; o <<= 1) v += __shfl_xor(v, o);
    return v;
}
template <int CTRL> __device__ __forceinline__ float dpp_f(float v) { return __builtin_bit_cast(float, __builtin_amdgcn_update_dpp(0, __builtin_bit_cast(int, v), CTRL, 0xF, 0xF, false)); }
__device__ __forceinline__ float wave_sum(float v) {
    v += dpp_f<0xB1>(v);
    v += dpp_f<0x4E>(v);
    v += dpp_f<0x124>(v);
    v += dpp_f<0x128>(v);
    { auto r = __builtin_amdgcn_permlane16_swap(__float_as_uint(v), __float_as_uint(v), false, false); v = __uint_as_float(r[0]) + __uint_as_float(r[1]); }
    { auto r = __builtin_amdgcn_permlane32_swap(__float_as_uint(v), __float_as_uint(v), false, false); v = __uint_as_float(r[0]) + __uint_as_float(r[1]); }
    return v;
}
template <int CTRL> __device__ __forceinline__ int dpp_i(int v) { return __builtin_amdgcn_update_dpp(0, v, CTRL, 0xF, 0xF, false); }
__device__ __forceinline__ int wave_sum_i(int v) {
    v += dpp_i<0xB1>(v); v += dpp_i<0x4E>(v); v += dpp_i<0x124>(v); v += dpp_i<0x128>(v);
    { auto r = __builtin_amdgcn_permlane16_swap((unsigned)v, (unsigned)v, false, false); v = (int)(r[0] + r[1]); }
    { auto r = __builtin_amdgcn_permlane32_swap((unsigned)v, (unsigned)v, false, false); v = (int)(r[0] + r[1]); }
    return v;
}
__device__ __forceinline__ float sigmoidf_(float x) { return __builtin_amdgcn_rcpf(1.f + __expf(-x)); }
__device__ __forceinline__ int crow(int r, int hi) { return (r & 3) + 8 * (r >> 2) + 4 * hi; }

#define XB_TMO      128
#define XB_XCNT(j)  (256  + 64 * (j))
#define XB_XSUB(j)  (1280 + 64 * (j))
#define XB_XGEN(j)  (2304 + 64 * (j))
#define XB_TOP      3328
#define XB_TOPGEN   3392
#define XCD_BAR_WORDS 3456
#define XB_SPIN_CAP (1u << 18)
__device__ __forceinline__ unsigned xb_ld(unsigned* p)              { return __hip_atomic_load(p, __ATOMIC_RELAXED, __HIP_MEMORY_SCOPE_AGENT); }
__device__ __forceinline__ unsigned xb_add(unsigned* p, unsigned v) { return __hip_atomic_fetch_add(p, v, __ATOMIC_RELAXED, __HIP_MEMORY_SCOPE_AGENT); }
__device__ __forceinline__ unsigned xb_xcc_id() { return (unsigned)__builtin_amdgcn_s_getreg((3 << 11) | 20) & 0xFu; }
#define XB_SPIN(cond, bar) do { unsigned _sp = 0; while (cond) { __builtin_amdgcn_s_sleep(1); \
    if ((++_sp & 255u) == 0u) { if (xb_ld(&(bar)[XB_TMO])) break; if (_sp > XB_SPIN_CAP) { atomicAdd(&(bar)[XB_TMO], 1u); break; } } } } while (0)
struct XcdBarrier { unsigned* bar; unsigned x; volatile LAS unsigned* st; int wave; };
__device__ __forceinline__ XcdBarrier xcd_barrier_post(unsigned* bar, volatile LAS unsigned* st, int wave) {
    XcdBarrier b; b.bar = bar; b.x = xb_xcc_id(); b.st = st; b.wave = wave;
    if (tid_fresh(wave) == 0) (void)xb_add(&bar[XB_XCNT(b.x)], 1u);
    return b;
}
__device__ __forceinline__ void xcd_barrier_complete(unsigned* bar, unsigned x, unsigned& nloc, unsigned& nx) {
    const unsigned G = gridDim.x * gridDim.y * gridDim.z;
    unsigned sum, cnt, mine, sp = 0u;
    for (;;) {
        sum = 0u; cnt = 0u; mine = 0u;
#pragma unroll
        for (unsigned j = 0; j < 16; ++j) { const unsigned c = xb_ld(&bar[XB_XCNT(j)]); sum += c; cnt += (c > 0u) ? 1u : 0u; mine = (j == x) ? c : mine; }
        if (sum == G) break;
        __builtin_amdgcn_s_sleep(1);
        if ((++sp & 255u) == 0u) { if (xb_ld(&bar[XB_TMO])) break; if (sp > XB_SPIN_CAP) { atomicAdd(&bar[XB_TMO], 1u); break; } }
    }
    nloc = mine > 0u ? mine : 1u; nx = cnt > 0u ? cnt : 1u;
}
__device__ __forceinline__ void xcd_barrier(const XcdBarrier& b) {
    asm volatile("s_waitcnt vmcnt(0)" ::: "memory");
    __syncthreads();
    if (tid_fresh(b.wave) == 0) {
        unsigned* bar = b.bar;
        __builtin_amdgcn_s_waitcnt(0);
        unsigned nloc = b.st[0], nx = b.st[1];
        if (nloc == 0u) { xcd_barrier_complete(bar, b.x, nloc, nx); b.st[0] = nloc; b.st[1] = nx; }
        const unsigned old = xb_add(&bar[XB_XSUB(b.x)], 1u);
        const unsigned gen = old / nloc;
        if (old + 1u == (gen + 1u) * nloc) {
            __builtin_amdgcn_fence(__ATOMIC_RELEASE, "agent");
            asm volatile("s_waitcnt vmcnt(0)" ::: "memory");
            const unsigned og = xb_add(&bar[XB_TOP], 1u);
            const unsigned tg = og / nx;
            if (og + 1u == (tg + 1u) * nx) xb_add(&bar[XB_TOPGEN], 1u);
            else XB_SPIN(xb_ld(&bar[XB_TOPGEN]) == tg, bar);
            __builtin_amdgcn_fence(__ATOMIC_ACQUIRE, "agent");
            xb_add(&bar[XB_XGEN(b.x)], 1u);
            asm volatile("s_waitcnt vmcnt(0)" ::: "memory");
        } else {
            XB_SPIN(xb_ld(&bar[XB_XGEN(b.x)]) == gen, bar);
            __builtin_amdgcn_fence(__ATOMIC_ACQUIRE, "agent");
            asm volatile("s_waitcnt vmcnt(0)" ::: "memory");
        }
    }
    __syncthreads();
}

namespace pg8 {
constexpr int BM = 256, BK = 64, HALF = 128, HTB = HALF * BK * 2, STAGE_BYTES = 8 * HTB, NXCD = 8, WGM = 8;
__host__ __device__ __forceinline__ int lds_byte(int r, int c) { const int st = (r >> 4) * 2 + (c >> 5), rr = r & 15, cc = c & 31, ob = rr * 64 + cc * 2; return st * 1024 + (ob ^ (((ob >> 9) & 1) << 5)); }
__host__ __device__ __forceinline__ void stage_rc(int b, int& R, int& C) { const int st = b / 1024, sb = b % 1024, swz = sb ^ (((sb >> 9) & 1) << 5); R = (st >> 1) * 16 + swz / 64; C = (st & 1) * 32 + (swz % 64) / 2; }
__host__ __device__ __forceinline__ int perm32(int rho) { const int n = rho >> 4, i = rho & 15; return 8 * (i >> 2) + 4 * n + (i & 3); }
struct Unit { int pm, pn, ta, tb; };
struct Gemm { const bf16_t* A; const bf16_t* Bt; int K; const int* gidx; int rpe, nvalid; };

struct StaticOrder {
    int nM, nN, nwg, G, c;
    __device__ void init(int nM_, int nN_, int G_, int c_) { nM = nM_; nN = nN_; nwg = nM * nN; G = G_; c = c_; }
    __device__ bool next(int i, Unit& u) const {
        const long L = (long)i * G + c; if (L >= nwg) return false;
        int wgid = (int)L; { const int q = nwg / NXCD, r = nwg % NXCD, xcd = wgid % NXCD, off = wgid / NXCD; wgid = (xcd < r ? xcd * (q + 1) : r * (q + 1) + (xcd - r) * q) + off; }
        const int nig = WGM * nN, gid = wgid / nig, fm = gid * WGM, gsz = (nM - fm) < WGM ? (nM - fm) : WGM;
        u.pm = fm + ((wgid % nig) % gsz); u.pn = (wgid % nig) / gsz; u.ta = u.pm; u.tb = u.pn; return true;
    }
};
struct GroupedOrder {
    int TM, TN, share, nloc, j, x;
    __device__ void init(int TM_, int TN_, int G_, int c_) { TM = TM_; TN = TN_; share = NE * TM * TN / NXCD; x = c_ % NXCD; j = c_ / NXCD; nloc = (G_ - x + NXCD - 1) / NXCD; }
    __device__ bool next(int i, Unit& u) const {
        const int v = i * nloc + j; if (v >= share) return false;
        const int L = x * share + v;
        const int per = TM * TN, e = L / per, r = L % per, tm = r % TM, pn = r / TM;
        u.pm = e * TM + tm; u.pn = pn; u.ta = u.pm; u.tb = e * TN + pn; return true;
    }
};

struct EpiF32 {
    static constexpr bool PERM = false;
    float* C; int ldc;
    __device__ __forceinline__ void operator()(const f32x4 (&acc)[2][2][4][2], const Unit& u, int wr, int wc, int fr, int fq) const {
        const int row0 = u.pm * BM + wr * 64 + fr, col0 = u.pn * BM + wc * 32 + 4 * fq;
#pragma unroll
        for (int ai = 0; ai < 2; ++ai)
#pragma unroll
            for (int m = 0; m < 4; ++m) { float* rowp = C + (size_t)(row0 + ai * HALF + m * 16) * ldc + col0;
#pragma unroll
                for (int bj = 0; bj < 2; ++bj)
#pragma unroll
                    for (int n = 0; n < 2; ++n) *(f32x4*)(rowp + bj * HALF + n * 16) = acc[ai][bj][m][n]; }
    }
};
struct EpiBf16 {
    static constexpr bool PERM = true;
    bf16_t* O; int ldc; int gate_pn; float* G;
    __device__ __forceinline__ void operator()(const f32x4 (&acc)[2][2][4][2], const Unit& u, int wr, int wc, int fr, int fq) const {
        const int row0 = u.pm * BM + wr * 64 + fr;
        if (u.pn >= gate_pn) {
            if (wc == 0) {
#pragma unroll
                for (int ai = 0; ai < 2; ++ai)
#pragma unroll
                    for (int m = 0; m < 4; ++m) { float* gp = G + (size_t)(row0 + ai * HALF + m * 16) * 32 + 8 * fq;
                        *(f32x4*)gp = acc[ai][0][m][0]; *(f32x4*)(gp + 4) = acc[ai][0][m][1]; }
            }
            return;
        }
        const int col0 = u.pn * BM + wc * 32 + 8 * fq;
#pragma unroll
        for (int ai = 0; ai < 2; ++ai)
#pragma unroll
            for (int m = 0; m < 4; ++m) { bf16_t* rowp = O + (size_t)(row0 + ai * HALF + m * 16) * ldc + col0;
#pragma unroll
                for (int bj = 0; bj < 2; ++bj) { const f32x4 v0 = acc[ai][bj][m][0], v1 = acc[ai][bj][m][1];
                    u32x4 w; w.x = cvtpk(v0[0], v0[1]); w.y = cvtpk(v0[2], v0[3]); w.z = cvtpk(v1[0], v1[1]); w.w = cvtpk(v1[2], v1[3]);
                    *(u32x4*)(rowp + bj * HALF) = w; } }
    }
};
struct EpiSwiGLU {
    static constexpr bool PERM = true;
    bf16_t* O;
    __device__ __forceinline__ void operator()(const f32x4 (&acc)[2][2][4][2], const Unit& u, int wr, int wc, int fr, int fq) const {
        const int row0 = u.pm * BM + wr * 64 + fr, col0 = u.pn * HALF + wc * 32 + 8 * fq;
#pragma unroll
        for (int ai = 0; ai < 2; ++ai)
#pragma unroll
            for (int m = 0; m < 4; ++m) { bf16_t* rowp = O + (size_t)(row0 + ai * HALF + m * 16) * D + col0;
                float h[8];
#pragma unroll
                for (int n = 0; n < 2; ++n)
#pragma unroll
                    for (int j = 0; j < 4; ++j) { const float g = acc[ai][0][m][n][j], up = acc[ai][1][m][n][j]; h[4 * n + j] = g * sigmoidf_(g) * up; }
                u32x4 w; w.x = cvtpk(h[0], h[1]); w.y = cvtpk(h[2], h[3]); w.z = cvtpk(h[4], h[5]); w.w = cvtpk(h[6], h[7]);
                *(u32x4*)rowp = w; }
    }
};
struct EpiDown {
    static constexpr bool PERM = true;
    bf16_t* O; const float* gate; int rpe;
    __device__ __forceinline__ void operator()(const f32x4 (&acc)[2][2][4][2], const Unit& u, int wr, int wc, int fr, int fq) const {
        const int row0 = u.pm * BM + wr * 64 + fr, col0 = u.pn * BM + wc * 32 + 8 * fq;
#pragma unroll
        for (int ai = 0; ai < 2; ++ai)
#pragma unroll
            for (int m = 0; m < 4; ++m) { const int row = row0 + ai * HALF + m * 16; const int e = row / rpe, slot = row - e * rpe;
                const float gs = gate[e * IDXS + slot];
                bf16_t* rowp = O + (size_t)row * D + col0;
#pragma unroll
                for (int bj = 0; bj < 2; ++bj) { const f32x4 v0 = acc[ai][bj][m][0] * gs, v1 = acc[ai][bj][m][1] * gs;
                    u32x4 w; w.x = cvtpk(v0[0], v0[1]); w.y = cvtpk(v0[2], v0[3]); w.z = cvtpk(v1[0], v1[1]); w.w = cvtpk(v1[2], v1[3]);
                    *(u32x4*)(rowp + bj * HALF) = w; } }
    }
};

template <class Epi, class Sched, bool GA = false>
__device__ __forceinline__ void gemm_phase(LAS unsigned char* lds, const Gemm g, const Sched& S, const Epi& E, const int wid) {
    const int lane = lane_fresh(), tid = wid * 64 + lane, wr = wid >> 2, wc = wid & 3, fr = lane & 15, fq = lane >> 4;
    const int K = g.K, nt = K / BK;
    unsigned voffA[2], voffB[2]; int RA[2], CA[2];
#pragma unroll
    for (int i = 0; i < 2; ++i) { int R, C; stage_rc(tid * 16 + i * 8192, R, C); const int Rb = Epi::PERM ? ((R & ~31) + perm32(R & 31)) : R; RA[i] = R; CA[i] = C;
        voffA[i] = (unsigned)(R * K + C) * 2u; voffB[i] = (unsigned)(Rb * K + C) * 2u; }
    const size_t kstep = (size_t)(BK * 2);
    const size_t hstep = (size_t)HALF * K * 2;
    const size_t tstep = 2 * hstep;
    const unsigned ldsw = (unsigned)wid * 1024u;
    const int aoff = lds_byte(wr * 64 + fr, fq * 8), boff = lds_byte(wc * 32 + fr, fq * 8);
#define PG8_SA(b, h) (((b) * 2 + (h)) * HTB)
#define PG8_SB(b, h) ((4 + (b) * 2 + (h)) * HTB)
#define PG8_STAGE(bufoff, gbase, voff) do { _Pragma("unroll") for (int _i = 0; _i < 2; ++_i) \
        __builtin_amdgcn_global_load_lds((const unsigned*)((const char*)(gbase) + (voff)[_i]), (LAS unsigned*)(lds + (bufoff) + ldsw + _i * 8192), 16, 0, 0); } while (0)
#define PG8_LDA(dst, b, h) do { _Pragma("unroll") for (int m = 0; m < 4; ++m) _Pragma("unroll") for (int k = 0; k < 2; ++k) dst[m][k] = *(const LAS bf16x8*)(lds + PG8_SA(b, h) + aoff + m * 2048 + k * 1024); } while (0)
#define PG8_LDB(dst, b, h) do { _Pragma("unroll") for (int n = 0; n < 2; ++n) _Pragma("unroll") for (int k = 0; k < 2; ++k) dst[n][k] = *(const LAS bf16x8*)(lds + PG8_SB(b, h) + boff + n * 2048 + k * 1024); } while (0)
#define PG8_MMA(ai, bj, At, Bt) do { __builtin_amdgcn_s_setprio(1); _Pragma("unroll") for (int m = 0; m < 4; ++m) _Pragma("unroll") for (int n = 0; n < 2; ++n) _Pragma("unroll") for (int k = 0; k < 2; ++k) \
        acc[ai][bj][m][n] = __builtin_amdgcn_mfma_f32_16x16x32_bf16(Bt[n][k], At[m][k], acc[ai][bj][m][n], 0, 0, 0); __builtin_amdgcn_s_setprio(0); } while (0)
#define PG8_WAIT_V(n) asm volatile("s_waitcnt vmcnt(" #n ")" ::: "memory")
#define PG8_WAIT_L(n) asm volatile("s_waitcnt lgkmcnt(" #n ")" ::: "memory")
#define PG8_BAR __builtin_amdgcn_s_barrier()
#define PG8_SCHED __builtin_amdgcn_sched_barrier(0)
#define PG8_GIDX(u_, x0, x1) do { _Pragma("unroll") for (int _i = 0; _i < 2; ++_i) { \
        const int r0_ = (u_).pm * BM + RA[_i], r1_ = r0_ + HALF; const int e0_ = r0_ / g.rpe, e1_ = r1_ / g.rpe; int s0_ = r0_ - e0_ * g.rpe, s1_ = r1_ - e1_ * g.rpe; \
        s0_ = s0_ < g.nvalid ? s0_ : g.nvalid - 1; s1_ = s1_ < g.nvalid ? s1_ : g.nvalid - 1;            \
        (x0)[_i] = g.gidx[e0_ * IDXS + s0_]; (x1)[_i] = g.gidx[e1_ * IDXS + s1_]; } } while (0)
#define PG8_GIDX_DMA(u_) do { _Pragma("unroll") for (int _i = 0; _i < 2; ++_i) { \
        const int r0_ = (u_).pm * BM + RA[_i], r1_ = r0_ + HALF; const int e0_ = r0_ / g.rpe, e1_ = r1_ / g.rpe; int s0_ = r0_ - e0_ * g.rpe, s1_ = r1_ - e1_ * g.rpe; \
        s0_ = s0_ < g.nvalid ? s0_ : g.nvalid - 1; s1_ = s1_ < g.nvalid ? s1_ : g.nvalid - 1; \
        __builtin_amdgcn_global_load_lds((const unsigned*)(g.gidx + e0_ * IDXS + s0_), (LAS unsigned*)(lds + STAGE_BYTES + ((_i) * 8 + wid) * 256), 4, 0, 0); \
        __builtin_amdgcn_global_load_lds((const unsigned*)(g.gidx + e1_ * IDXS + s1_), (LAS unsigned*)(lds + STAGE_BYTES + ((2 + _i) * 8 + wid) * 256), 4, 0, 0); } } while (0)
#define PG8_GOFF(x0, x1, o0, o1) do { _Pragma("unroll") for (int _i = 0; _i < 2; ++_i) { (o0)[_i] = (unsigned)((x0)[_i] * K + CA[_i]) * 2u; (o1)[_i] = (unsigned)((x1)[_i] * K + CA[_i]) * 2u; } } while (0)
    Unit cur, nxt; int ui = 0;
    if (!S.next(0, cur)) return;
    f32x4 acc[2][2][4][2];
#pragma unroll
    for (int a = 0; a < 2; ++a)
#pragma unroll
        for (int b = 0; b < 2; ++b)
#pragma unroll
            for (int m = 0; m < 4; ++m)
#pragma unroll
                for (int n = 0; n < 2; ++n) acc[a][b][m][n] = (f32x4){0.f, 0.f, 0.f, 0.f};
    bf16x8 At[4][2], B0[2][2], B1[2][2];
    unsigned vc0[2], vc1[2];
    unsigned vl0[2] = {0u, 0u}, vl1[2] = {0u, 0u};
    const char *cA0, *cA1, *nA0, *nA1;
    if constexpr (GA) { int ic0[2], ic1[2]; cA0 = cA1 = (const char*)g.A; PG8_GIDX(cur, ic0, ic1); PG8_GOFF(ic0, ic1, vc0, vc1); asm volatile("s_waitcnt vmcnt(0)" ::: "memory"); }
    else { cA0 = (const char*)g.A + (size_t)cur.ta * tstep; cA1 = cA0 + hstep; vc0[0] = vc1[0] = voffA[0]; vc0[1] = vc1[1] = voffA[1]; }
    const char* cB = (const char*)g.Bt + (size_t)cur.tb * tstep;
    PG8_STAGE(PG8_SB(0, 0), cB, voffB); PG8_STAGE(PG8_SB(0, 1), cB + hstep, voffB); PG8_STAGE(PG8_SA(0, 0), cA0, vc0); PG8_STAGE(PG8_SA(0, 1), cA1, vc1);
    if (wr == 1) PG8_BAR;
    PG8_WAIT_V(2); PG8_BAR;
    PG8_STAGE(PG8_SB(1, 0), cB + kstep, voffB); PG8_STAGE(PG8_SA(1, 0), cA0 + kstep, vc0); PG8_STAGE(PG8_SB(1, 1), cB + hstep + kstep, voffB);
    PG8_WAIT_V(6); PG8_BAR;
    for (;;) {
        const bool has_next = S.next(ui + 1, nxt);
        const char* nB = has_next ? (const char*)g.Bt + (size_t)nxt.tb * tstep : cB;
        if constexpr (GA) { nA0 = nA1 = (const char*)g.A; if (has_next) PG8_GIDX_DMA(nxt); }
        else { nA0 = has_next ? (const char*)g.A + (size_t)nxt.ta * tstep : cA0; nA1 = nA0 + hstep; }
        for (int t = 0; t < nt; t += 2) {
            const bool last = (t == nt - 2);
            const char* a1_1 = cA1 + (size_t)(t + 1) * kstep;
            const char* a2_0 = last ? nA0 : cA0 + (size_t)(t + 2) * kstep; const char* a2_1 = last ? nA1 : cA1 + (size_t)(t + 2) * kstep;
            const char* b2 = last ? nB : cB + (size_t)(t + 2) * kstep;
            const char* a3_0 = a2_0 + kstep; const char* b3 = b2 + kstep;
            unsigned w0[2], w1[2];
            if constexpr (GA) {
                if (last && has_next) { int j0[2], j1[2];
                    _Pragma("unroll") for (int _i = 0; _i < 2; ++_i) { j0[_i] = (int)*(const LAS unsigned*)(lds + STAGE_BYTES + ((_i) * 8 + wid) * 256 + lane * 4); j1[_i] = (int)*(const LAS unsigned*)(lds + STAGE_BYTES + ((2 + _i) * 8 + wid) * 256 + lane * 4); }
                    PG8_GOFF(j0, j1, w0, w1); vl0[0] = w0[0]; vl0[1] = w0[1]; vl1[0] = w1[0]; vl1[1] = w1[1]; }
                else { w0[0] = vc0[0]; w0[1] = vc0[1]; w1[0] = vc1[0]; w1[1] = vc1[1]; }
            } else { w0[0] = w1[0] = voffA[0]; w0[1] = w1[1] = voffA[1]; }
            PG8_LDB(B0, 0, 0); PG8_LDB(B1, 0, 1); PG8_SCHED; PG8_LDA(At, 0, 0); PG8_STAGE(PG8_SA(1, 1), a1_1, vc1);
            PG8_WAIT_V(8); PG8_WAIT_L(0); PG8_BAR; PG8_MMA(0, 0, At, B0); PG8_MMA(0, 1, At, B1); PG8_BAR; PG8_SCHED;
            PG8_LDA(At, 0, 1); PG8_STAGE(PG8_SB(0, 0), b2, voffB); PG8_STAGE(PG8_SB(0, 1), b2 + hstep, voffB); PG8_STAGE(PG8_SA(0, 0), a2_0, w0);
            PG8_WAIT_V(8); PG8_WAIT_L(0); PG8_BAR; PG8_MMA(1, 0, At, B0); PG8_MMA(1, 1, At, B1); PG8_BAR; PG8_SCHED;
            PG8_LDB(B0, 1, 0); PG8_LDB(B1, 1, 1); PG8_SCHED; PG8_LDA(At, 1, 0); PG8_STAGE(PG8_SA(0, 1), a2_1, w1);
            PG8_WAIT_V(8); PG8_WAIT_L(0); PG8_BAR; PG8_MMA(0, 0, At, B0); PG8_MMA(0, 1, At, B1); PG8_BAR; PG8_SCHED;
            PG8_LDA(At, 1, 1); PG8_STAGE(PG8_SB(1, 0), b3, voffB); PG8_STAGE(PG8_SB(1, 1), b3 + hstep, voffB); PG8_STAGE(PG8_SA(1, 0), a3_0, w0);
            PG8_WAIT_V(8); PG8_WAIT_L(0); PG8_BAR; PG8_MMA(1, 0, At, B0); PG8_MMA(1, 1, At, B1); PG8_BAR; PG8_SCHED;
        }
        if (wr == 0) PG8_BAR;
        E(acc, cur, wr, wc, fr, fq);
        if (!has_next) break;
#pragma unroll
        for (int a = 0; a < 2; ++a)
#pragma unroll
            for (int b = 0; b < 2; ++b)
#pragma unroll
                for (int m = 0; m < 4; ++m)
#pragma unroll
                    for (int n = 0; n < 2; ++n) acc[a][b][m][n] = (f32x4){0.f, 0.f, 0.f, 0.f};
        cur = nxt; cA0 = nA0; cA1 = nA1; cB = nB; ++ui;
        if constexpr (GA) { vc0[0] = vl0[0]; vc0[1] = vl0[1]; vc1[0] = vl1[0]; vc1[1] = vl1[1]; }
        if (wr == 1) PG8_BAR;
    }
    PG8_WAIT_V(0);
    PG8_BAR;
#undef PG8_GIDX
#undef PG8_GIDX_DMA
#undef PG8_GOFF
#undef PG8_SA
#undef PG8_SB
#undef PG8_STAGE
#undef PG8_LDA
#undef PG8_LDB
#undef PG8_MMA
#undef PG8_WAIT_V
#undef PG8_WAIT_L
#undef PG8_BAR
#undef PG8_SCHED
}
}

namespace att {
using bf16 = unsigned short;
constexpr int   NW = 8, QBLK = 32, KVBLK = 64;
constexpr int   D = 128;
constexpr float THR = 8.f;
constexpr int LDQ = NQD, LDKK = NQD, LDV = NQKV, LDO = NOF;
constexpr size_t SHM_V = KVBLK * D * 2, SHM_K = KVBLK * D * 2, SHM_ATTN = 2 * SHM_V + 2 * SHM_K + NW * 64 * 4;
using bf16x8 = ::bf16x8; using s16x4 = ::s16x4; using f32x16 = ::f32x16; using u32x4 = ::u32x4;
template <int DQK> __device__ __forceinline__ int kswz(int row, int colB) { return DQK == 128 ? row * 256 + (colB ^ ((row & 7) << 4)) : row * 128 + (colB ^ (((row >> 1) & 7) << 4)); }

template <bool FIRST> __device__ __forceinline__ void partialSM(f32x16& p0, f32x16& p1, float& m_reg, float& alpha) {
  constexpr float THR2 = THR * 1.4426950408889634f;
  float pmax = p0[0]; for (int r = 1; r < 16; ++r) pmax = fmaxf(pmax, p0[r]); for (int r = 0; r < 16; ++r) pmax = fmaxf(pmax, p1[r]);
  { auto rr = __builtin_amdgcn_permlane32_swap(__float_as_uint(pmax), __float_as_uint(pmax), false, false);
    pmax = fmaxf(__uint_as_float(rr[0]), __uint_as_float(rr[1])); }
  if (!FIRST && __builtin_expect(__all(pmax <= THR2), 1)) { alpha = 1.f; }
  else { const float sh = FIRST ? pmax : fmaxf(pmax, 0.f); alpha = FIRST ? 1.f : __builtin_amdgcn_exp2f(-sh); m_reg += sh;
    for (int r = 0; r < 16; ++r) p0[r] -= sh; for (int r = 0; r < 16; ++r) p1[r] -= sh; }
  for (int r = 0; r < 16; ++r) p0[r] = __builtin_amdgcn_exp2f(p0[r]);
}
__device__ __forceinline__ void finishSM(f32x16& p0, f32x16& p1, float alpha, float& l_reg, bf16x8& pa0, bf16x8& pa1, bf16x8& pa2, bf16x8& pa3) {
  for (int r = 0; r < 16; ++r) p1[r] = __builtin_amdgcn_exp2f(p1[r]);
  float ps = 0; for (int r = 0; r < 16; ++r) ps += p0[r]; for (int r = 0; r < 16; ++r) ps += p1[r];
  { auto rr = __builtin_amdgcn_permlane32_swap(__float_as_uint(ps), __float_as_uint(ps), false, false);
    ps = __uint_as_float(rr[0]) + __uint_as_float(rr[1]); }
  l_reg = l_reg * alpha + ps;
#define PK4(P, BASE, OUT) do { unsigned a0 = cvtpk_s(P[BASE + 0], P[BASE + 1]), a1 = cvtpk_s(P[BASE + 2], P[BASE + 3]);   \
    unsigned b0 = cvtpk_s(P[BASE + 4], P[BASE + 5]), b1 = cvtpk_s(P[BASE + 6], P[BASE + 7]);                              \
    auto r0 = __builtin_amdgcn_permlane32_swap(a0, b0, false, false); auto r1 = __builtin_amdgcn_permlane32_swap(a1, b1, false, false); \
    u32x4 w = {r0[0], r1[0], r0[1], r1[1]}; OUT = *reinterpret_cast<bf16x8*>(&w); } while (0)
  PK4(p0, 0, pa0); PK4(p0, 8, pa1); PK4(p1, 0, pa2); PK4(p1, 8, pa3);
#undef PK4
}
template <int DQK> __device__ __forceinline__ void qkt(f32x16& p0, f32x16& p1, const bf16* Ks, const bf16x8* qr, int r32, int hi, float negm) {
  for (int r = 0; r < 16; ++r) { p0[r] = negm; p1[r] = negm; }
  for (int d0 = 0; d0 < DQK / 16; ++d0) { int cb = (d0 * 16 + hi * 8) * 2;
    bf16x8 b0 = *reinterpret_cast<const bf16x8*>((const char*)Ks + kswz<DQK>(r32, cb));
    bf16x8 b1 = *reinterpret_cast<const bf16x8*>((const char*)Ks + kswz<DQK>(32 + r32, cb));
    p0 = __builtin_amdgcn_mfma_f32_32x32x16_bf16(b0, qr[d0], p0, 0, 0, 0);
    p1 = __builtin_amdgcn_mfma_f32_32x32x16_bf16(b1, qr[d0], p1, 0, 0, 0); }
}
__device__ __forceinline__ int v_st(int k, int c) { const int kk = (k & ~0xC) | ((k & 4) << 1) | ((k & 8) >> 1); return ((kk >> 3) * 4 + (c >> 5)) * 512 + ((kk & 7) * 32 + (c & 31)) * 2; }
__device__ __forceinline__ int v_rd_base(int lane) { return ((lane & 3) << 3) | (((lane >> 2) & 3) << 6) | (((lane >> 4) & 1) << 5) | (((lane >> 5) & 1) << 8); }
constexpr int v_rd_off(int d0, int ks, int half) { return d0 * 512 + ks * 4096 + half * 2048; }
template <int OFF> __device__ __forceinline__ s16x4 tr_read(int vb) {
  s16x4 r; asm volatile("ds_read_b64_tr_b16 %0, %1 offset:%2" : "=&v"(r) : "v"(vb), "i"(OFF) : "memory"); return r;
}
template <int D0> __device__ __forceinline__ void pv_one(f32x16& od, int vb, bf16x8 pa0, bf16x8 pa1, bf16x8 pa2, bf16x8 pa3) {
  const s16x4 l0 = tr_read<v_rd_off(D0, 0, 0)>(vb), h0 = tr_read<v_rd_off(D0, 0, 1)>(vb), l1 = tr_read<v_rd_off(D0, 1, 0)>(vb), h1 = tr_read<v_rd_off(D0, 1, 1)>(vb);
  const s16x4 l2 = tr_read<v_rd_off(D0, 2, 0)>(vb), h2 = tr_read<v_rd_off(D0, 2, 1)>(vb), l3 = tr_read<v_rd_off(D0, 3, 0)>(vb), h3 = tr_read<v_rd_off(D0, 3, 1)>(vb);
  asm volatile("s_waitcnt lgkmcnt(0)" ::: "memory"); SBAR();
#define PK(L, H) (bf16x8){L[0], L[1], L[2], L[3], H[0], H[1], H[2], H[3]}
  od = __builtin_amdgcn_mfma_f32_32x32x16_bf16(pa0, PK(l0, h0), od, 0, 0, 0);
  od = __builtin_amdgcn_mfma_f32_32x32x16_bf16(pa1, PK(l1, h1), od, 0, 0, 0);
  od = __builtin_amdgcn_mfma_f32_32x32x16_bf16(pa2, PK(l2, h2), od, 0, 0, 0);
  od = __builtin_amdgcn_mfma_f32_32x32x16_bf16(pa3, PK(l3, h3), od, 0, 0, 0);
#undef PK
}
#define PV_READ8(D0, l0, h0, l1, h1, l2, h2, l3, h3) \
  const s16x4 l0 = tr_read<v_rd_off(D0, 0, 0)>(vb), h0 = tr_read<v_rd_off(D0, 0, 1)>(vb), l1 = tr_read<v_rd_off(D0, 1, 0)>(vb), h1 = tr_read<v_rd_off(D0, 1, 1)>(vb); \
  const s16x4 l2 = tr_read<v_rd_off(D0, 2, 0)>(vb), h2 = tr_read<v_rd_off(D0, 2, 1)>(vb), l3 = tr_read<v_rd_off(D0, 3, 0)>(vb), h3 = tr_read<v_rd_off(D0, 3, 1)>(vb);
#define PV_MMA4(od, l0, h0, l1, h1, l2, h2, l3, h3) do { \
  od = __builtin_amdgcn_mfma_f32_32x32x16_bf16(pa0, (bf16x8){l0[0], l0[1], l0[2], l0[3], h0[0], h0[1], h0[2], h0[3]}, od, 0, 0, 0); \
  od = __builtin_amdgcn_mfma_f32_32x32x16_bf16(pa1, (bf16x8){l1[0], l1[1], l1[2], l1[3], h1[0], h1[1], h1[2], h1[3]}, od, 0, 0, 0); \
  od = __builtin_amdgcn_mfma_f32_32x32x16_bf16(pa2, (bf16x8){l2[0], l2[1], l2[2], l2[3], h2[0], h2[1], h2[2], h2[3]}, od, 0, 0, 0); \
  od = __builtin_amdgcn_mfma_f32_32x32x16_bf16(pa3, (bf16x8){l3[0], l3[1], l3[2], l3[3], h3[0], h3[1], h3[2], h3[3]}, od, 0, 0, 0); } while (0)
__device__ __forceinline__ void pv_d0p(f32x16* o, int vb, bf16x8 pa0, bf16x8 pa1, bf16x8 pa2, bf16x8 pa3) {
  SBAR();
  PV_READ8(0, a0, b0, a1, b1, a2, b2, a3, b3)
  PV_READ8(1, c0, d0, c1, d1, c2, d2, c3, d3)
  asm volatile("s_waitcnt lgkmcnt(8)" ::: "memory"); SBAR();
  PV_MMA4(o[0], a0, b0, a1, b1, a2, b2, a3, b3);
  PV_READ8(2, e0, f0, e1, f1, e2, f2, e3, f3)
  asm volatile("s_waitcnt lgkmcnt(8)" ::: "memory"); SBAR();
  PV_MMA4(o[1], c0, d0, c1, d1, c2, d2, c3, d3);
  PV_READ8(3, g0, h0, g1, h1, g2, h2, g3, h3)
  asm volatile("s_waitcnt lgkmcnt(8)" ::: "memory"); SBAR();
  PV_MMA4(o[2], e0, f0, e1, f1, e2, f2, e3, f3);
  asm volatile("s_waitcnt lgkmcnt(0)" ::: "memory"); SBAR();
  PV_MMA4(o[3], g0, h0, g1, h1, g2, h2, g3, h3);
}
__device__ __forceinline__ void pv_d0(f32x16* o, int vb, bf16x8 pa0, bf16x8 pa1, bf16x8 pa2, bf16x8 pa3) {
  pv_one<0>(o[0], vb, pa0, pa1, pa2, pa3); pv_one<1>(o[1], vb, pa0, pa1, pa2, pa3); pv_one<2>(o[2], vb, pa0, pa1, pa2, pa3); pv_one<3>(o[3], vb, pa0, pa1, pa2, pa3);
}

template <int DQK>
__device__ __forceinline__ void attn_dense_body(const bf16* __restrict__ Qb, const bf16* __restrict__ Kh, const bf16* __restrict__ Vh,
                                                float* __restrict__ Ob, int seq, char* lds, int wave_) {
  constexpr int NQ = DQK / 16;
  int tid = tid_fresh(wave_); asm volatile("" : "+v"(tid));
  const int wid = tid >> 6, lane = tid & 63, r32 = lane & 31, hi = lane >> 5;
  bf16* V_lds = (bf16*)lds; bf16* K_lds = (bf16*)(lds + 2 * SHM_V);
  float* ws = (float*)(lds + 2 * SHM_V + 2 * SHM_K) + wid * 64; float* li_l = ws; float* al_l = ws + 32;
  float m_reg = 0.f  , l_reg = 0; f32x16 o[4] = {}; bf16x8 qr[NQ];
  const bf16* Qw = Qb + (long)(wid * QBLK + r32) * LDQ + hi * 8;
#pragma unroll
  for (int d0 = 0; d0 < NQ; ++d0) qr[d0] = *reinterpret_cast<const bf16x8*>(Qw + d0 * 16);
  const int sr = tid >> 4, sc = (tid & 15) * 8, vst0 = v_st(sr, sc), vst1 = v_st(32 + sr, sc);
  const int kr = tid >> 3, kc8 = (tid & 7) * 8;
  const int vb0 = (int)(uintptr_t)V_lds + v_rd_base(lane);
  struct { bf16x8 vs0, vs1, ks0, ks1; } sr_[2];
#define SLOAD(i, k0) do { sr_[i].vs0 = *reinterpret_cast<const bf16x8*>(&Vh[(long)((k0) + sr) * LDV + sc]); sr_[i].vs1 = *reinterpret_cast<const bf16x8*>(&Vh[(long)((k0) + 32 + sr) * LDV + sc]); \
    if constexpr (DQK == 128) { sr_[i].ks0 = *reinterpret_cast<const bf16x8*>(&Kh[(long)((k0) + sr) * LDKK + sc]); sr_[i].ks1 = *reinterpret_cast<const bf16x8*>(&Kh[(long)((k0) + 32 + sr) * LDKK + sc]); } \
    else { sr_[i].ks0 = *reinterpret_cast<const bf16x8*>(&Kh[(long)((k0) + kr) * LDKK + kc8]); } } while (0)
#define SWRITE(b, i) do { *(bf16x8*)((char*)V_lds + (b) * SHM_V + vst0) = sr_[i].vs0;          \
    *(bf16x8*)((char*)V_lds + (b) * SHM_V + vst1) = sr_[i].vs1;               \
    if constexpr (DQK == 128) { *(bf16x8*)((char*)K_lds + (b) * SHM_K + kswz<128>(sr, sc * 2)) = sr_[i].ks0;                       \
    *(bf16x8*)((char*)K_lds + (b) * SHM_K + kswz<128>(32 + sr, sc * 2)) = sr_[i].ks1; } \
    else { *(bf16x8*)((char*)K_lds + (b) * SHM_K + kswz<64>(kr, kc8 * 2)) = sr_[i].ks0; } } while (0)
#define SWAIT() do { if constexpr (DQK == 128) asm volatile("s_waitcnt vmcnt(4)" ::: "memory"); else asm volatile("s_waitcnt vmcnt(3)" ::: "memory"); } while (0)
#define RESC(a) do { if (__any((a) < 1.f)) { if (hi == 0) al_l[r32] = (a); asm volatile("s_waitcnt lgkmcnt(0)" ::: "memory"); \
    for (int d = 0; d < 4; ++d) for (int r = 0; r < 16; ++r) o[d][r] *= al_l[crow(r, hi)]; } } while (0)
  f32x16 pA0, pA1, pB0, pB1; float alA, alB; bf16x8 pa0, pa1, pa2, pa3; const int NT = seq / KVBLK;
  constexpr int SE = 0, SO = 1;
  SLOAD(SE, 0); asm volatile("s_waitcnt vmcnt(0)" ::: "memory"); SWRITE(0, SE); __syncthreads();
  qkt<DQK>(pA0, pA1, K_lds, qr, r32, hi, 0.f); partialSM<true>(pA0, pA1, m_reg, alA);
  SLOAD(SO, KVBLK); SLOAD(SE, 2 * KVBLK);
  SWAIT(); SWRITE(1, SO); __syncthreads();
  for (int j = 1; j + 1 < NT; j += 2) {
    SBAR(); qkt<DQK>(pB0, pB1, (bf16*)((char*)K_lds + SHM_K), qr, r32, hi, -m_reg);
    finishSM(pA0, pA1, alA, l_reg, pa0, pa1, pa2, pa3); SBAR();
    SLOAD(SO, (j + 2) * KVBLK); SBAR();
    pv_d0(o, vb0, pa0, pa1, pa2, pa3); partialSM<false>(pB0, pB1, m_reg, alB);
    __syncthreads(); SWAIT(); SWRITE(0, SE);
    RESC(alB); __syncthreads();
    SBAR(); qkt<DQK>(pA0, pA1, K_lds, qr, r32, hi, -m_reg);
    finishSM(pB0, pB1, alB, l_reg, pa0, pa1, pa2, pa3); SBAR();
    { const int jn = (j + 3 < NT) ? j + 3 : NT - 1; SLOAD(SE, jn * KVBLK); } SBAR();
    pv_d0(o, vb0 + (int)SHM_V, pa0, pa1, pa2, pa3); partialSM<false>(pA0, pA1, m_reg, alA);
    __syncthreads(); SWAIT(); SWRITE(1, SO);
    RESC(alA); __syncthreads();
  }
  SBAR(); qkt<DQK>(pB0, pB1, (bf16*)((char*)K_lds + SHM_K), qr, r32, hi, -m_reg);
  finishSM(pA0, pA1, alA, l_reg, pa0, pa1, pa2, pa3); SBAR();
  pv_d0(o, vb0, pa0, pa1, pa2, pa3); partialSM<false>(pB0, pB1, m_reg, alB);
  __syncthreads(); RESC(alB);
  finishSM(pB0, pB1, alB, l_reg, pa0, pa1, pa2, pa3); SBAR();
  pv_d0(o, vb0 + (int)SHM_V, pa0, pa1, pa2, pa3);
  if (hi == 0) li_l[r32] = l_reg; asm volatile("s_waitcnt lgkmcnt(0)" ::: "memory");
  float rli[16];
#pragma unroll
  for (int r = 0; r < 16; ++r) rli[r] = __builtin_amdgcn_rcpf(li_l[crow(r, hi)]);
  float* Ow = Ob + (long)(wid * QBLK) * LDO;
#pragma unroll
  for (int r = 0; r < 16; ++r) { int orow = crow(r, hi);
    for (int d0 = 0; d0 < 4; ++d0) Ow[(long)orow * LDO + d0 * 32 + r32] = o[d0][r] * rli[r]; }
#undef SLOAD
#undef SWRITE
#undef SWAIT
#undef RESC
}


template <int DQK>
__device__ __forceinline__ void attn_dense_body2(const bf16* __restrict__ Qb, const bf16* __restrict__ Kh, const bf16* __restrict__ Vh,
                                                 float* __restrict__ Ob, int seq, char* lds, int wave_) {
  constexpr int NQ = DQK / 16;
  int tid = tid_fresh(wave_); asm volatile("" : "+v"(tid));
  const int wid = tid >> 6, lane = tid & 63, r32 = lane & 31, hi = lane >> 5;
  const int widu = __builtin_amdgcn_readfirstlane(wid);
  char* V_ring = lds; char* K_ring = lds + 65536;
  float* ws = (float*)(lds + 65536 + 49152) + wid * 64; float* li_l = ws; float* al_l = ws + 32;
  float m_reg = 0.f, l_reg = 0; f32x16 o[4] = {}; bf16x8 qr[NQ];
  const bf16* Qw = Qb + (long)(wid * QBLK + r32) * LDQ + hi * 8;
#pragma unroll
  for (int d0 = 0; d0 < NQ; ++d0) qr[d0] = *reinterpret_cast<const bf16x8*>(Qw + d0 * 16);
  int voff[2], koff[2];
#pragma unroll
  for (int i = 0; i < 2; ++i) { const int o_ = (((wid * 2 + i) * 64 + lane) & 1023) * 16, sub = o_ >> 9, wi = o_ & 511, kk = ((sub >> 2) << 3) | (wi >> 6);
    const int k = (kk & ~0xC) | ((kk & 4) << 1) | ((kk & 8) >> 1), c = ((sub & 3) << 5) | ((wi & 63) >> 1); voff[i] = k * LDV + c;
    if constexpr (DQK == 128) { const int row = o_ >> 8, cB = (o_ & 255) ^ ((row & 7) << 4); koff[i] = row * LDKK + (cB >> 1); }
    else { const int o2 = ((wid * 64 + lane) & 511) * 16, row = o2 >> 7, cB = (o2 & 127) ^ (((row >> 1) & 7) << 4); koff[i] = row * LDKK + (cB >> 1); } }
  const int vrd = (int)(uintptr_t)V_ring + v_rd_base(lane);
#define ADMA(t_, kb_, vb_) do { const long k0_ = (long)(t_) * KVBLK; \
    _Pragma("unroll") for (int i_ = 0; i_ < 2; ++i_) __builtin_amdgcn_global_load_lds((const unsigned*)(Vh + k0_ * LDV + voff[i_]), (__attribute__((address_space(3))) unsigned*)(uintptr_t)((unsigned)(uintptr_t)V_ring + (vb_) * 16384 + (widu * 2 + i_) * 1024), 16, 0, 0); \
    if constexpr (DQK == 128) { _Pragma("unroll") for (int i_ = 0; i_ < 2; ++i_) __builtin_amdgcn_global_load_lds((const unsigned*)(Kh + k0_ * LDKK + koff[i_]), (__attribute__((address_space(3))) unsigned*)(uintptr_t)((unsigned)(uintptr_t)K_ring + (kb_) * 16384 + (widu * 2 + i_) * 1024), 16, 0, 0); } \
    else __builtin_amdgcn_global_load_lds((const unsigned*)(Kh + k0_ * LDKK + koff[0]), (__attribute__((address_space(3))) unsigned*)(uintptr_t)((unsigned)(uintptr_t)K_ring + (kb_) * 16384 + widu * 1024), 16, 0, 0); } while (0)
#define AWAIT() do { if constexpr (DQK == 128) asm volatile("s_waitcnt vmcnt(4) lgkmcnt(0)" ::: "memory"); else asm volatile("s_waitcnt vmcnt(3) lgkmcnt(0)" ::: "memory"); \
    __builtin_amdgcn_s_barrier(); asm volatile("" ::: "memory"); } while (0)
#define RESC(a) do { if (__any((a) < 1.f)) { if (hi == 0) al_l[r32] = (a); asm volatile("s_waitcnt lgkmcnt(0)" ::: "memory"); \
    for (int d = 0; d < 4; ++d) for (int r = 0; r < 16; ++r) o[d][r] *= al_l[crow(r, hi)]; } } while (0)
#define KB3(x) ((x) >= 3 ? (x) - 3 : (x))
#define VB4(x) ((x) & 3)
  f32x16 pA0, pA1, pB0, pB1; float alA, alB; bf16x8 pa0, pa1, pa2, pa3; const int NT = seq / KVBLK;
  asm volatile("s_waitcnt vmcnt(0)" ::: "memory");
  ADMA(0, 0, 0); ADMA(1, 1, 1);
  AWAIT();
  ADMA(2, 2, 2);
  qkt<DQK>(pA0, pA1, (const bf16*)K_ring, qr, r32, hi, 0.f); partialSM<true>(pA0, pA1, m_reg, alA);
  int kb = 1, vb = 1;
  for (int j = 1; j + 1 < NT; j += 2) {
    AWAIT();
    { const int jn = (j + 2 < NT) ? j + 2 : NT - 1; ADMA(jn, KB3(kb + 2), VB4(vb + 2)); }
    SBAR(); __builtin_amdgcn_s_setprio(1); qkt<DQK>(pB0, pB1, (const bf16*)(K_ring + kb * 16384), qr, r32, hi, -m_reg);
    finishSM(pA0, pA1, alA, l_reg, pa0, pa1, pa2, pa3); SBAR();
    pv_d0p(o, vrd + VB4(vb + 3) * 16384, pa0, pa1, pa2, pa3); partialSM<false>(pB0, pB1, m_reg, alB); __builtin_amdgcn_s_setprio(0);
    RESC(alB);
    kb = KB3(kb + 1); vb = VB4(vb + 1);
    AWAIT();
    { const int jn = (j + 3 < NT) ? j + 3 : NT - 1; ADMA(jn, KB3(kb + 2), VB4(vb + 2)); }
    SBAR(); __builtin_amdgcn_s_setprio(1); qkt<DQK>(pA0, pA1, (const bf16*)(K_ring + kb * 16384), qr, r32, hi, -m_reg);
    finishSM(pB0, pB1, alB, l_reg, pa0, pa1, pa2, pa3); SBAR();
    pv_d0p(o, vrd + VB4(vb + 3) * 16384, pa0, pa1, pa2, pa3); partialSM<false>(pA0, pA1, m_reg, alA); __builtin_amdgcn_s_setprio(0);
    RESC(alA);
    kb = KB3(kb + 1); vb = VB4(vb + 1);
  }
  asm volatile("s_waitcnt vmcnt(0) lgkmcnt(0)" ::: "memory"); __builtin_amdgcn_s_barrier(); asm volatile("" ::: "memory");
  SBAR(); __builtin_amdgcn_s_setprio(1); qkt<DQK>(pB0, pB1, (const bf16*)(K_ring + kb * 16384), qr, r32, hi, -m_reg);
  finishSM(pA0, pA1, alA, l_reg, pa0, pa1, pa2, pa3); SBAR();
  pv_d0p(o, vrd + VB4(vb + 3) * 16384, pa0, pa1, pa2, pa3); partialSM<false>(pB0, pB1, m_reg, alB); __builtin_amdgcn_s_setprio(0);
  RESC(alB);
  finishSM(pB0, pB1, alB, l_reg, pa0, pa1, pa2, pa3); SBAR();
  pv_d0p(o, vrd + vb * 16384, pa0, pa1, pa2, pa3);
  if (hi == 0) li_l[r32] = l_reg; asm volatile("s_waitcnt lgkmcnt(0)" ::: "memory");
  float rli[16];
#pragma unroll
  for (int r = 0; r < 16; ++r) rli[r] = __builtin_amdgcn_rcpf(li_l[crow(r, hi)]);
  if constexpr (DQK == 128) {
    bf16_t* Ow = (bf16_t*)Ob + (long)(wid * QBLK) * 2048;
#pragma unroll
    for (int r = 0; r < 16; ++r) { int orow = crow(r, hi);
      for (int d0 = 0; d0 < 4; ++d0) { const float v = o[d0][r] * rli[r]; Ow[(long)orow * 2048 + d0 * 32 + r32] = (bf16_t)(cvtpk(v, v) & 0xffffu); } }
  } else {
    float* Ow = Ob + (long)(wid * QBLK) * LDO;
#pragma unroll
    for (int r = 0; r < 16; ++r) { int orow = crow(r, hi);
      for (int d0 = 0; d0 < 4; ++d0) Ow[(long)orow * LDO + d0 * 32 + r32] = o[d0][r] * rli[r]; }
  }
#undef ADMA
#undef AWAIT
#undef RESC
#undef KB3
#undef VB4
}

__device__ __forceinline__ void attn_diff512(const bf16* __restrict__ Qb, const bf16* __restrict__ Kh, const bf16* __restrict__ Vh,
                                             float* __restrict__ Ob, int seq, char* lds, int wave_) {
  int tid = tid_fresh(wave_); asm volatile("" : "+v"(tid));
  const int wid = tid >> 6, lane = tid & 63, r32 = lane & 31, hi = lane >> 5;
  const int widu = __builtin_amdgcn_readfirstlane(wid);
  char* V_ring = lds; char* K_ring = lds + 65536;
  __attribute__((address_space(3))) float* al_l = (__attribute__((address_space(3))) float*)(uintptr_t)((unsigned)(uintptr_t)lds + 65536 + 49152) + wid * 128 + 64;
  float m0 = 0.f, m1 = 0.f, l0 = 0.f, l1 = 0.f; f32x16 oa[4] = {}, ob[4] = {}; bf16x8 qa[4], qb[4];
  { const bf16* Qw = Qb + (long)(wid * 64 + r32) * LDQ + hi * 8;
#pragma unroll
    for (int d0 = 0; d0 < 4; ++d0) { qa[d0] = *reinterpret_cast<const bf16x8*>(Qw + d0 * 16); qb[d0] = *reinterpret_cast<const bf16x8*>(Qw + (long)32 * LDQ + d0 * 16); } }
#define VOFF(i) ({ const int o_ = (((wid * 2 + (i)) * 64 + lane) & 1023) * 16, sub = o_ >> 9, wi = o_ & 511, kk = ((sub >> 2) << 3) | (wi >> 6); \
    const int k = (kk & ~0xC) | ((kk & 4) << 1) | ((kk & 8) >> 1), c = ((sub & 3) << 5) | ((wi & 63) >> 1); k * LDV + c; })
#define KOFF() ({ const int o2 = ((wid * 64 + lane) & 511) * 16, row = o2 >> 7, cB = (o2 & 127) ^ (((row >> 1) & 7) << 4); row * LDKK + (cB >> 1); })
#define ADMA(t_, kb_, vb_) do { const long k0_ = (long)(t_) * KVBLK; \
    _Pragma("unroll") for (int i_ = 0; i_ < 2; ++i_) __builtin_amdgcn_global_load_lds((const unsigned*)(Vh + k0_ * LDV + VOFF(i_)), (__attribute__((address_space(3))) unsigned*)(uintptr_t)((unsigned)(uintptr_t)V_ring + (vb_) * 16384 + (widu * 2 + i_) * 1024), 16, 0, 0); \
    __builtin_amdgcn_global_load_lds((const unsigned*)(Kh + k0_ * LDKK + KOFF()), (__attribute__((address_space(3))) unsigned*)(uintptr_t)((unsigned)(uintptr_t)K_ring + (kb_) * 16384 + widu * 1024), 16, 0, 0); } while (0)
#define AWAIT() do { asm volatile("s_waitcnt vmcnt(3) lgkmcnt(0)" ::: "memory"); __builtin_amdgcn_s_barrier(); asm volatile("" ::: "memory"); } while (0)
#define KB3(x) ((x) >= 3 ? (x) - 3 : (x))
#define VB4(x) ((x) & 3)
#define SMG(p, mreg, lreg, oacc, G_, FIRST_, q0, q1) do { \
    float pmax = p[0]; _Pragma("unroll") for (int r = 1; r < 16; ++r) pmax = fmaxf(pmax, p[r]); \
    { auto rr = __builtin_amdgcn_permlane32_swap(__float_as_uint(pmax), __float_as_uint(pmax), false, false); pmax = fmaxf(__uint_as_float(rr[0]), __uint_as_float(rr[1])); } \
    float alpha = 1.f; \
    if ((FIRST_) || !__all(pmax <= THR * 1.4426950408889634f)) { const float sh = (FIRST_) ? pmax : fmaxf(pmax, 0.f); alpha = (FIRST_) ? 1.f : __builtin_amdgcn_exp2f(-sh); mreg += sh; \
        _Pragma("unroll") for (int r = 0; r < 16; ++r) p[r] -= sh; \
        if (!(FIRST_) && __any(alpha < 1.f)) { if (hi == 0) al_l[(G_) * 32 + r32] = alpha; asm volatile("s_waitcnt lgkmcnt(0)" ::: "memory"); \
            _Pragma("unroll") for (int d = 0; d < 4; ++d) _Pragma("unroll") for (int r = 0; r < 16; ++r) oacc[d][r] *= al_l[(G_) * 32 + crow(r, hi)]; } } \
    float ps = 0.f; \
    _Pragma("unroll") for (int r = 0; r < 16; ++r) { p[r] = __builtin_amdgcn_exp2f(p[r]); ps += p[r]; } \
    { auto rr = __builtin_amdgcn_permlane32_swap(__float_as_uint(ps), __float_as_uint(ps), false, false); ps = __uint_as_float(rr[0]) + __uint_as_float(rr[1]); } \
    lreg = lreg * alpha + ps; \
    PK4(p, 0, q0); PK4(p, 8, q1); } while (0)
#define PK4(P, BASE, OUT) do { unsigned a0_ = cvtpk_s(P[BASE + 0], P[BASE + 1]), a1_ = cvtpk_s(P[BASE + 2], P[BASE + 3]);   \
    unsigned b0_ = cvtpk_s(P[BASE + 4], P[BASE + 5]), b1_ = cvtpk_s(P[BASE + 6], P[BASE + 7]);                              \
    auto r0_ = __builtin_amdgcn_permlane32_swap(a0_, b0_, false, false); auto r1_ = __builtin_amdgcn_permlane32_swap(a1_, b1_, false, false); \
    u32x4 w_ = {r0_[0], r1_[0], r0_[1], r1_[1]}; OUT = *reinterpret_cast<bf16x8*>(&w_); } while (0)
#define PV_READ4(D0, H, l0, h0, l1, h1) \
  const s16x4 l0 = tr_read<v_rd_off(D0, 2 * (H), 0)>(vb), h0 = tr_read<v_rd_off(D0, 2 * (H), 1)>(vb), l1 = tr_read<v_rd_off(D0, 2 * (H) + 1, 0)>(vb), h1 = tr_read<v_rd_off(D0, 2 * (H) + 1, 1)>(vb);
#define PV_MM4(oA, oB, l0, h0, l1, h1) do { \
  const bf16x8 v0_ = (bf16x8){l0[0], l0[1], l0[2], l0[3], h0[0], h0[1], h0[2], h0[3]}, v1_ = (bf16x8){l1[0], l1[1], l1[2], l1[3], h1[0], h1[1], h1[2], h1[3]}; \
  oA = __builtin_amdgcn_mfma_f32_32x32x16_bf16(fa0, v0_, oA, 0, 0, 0); oB = __builtin_amdgcn_mfma_f32_32x32x16_bf16(fb0, v0_, oB, 0, 0, 0); \
  oA = __builtin_amdgcn_mfma_f32_32x32x16_bf16(fa1, v1_, oA, 0, 0, 0); oB = __builtin_amdgcn_mfma_f32_32x32x16_bf16(fb1, v1_, oB, 0, 0, 0); } while (0)
#define HALF(kb_, vb_, H, FIRST_) do { \
    f32x16 pa_, pb_; \
    _Pragma("unroll") for (int r = 0; r < 16; ++r) { pa_[r] = -m0; pb_[r] = -m1; } \
    if (widu >= 4) __builtin_amdgcn_s_setprio(2); else __builtin_amdgcn_s_setprio(1); \
    { const char* Ks_ = K_ring + (kb_) * 16384; \
      _Pragma("unroll") for (int d0 = 0; d0 < 4; ++d0) { const int cb = (d0 * 16 + hi * 8) * 2; \
        const bf16x8 kf = *reinterpret_cast<const bf16x8*>(Ks_ + kswz<64>(32 * (H) + r32, cb)); \
        pa_ = __builtin_amdgcn_mfma_f32_32x32x16_bf16(kf, qa[d0], pa_, 0, 0, 0); pb_ = __builtin_amdgcn_mfma_f32_32x32x16_bf16(kf, qb[d0], pb_, 0, 0, 0); } } \
    if (widu >= 4) __builtin_amdgcn_s_setprio(1); else __builtin_amdgcn_s_setprio(0); \
    bf16x8 fa0, fa1, fb0, fb1; \
    SMG(pa_, m0, l0, oa, 0, FIRST_, fa0, fa1); \
    SMG(pb_, m1, l1, ob, 1, FIRST_, fb0, fb1); \
    { const int vb = (int)(uintptr_t)V_ring + v_rd_base(lane) + (vb_) * 16384; SBAR(); if (widu >= 4) __builtin_amdgcn_s_setprio(2); else __builtin_amdgcn_s_setprio(1); \
      PV_READ4(0, H, a0, b0, a1, b1) \
      PV_READ4(1, H, c0, d0, c1, d1) \
      asm volatile("s_waitcnt lgkmcnt(4)" ::: "memory"); SBAR(); \
      PV_MM4(oa[0], ob[0], a0, b0, a1, b1); \
      PV_READ4(2, H, e0, f0, e1, f1) \
      asm volatile("s_waitcnt lgkmcnt(4)" ::: "memory"); SBAR(); \
      PV_MM4(oa[1], ob[1], c0, d0, c1, d1); \
      PV_READ4(3, H, g0, h0, g1, h1) \
      asm volatile("s_waitcnt lgkmcnt(4)" ::: "memory"); SBAR(); \
      PV_MM4(oa[2], ob[2], e0, f0, e1, f1); \
      asm volatile("s_waitcnt lgkmcnt(0)" ::: "memory"); SBAR(); \
      PV_MM4(oa[3], ob[3], g0, h0, g1, h1); if (widu >= 4) __builtin_amdgcn_s_setprio(1); else __builtin_amdgcn_s_setprio(0); } } while (0)
#define TILE(kb_, vb_, FIRST_) do { HALF(kb_, vb_, 0, FIRST_); HALF(kb_, vb_, 1, false); } while (0)
  const int NT = seq / KVBLK;
  asm volatile("s_waitcnt vmcnt(0)" ::: "memory");
  ADMA(0, 0, 0); ADMA(1, 1, 1);
  AWAIT();
  ADMA(2, 2, 2);
  TILE(0, 0, true);
  int kb = 1, vb4 = 1;
  for (int j = 1; j < NT; ++j) {
    if (j + 1 < NT) { AWAIT(); } else { asm volatile("s_waitcnt vmcnt(0) lgkmcnt(0)" ::: "memory"); __builtin_amdgcn_s_barrier(); asm volatile("" ::: "memory"); }
    if (j + 1 < NT) { const int jn = (j + 2 < NT) ? j + 2 : NT - 1; ADMA(jn, KB3(kb + 2), VB4(vb4 + 2)); }
    TILE(kb, vb4, false);
    kb = KB3(kb + 1); vb4 = VB4(vb4 + 1);
  }
  __builtin_amdgcn_s_setprio(0);
  if (hi == 0) { al_l[r32 - 64] = l0; al_l[r32 - 32] = l1; } asm volatile("s_waitcnt lgkmcnt(0)" ::: "memory");
  float* Ow = Ob + (long)(wid * 64) * LDO;
#pragma unroll
  for (int r = 0; r < 16; ++r) { const int orow = crow(r, hi); const float ra = __builtin_amdgcn_rcpf(al_l[orow - 64]);
#pragma unroll
    for (int d0 = 0; d0 < 4; ++d0) Ow[(long)orow * LDO + d0 * 32 + r32] = oa[d0][r] * ra; }
  SBAR();
#pragma unroll
  for (int r = 0; r < 16; ++r) { const int orow = crow(r, hi); const float rb = __builtin_amdgcn_rcpf(al_l[orow - 32]);
#pragma unroll
    for (int d0 = 0; d0 < 4; ++d0) Ow[(long)(32 + orow) * LDO + d0 * 32 + r32] = ob[d0][r] * rb; }
#undef ADMA
#undef AWAIT
#undef KB3
#undef VB4
#undef SMG
#undef PK4
#undef TILE
#undef HALF
#undef VOFF
#undef KOFF
#undef PV_MM4
#undef PV_READ4
}

typedef short v4i16_t __attribute__((ext_vector_type(4)));
__device__ __forceinline__ s16x4 vtr(int addr) { return __builtin_bit_cast(s16x4, __builtin_amdgcn_ds_read_tr16_b64_v4i16((__attribute__((address_space(3))) v4i16_t*)(uintptr_t)(unsigned)addr)); }
#define PKF(L, H) (bf16x8){L[0], L[1], L[2], L[3], H[0], H[1], H[2], H[3]}
template <int D0, int KS> __device__ __forceinline__ bf16x8 vfragc(int vb) {
  const s16x4 l = vtr(vb + v_rd_off(D0, KS, 0)), h = vtr(vb + v_rd_off(D0, KS, 1));
  return (bf16x8){l[0], l[1], l[2], l[3], h[0], h[1], h[2], h[3]};
}
template <int D0, int KS> __device__ __forceinline__ bf16x8 vfrag(int vb) {
  const s16x4 l = tr_read<v_rd_off(D0, KS, 0)>(vb), h = tr_read<v_rd_off(D0, KS, 1)>(vb);
  asm volatile("s_waitcnt lgkmcnt(0)" ::: "memory"); SBAR();
  return PKF(l, h);
}
#define PK4(P, BASE, OUT) do { unsigned a0 = cvtpk_s(P[BASE + 0], P[BASE + 1]), a1 = cvtpk_s(P[BASE + 2], P[BASE + 3]);   \
    unsigned b0 = cvtpk_s(P[BASE + 4], P[BASE + 5]), b1 = cvtpk_s(P[BASE + 6], P[BASE + 7]);                              \
    auto r0 = __builtin_amdgcn_permlane32_swap(a0, b0, false, false); auto r1 = __builtin_amdgcn_permlane32_swap(a1, b1, false, false); \
    u32x4 w = {r0[0], r1[0], r0[1], r1[1]}; OUT = *reinterpret_cast<bf16x8*>(&w); } while (0)
}

constexpr int NIN = 39;
constexpr int NPHASE = 24;
struct Args { const float* in[NIN]; float* out; unsigned char* ws; int ph_lo, ph_hi; };
enum { I_X = 0, I_C, I_CTX, I_CCTX,
       I_WMOD0, I_BMOD0, I_GPREMIX0, I_GPOSTMIX0, I_WIN0, I_LQ1, I_LK1, I_LQ2, I_LK2, I_GSUBLN, I_GQ, I_GK, I_WOUT0, I_GPREFFN0, I_GPOSTFFN0, I_WROUTER0, I_WGATE0, I_WUP0, I_WDOWN0,
       I_WMOD1, I_BMOD1, I_GPREMIX1, I_GPOSTMIX1, I_WIN1, I_BGATE1, I_WCONV1, I_BCONV1, I_GHEAD1, I_WOUT1, I_GPREFFN1, I_GPOSTFFN1, I_WROUTER1, I_WGATE1, I_WUP1, I_WDOWN1 };

__device__ __forceinline__ void tr_load(const float* __restrict__ W, int N, int k0, int n0, int lane, float (&v)[32]) {
#pragma unroll
    for (int i = 0; i < 32; ++i) { const int kk = 2 * i + (lane >> 5); v[i] = W[(size_t)(k0 + kk) * N + n0 + (lane & 31)]; }
}
__device__ __forceinline__ void tr_store(const float (&v)[32], int k0, bf16_t* WT, size_t out_row0, LAS float* scr, int lane) {
#pragma unroll
    for (int i = 0; i < 32; ++i) { const int kk = 2 * i + (lane >> 5); scr[kk * 33 + (lane & 31)] = v[i]; }
    LDS_WAIT(); asm volatile("" ::: "memory");
    const int c = lane & 7;
#pragma unroll
    for (int j = 0; j < 4; ++j) { const int n = (lane >> 3) + 8 * j; const LAS float* s = scr + (8 * c) * 33 + n;
        u32x4 o; o.x = cvtpk(s[0 * 33], s[1 * 33]); o.y = cvtpk(s[2 * 33], s[3 * 33]); o.z = cvtpk(s[4 * 33], s[5 * 33]); o.w = cvtpk(s[6 * 33], s[7 * 33]);
        *(u32x4*)(WT + (out_row0 + n) * (size_t)D + k0 + 8 * c) = o; }
    LDS_WAIT(); asm volatile("" ::: "memory");
}
__device__ __forceinline__ void tr_item(const float* __restrict__ W, int N, int k0, int n0, bf16_t* WT, size_t out_row0, LAS float* scr, int lane) {
    float v[32]; tr_load(W, N, k0, n0, lane, v); tr_store(v, k0, WT, out_row0, scr, lane);
}
struct ExpItem { const float* W; bf16_t* WT; size_t row0; int k0, n0; };
__device__ __forceinline__ ExpItem exp_item(int it, int kind, const float* wg, const float* wu, const float* wd, bf16_t* WGUp, bf16_t* WDp) {
    const int mat = it >> 11, r = it & 2047, kb = r >> 6, nb = r & 63, n0 = 32 * nb;
    const int e = kind == 0 ? mat / 3 : (kind == 1 ? mat >> 1 : mat), which = kind == 0 ? mat % 3 : (kind == 1 ? (mat & 1) : 2);
    ExpItem x; x.k0 = 64 * kb; x.n0 = n0; const size_t eoff = (size_t)e * D * D;
    if (which == 0) { x.W = wg + eoff; x.WT = WGUp; x.row0 = (size_t)e * 4096 + (n0 >> 7) * 256 + (n0 & 127); }
    else if (which == 1) { x.W = wu + eoff; x.WT = WGUp; x.row0 = (size_t)e * 4096 + (n0 >> 7) * 256 + 128 + (n0 & 127); }
    else { x.W = wd + eoff; x.WT = WDp; x.row0 = (size_t)e * 2048 + n0; }
    return x;
}
__device__ __forceinline__ void conv_dyn(unsigned* counter, int total, int kind, const float* wg, const float* wu, const float* wd, bf16_t* WGUp, bf16_t* WDp,
                                         const unsigned* done, unsigned target, LAS float* scr, int lane) {
    for (;;) {
        if (done && __builtin_amdgcn_readfirstlane((int)__hip_atomic_load(done, __ATOMIC_RELAXED, __HIP_MEMORY_SCOPE_AGENT)) >= (int)target) break;
        int it0 = 0; if (lane == 0) it0 = (int)__hip_atomic_fetch_add(counter, 8u, __ATOMIC_RELAXED, __HIP_MEMORY_SCOPE_AGENT);
        it0 = __builtin_amdgcn_readfirstlane(it0);
        if (it0 >= total) break;
#pragma unroll 1
        for (int p = 0; p < 8; p += 2) {
            const ExpItem xa = exp_item(it0 + p, kind, wg, wu, wd, WGUp, WDp), xb = exp_item(it0 + p + 1, kind, wg, wu, wd, WGUp, WDp);
            float va[32], vb[32];
            tr_load(xa.W, D, xa.k0, xa.n0, lane, va); tr_load(xb.W, D, xb.k0, xb.n0, lane, vb);
            tr_store(va, xa.k0, xa.WT, xa.row0, scr, lane); tr_store(vb, xb.k0, xb.WT, xb.row0, scr, lane);
        }
    }
}
__device__ __forceinline__ int gemm_wgs(int nunits, int G) { const int rounds = (nunits + G - 1) / G; return (nunits + rounds - 1) / rounds; }
__device__ __forceinline__ void conv_plain(const float* W, int N, bf16_t* WT, int item, LAS float* scr, int lane) {
    const int nblk = N / 32, kb = item / nblk, nb = item % nblk;
    tr_item(W, N, 64 * kb, 32 * nb, WT, (size_t)32 * nb, scr, lane);
}
struct Row { f32x4 v[8]; };
__device__ __forceinline__ void row_load(Row& r, const float* p, int lane) {
#pragma unroll
    for (int j = 0; j < 8; ++j) r.v[j] = *(const f32x4*)(p + 4 * lane + 256 * j);
}
__device__ __forceinline__ void row_load_bf16(Row& r, const bf16_t* p, int lane) {
#pragma unroll
    for (int j = 0; j < 8; ++j) { const u32x2 w = *(const u32x2*)(p + 4 * lane + 256 * j); r.v[j] = (f32x4){bflo(w.x), bfhi(w.x), bflo(w.y), bfhi(w.y)}; }
}
__device__ __forceinline__ float row_ss(const Row& r) { float s = 0.f;
#pragma unroll
    for (int j = 0; j < 8; ++j) s += (r.v[j].x * r.v[j].x + r.v[j].y * r.v[j].y) + (r.v[j].z * r.v[j].z + r.v[j].w * r.v[j].w);
    return wave_sum(s); }
__device__ __forceinline__ void row_store_bf16(const Row& r, bf16_t* p, int lane) {
#pragma unroll
    for (int j = 0; j < 8; ++j) { u32x2 w; w.x = cvtpk(r.v[j].x, r.v[j].y); w.y = cvtpk(r.v[j].z, r.v[j].w); *(u32x2*)(p + 4 * lane + 256 * j) = w; }
}
__device__ __forceinline__ void row_store_f32(const Row& r, float* p, int lane) {
#pragma unroll
    for (int j = 0; j < 8; ++j) *(f32x4*)(p + 4 * lane + 256 * j) = r.v[j];
}
__device__ __forceinline__ void row_norm_mod(Row& x, const float* g, const float* shift, const float* scale, int lane) {
    const float r = rsqrtf(row_ss(x) * (1.f / D) + EPS);
#pragma unroll
    for (int j = 0; j < 8; ++j) { const f32x4 gg = *(const f32x4*)(g + 4 * lane + 256 * j), sh = *(const f32x4*)(shift + 4 * lane + 256 * j), sc = *(const f32x4*)(scale + 4 * lane + 256 * j);
        x.v[j] = (x.v[j] * r) * gg * (sc + 1.f) + sh; }
}

#define MOD ((float*)(ws + WS_MOD))
#define AFFT ((float*)(ws + WS_AFFT))
#define IDX ((int*)(ws + WS_IDX))
#define GATEV ((float*)(ws + WS_GATEV))
#define INV ((int*)(ws + WS_INV))
#define GATES ((float*)(ws + WS_GATES))
#define GB ((float*)(ws + WS_GB))
#define GI ((float*)(ws + WS_GI))
#define NST ((float*)(ws + WS_NST))
#define WIN0 ((bf16_t*)(ws + WS_WIN0))
#define WOUT0 ((bf16_t*)(ws + WS_WOUT0))
#define WIN1 ((bf16_t*)(ws + WS_WIN1))
#define WOUT1 ((bf16_t*)(ws + WS_WOUT1))
#define WGU ((bf16_t*)(ws + WS_WGU))
#define WD ((bf16_t*)(ws + WS_WD))
#define XC ((bf16_t*)(ws + WS_XC))
#define XC2 ((bf16_t*)(ws + WS_XC2))
#define XN ((bf16_t*)(ws + WS_XN))
#define QKV ((bf16_t*)(ws + WS_QKV))
#define QD ((bf16_t*)(ws + WS_QD))
#define AO ((bf16_t*)(ws + WS_AO))
#define Y ((bf16_t*)(ws + WS_Y))
#define OF ((float*)(ws + WS_OF))
#define XE ((bf16_t*)(ws + WS_XE))
#define HID ((bf16_t*)(ws + WS_HID))
#define YE ((bf16_t*)(ws + WS_YE))
#define PROJ ((bf16_t*)(ws + WS_PROJ))
#define QC ((bf16_t*)(ws + WS_QC))
#define KC ((bf16_t*)(ws + WS_KC))
#define CST ((bf16_t*)(ws + WS_CST))
#define HD ((bf16_t*)(ws + WS_HD))
#define RO ((bf16_t*)(ws + WS_RO))
#define Y1 ((bf16_t*)(ws + WS_Y1))
__global__ void __launch_bounds__(NTHREADS, 2) mega(Args a) {
    extern __shared__ __attribute__((aligned(16))) unsigned char lds_raw[];
    LAS unsigned char* lds = (LAS unsigned char*)lds_raw;
    volatile LAS unsigned* MISC = (volatile LAS unsigned*)(lds + MISC_OFF);
    const int wave = wave_id();
    const int G = gridDim.x, bx = blockIdx.x;
    const int gw = bx * NWAVES + wave, NGW = G * NWAVES;
    { const int t0_ = tid_fresh(wave); if (t0_ < 64) MISC[t0_] = 0u; }
    __syncthreads();
    unsigned char* ws = a.ws;
    unsigned* ctl = (unsigned*)(ws + WS_CTL);
    const int lo = a.ph_lo, hi = a.ph_hi;
    const bool use_bar = (hi - lo) > 1;
    XcdBarrier bar; bar.bar = ctl + CW_BAR; bar.x = 0; bar.st = MISC + 8; bar.wave = wave;
    if (use_bar) bar = xcd_barrier_post(ctl + CW_BAR, MISC + 8, wave);
#ifndef PH_MASK
#define PH_MASK 0xFFFFFFu
#endif
#define IN(k) ((((unsigned)PH_MASK >> (k)) & 1u) && lo <= (k) && (k) < hi)
#define SEAM(k) do { if (IN((k) + 1)) xcd_barrier(bar); } while (0)

    if (IN(0)) { const int lane = lane_fresh(), tid = wave * 64 + lane;
        LAS float* scr = (LAS float*)(lds + wave * 16384);
        {
            constexpr int I0 = 32 * (NQKV / 32), I1 = 32 * 64, I2 = 32 * 257, I3 = 32 * 64;
            for (int it = gw; it < I0 + I1 + I2 + I3; it += NGW) {
                int r = it;
                if (r < I0) { conv_plain(a.in[I_WIN0], NQKV, WIN0, r, scr, lane); continue; } r -= I0;
                if (r < I1) { conv_plain(a.in[I_WOUT0], D, WOUT0, r, scr, lane); continue; } r -= I1;
                if (r < I2) { conv_plain(a.in[I_WIN1], 8224, WIN1, r, scr, lane); continue; } r -= I2;
                conv_plain(a.in[I_WOUT1], D, WOUT1, r, scr, lane);
            }
            for (size_t i = (size_t)bx * NTHREADS + tid; i < (size_t)224 * D / 8; i += (size_t)G * NTHREADS) *(u32x4*)(WIN1 + (size_t)8224 * D + i * 8) = (u32x4){0u, 0u, 0u, 0u};
        }
        __syncthreads();
        LAS float* sv = (LAS float*)lds;
        LAS float* red = (LAS float*)(lds + 16384);
        for (int i = tid; i < D; i += NTHREADS) { const float c0 = a.in[I_C][i], c1 = a.in[I_CCTX][i]; sv[i] = c0 * sigmoidf_(c0); sv[D + i] = c1 * sigmoidf_(c1); }
        __syncthreads();
        for (int cb = bx; cb < 256; cb += G) {
            for (int l = 0; l < 2; ++l) {
                const float* W = a.in[l ? I_WMOD1 : I_WMOD0]; const float* bm = a.in[l ? I_BMOD1 : I_BMOD0];
                const int c4 = tid % 12, kg = tid / 12;
                f32x4 a0 = (f32x4){0.f, 0.f, 0.f, 0.f}, a1 = a0;
                if (tid < 504) {
#pragma unroll 8
                    for (int k = kg; k < D; k += 42) { const f32x4 w = *(const f32x4*)(W + (size_t)k * 12288 + 48 * cb + 4 * c4); a0 += w * sv[k]; a1 += w * sv[D + k]; }
                    LAS float* rp = red + (kg * 12 + c4) * 8;
                    *(LAS f32x4*)rp = a0; *(LAS f32x4*)(rp + 4) = a1;
                }
                __syncthreads();
                if (tid < 96) { const int col = tid % 48, set = tid / 48; float s = 0.f;
                    for (int k2 = 0; k2 < 42; ++k2) s += red[(k2 * 12 + col / 4) * 8 + set * 4 + (col & 3)];
                    MOD[(size_t)(l * 2 + set) * 12288 + 48 * cb + col] = s + bm[48 * cb + col]; }
                __syncthreads();
            }
        }
        SEAM(0);
    }

    if (IN(1)) { const int lane = lane_fresh(), tid = wave * 64 + lane;
        for (int t = gw; t < T; t += NGW) {
            const int set = t < CTXL ? 1 : 0;
            const float* src = t < CTXL ? a.in[I_CTX] + (size_t)t * D : a.in[I_X] + (size_t)(t - CTXL) * D;
            const float* md = MOD + (size_t)(0 * 2 + set) * 12288;
            Row x; row_load(x, src, lane);
            row_norm_mod(x, a.in[I_GPREMIX0], md + 0 * D, md + 1 * D, lane);
            row_store_bf16(x, XN + (size_t)t * D, lane);
        }
        SEAM(1);
    }

    if (IN(2)) { const int lane = lane_fresh(), tid = wave * 64 + lane;
        const int GE = gemm_wgs((T / 256) * (NQKV / 256), G);
        if (bx < GE) {
            pg8::Gemm g{XN, WIN0, D, nullptr, 1, 0}; pg8::StaticOrder S; S.init(T / 256, NQKV / 256, GE, bx);
            pg8::EpiBf16 E{QKV, NQKV, 1 << 30, nullptr};
            pg8::gemm_phase<pg8::EpiBf16, pg8::StaticOrder>(lds, g, S, E, wave);
            if (tid == 0) __hip_atomic_fetch_add(ctl + CW_DONE2, 1u, __ATOMIC_RELAXED, __HIP_MEMORY_SCOPE_AGENT);
        } else conv_dyn(ctl + CW_C0, NE * 3 * 2048, 0, a.in[I_WGATE0], a.in[I_WUP0], a.in[I_WDOWN0], WGU, WD, ctl + CW_DONE2, (unsigned)GE, (LAS float*)(lds + wave * 16384), lane);
        SEAM(2);
    }

    if (IN(3)) { const int lane = lane_fresh(), tid = wave * 64 + lane;
        const float L2T = 13.287712379549449f;
        for (int t = gw; t < T; t += NGW) {
            const bool lat = t >= CTXL; const int tl = t - CTXL; const float prow = (float)(tl >> 6), pcol = (float)(tl & 63);
            bf16_t* qkv = QKV + (size_t)t * NQKV; bf16_t* qd = QD + (size_t)t * NQD;
            {
                const int g = lane >> 1, hp = lane & 1; const int base = (g < 16) ? g * 64 : 1024 + (g - 16) * 64;
                const float pos = hp ? pcol : prow; const float qs = (g < 16) ? 0.18033688011112042f : 1.f;
                u32x4 x1a = *(const u32x4*)(qkv + base + 16 * hp), x1b = *(const u32x4*)(qkv + base + 16 * hp + 8);
                u32x4 x2a = *(const u32x4*)(qkv + base + 32 + 16 * hp), x2b = *(const u32x4*)(qkv + base + 32 + 16 * hp + 8);
                unsigned x1w[8] = {x1a.x, x1a.y, x1a.z, x1a.w, x1b.x, x1b.y, x1b.z, x1b.w}, x2w[8] = {x2a.x, x2a.y, x2a.z, x2a.w, x2b.x, x2b.y, x2b.z, x2b.w};
                unsigned o1w[8], o2w[8];
#pragma unroll
                for (int w = 0; w < 8; ++w) {
                    float o1[2], o2[2];
#pragma unroll
                    for (int q = 0; q < 2; ++q) { const int j = 2 * w + q;
                        const float f = __builtin_amdgcn_exp2f(-L2T * (float)(2 * j) * (1.f / 32.f));
                        float sn = 0.f, cs = 1.f; if (lat) { const float ang = pos * f; sn = __sinf(ang); cs = __cosf(ang); }
                        const float v1 = q ? bfhi(x1w[w]) : bflo(x1w[w]), v2 = q ? bfhi(x2w[w]) : bflo(x2w[w]);
                        o1[q] = (v1 * cs - v2 * sn) * qs; o2[q] = (v2 * cs + v1 * sn) * qs; }
                    o1w[w] = cvtpk(o1[0], o1[1]); o2w[w] = cvtpk(o2[0], o2[1]);
                }
                const u32x4 r1a = {o1w[0], o1w[1], o1w[2], o1w[3]}, r1b = {o1w[4], o1w[5], o1w[6], o1w[7]}, r2a = {o2w[0], o2w[1], o2w[2], o2w[3]}, r2b = {o2w[4], o2w[5], o2w[6], o2w[7]};
                {
                    bf16_t* dst = qd + (g < 16 ? g * 64 : 2048 + (g - 16) * 64);
                    *(u32x4*)(dst + 16 * hp) = r1a; *(u32x4*)(dst + 16 * hp + 8) = r1b; *(u32x4*)(dst + 32 + 16 * hp) = r2a; *(u32x4*)(dst + 32 + 16 * hp + 8) = r2b;
                }
            }
            {
                const float pos = (lane < 32) ? prow : pcol;
                const float f = __builtin_amdgcn_exp2f(-L2T * (float)(2 * (lane & 31)) * (1.f / 64.f));
                float sn = 0.f, cs = 1.f; if (lat) { const float ang = pos * f; sn = __sinf(ang); cs = __cosf(ang); }
#pragma unroll
                for (int g = 0; g < 10; ++g) {
                    bf16_t* p = qkv + 3072 + g * 128;
                    const float x1 = bf2f(p[lane]), x2 = bf2f(p[64 + lane]);
                    const float ss = wave_sum(x1 * x1 + x2 * x2);
                    const float r = rsqrtf(ss * (1.f / 128.f) + EPS);
                    const float* gn = (g < 8) ? a.in[I_GQ] : a.in[I_GK];
                    const float y1 = x1 * r * gn[lane], y2 = x2 * r * gn[64 + lane];
                    const float qsg = (g < 8) ? 0.12751743082459868f : 1.f;
                    const float o1 = (y1 * cs - y2 * sn) * qsg, o2 = (y2 * cs + y1 * sn) * qsg;
                    const unsigned w1 = cvtpk(o1, o1), w2 = cvtpk(o2, o2);
                    bf16_t* d = qd + (g < 8 ? 1024 + g * 128 : 3072 + (g - 8) * 128); d[lane] = (bf16_t)(w1 & 0xffffu); d[64 + lane] = (bf16_t)(w2 & 0xffffu);
                }
            }
        }
        SEAM(3);
    }

    if (IN(4)) { const int lane = lane_fresh(), tid = wave * 64 + lane;
        float lam;
        { int ln = lane_fresh();
          const float p1 = a.in[I_LQ1][ln] * a.in[I_LK1][ln], p2 = a.in[I_LQ2][ln] * a.in[I_LK2][ln];
          lam = __expf(wave_sum_bp(p1)) - __expf(wave_sum_bp(p2)) + 0.2f; }
        const int vbx = (G % 8 == 0) ? (bx % 8) * (G / 8) + bx / 8 : bx;
        for (int u = vbx; u < 784; u += G) {
            const bool isctx = u >= 768; const bool big = u < 256;
            const int uu = isctx ? u - 768 : (big ? u : u - 256);
            const bool diff = big || (isctx && uu < 8);
            const int h = isctx ? (uu & 7) : (big ? (uu >> 5) : ((uu >> 6) & 7)), qb = isctx ? 0 : (big ? (uu & 31) : (uu & 63));
            const int row0 = isctx ? 0 : CTXL + qb * (big ? 512 : 256), seq = isctx ? CTXL : T;
            const int nm = diff ? 2 : 1;
            for (int m = 0; m < nm; ++m) {
                const int hc = diff ? (2 * h + m) * 128 : 2048 + h * 128;
                const bf16_t* Qb = QD + (size_t)row0 * NQD + (diff ? (2 * h + m) * 64 : 1024 + h * 128);
                const bf16_t* Kh = QD + (diff ? 2048 + (2 * h + m) * 64 : 3072 + (h >> 2) * 128);
                const bf16_t* Vh = QKV + (diff ? 2048 + h * 128 : 4352 + (h >> 2) * 128);
                if (big) att::attn_diff512(Qb, Kh, Vh, OF + (size_t)row0 * NOF + hc, seq, (char*)lds_raw, wave);
                else if (diff) att::attn_dense_body2<64>(Qb, Kh, Vh, OF + (size_t)row0 * NOF + hc, seq, (char*)lds_raw, wave);
                else att::attn_dense_body2<128>(Qb, Kh, Vh, (float*)(AO + (size_t)row0 * D + 1024 + h * 128), seq, (char*)lds_raw, wave);
                __syncthreads();
            }
            if (!diff) continue;
            VM_WAIT();
            int lane = lane_fresh();
            const float g0 = a.in[I_GSUBLN][2 * lane] * 0.8f, g1 = a.in[I_GSUBLN][2 * lane + 1] * 0.8f;
            const int nr = big ? 64 : 32;
            for (int rr = 0; rr < nr; ++rr) {
                const int row = row0 + wave * nr + rr;
                const f32x2 o1 = *(const f32x2*)(OF + (size_t)row * NOF + (2 * h) * 128 + 2 * lane), o2 = *(const f32x2*)(OF + (size_t)row * NOF + (2 * h + 1) * 128 + 2 * lane);
                const float v0 = o1.x - lam * o2.x, v1 = o1.y - lam * o2.y;
                const float rn = rsqrtf(wave_sum_bp(v0 * v0 + v1 * v1) * (1.f / 128.f) + EPS);
                *(unsigned*)(AO + (size_t)row * D + h * 128 + 2 * lane) = cvtpk(v0 * rn * g0, v1 * rn * g1);
            }
        }
        SEAM(4);
    }

    if (IN(5)) { const int lane = lane_fresh(), tid = wave * 64 + lane;
        const int GE = gemm_wgs((T / 256) * (D / 256), G);
        if (bx < GE) {
            pg8::Gemm g{AO, WOUT0, D, nullptr, 1, 0}; pg8::StaticOrder S; S.init(T / 256, D / 256, GE, bx);
            pg8::EpiBf16 E{Y, D, 1 << 30, nullptr};
            pg8::gemm_phase<pg8::EpiBf16, pg8::StaticOrder>(lds, g, S, E, wave);
            if (tid == 0) __hip_atomic_fetch_add(ctl + CW_DONE5, 1u, __ATOMIC_RELAXED, __HIP_MEMORY_SCOPE_AGENT);
        } else conv_dyn(ctl + CW_C0, NE * 3 * 2048, 0, a.in[I_WGATE0], a.in[I_WUP0], a.in[I_WDOWN0], WGU, WD, ctl + CW_DONE5, (unsigned)GE, (LAS float*)(lds + wave * 16384), lane);
        SEAM(5);
    }

#define PHASE_POSTMIX(LAYER, YBUF, T0, G_POST, G_PREFFN, W_ROUTER) do { \
        LAS float* wt = (LAS float*)lds;                                    \
        _Pragma("unroll") for (int rb = 0; rb < 2; ++rb) { f32x4 wv[8]; \
            _Pragma("unroll") for (int r = 0; r < 8; ++r) wv[r] = *(const f32x4*)((W_ROUTER) + 4 * (tid + NTHREADS * (rb * 8 + r))); \
            _Pragma("unroll") for (int r = 0; r < 8; ++r) { const int i4 = tid + NTHREADS * (rb * 8 + r); const int k = i4 >> 2, e0 = (i4 & 3) * 4; \
                wt[(e0 + 0) * D + k] = wv[r].x; wt[(e0 + 1) * D + k] = wv[r].y; wt[(e0 + 2) * D + k] = wv[r].z; wt[(e0 + 3) * D + k] = wv[r].w; } } \
        __syncthreads(); \
          \
        int cur_set = -1; f32x4 pg[8], ps[8], sh[8]; \
        for (int t = (T0) + gw; t < T; t += NGW) { \
            const int set = t < CTXL ? 1 : 0; \
            if (set != cur_set) { cur_set = set; const float* md = MOD + (size_t)((LAYER) * 2 + set) * 12288; \
                _Pragma("unroll") for (int j = 0; j < 8; ++j) { const int c = 4 * lane + 256 * j; \
                    pg[j] = *(const f32x4*)((G_POST) + c) * *(const f32x4*)(md + 2 * D + c); ps[j] = *(const f32x4*)((G_PREFFN) + c) * (*(const f32x4*)(md + 4 * D + c) + 1.f); sh[j] = *(const f32x4*)(md + 3 * D + c); } } \
            u32x2 yr[8]; Row x; \
            { const bf16_t* yp = (YBUF) + (size_t)t * D + 4 * lane; _Pragma("unroll") for (int j = 0; j < 8; ++j) yr[j] = *(const u32x2*)(yp + 256 * j); } \
            if ((LAYER) == 0) row_load(x, t < CTXL ? a.in[I_CTX] + (size_t)t * D : a.in[I_X] + (size_t)(t - CTXL) * D, lane); \
            else { u32x2 xr[8]; const bf16_t* xp = XC2 + (size_t)t * D + 4 * lane; _Pragma("unroll") for (int j = 0; j < 8; ++j) xr[j] = *(const u32x2*)(xp + 256 * j); \
                   __builtin_amdgcn_sched_barrier(0); \
                   _Pragma("unroll") for (int j = 0; j < 8; ++j) x.v[j] = (f32x4){bflo(xr[j].x), bfhi(xr[j].x), bflo(xr[j].y), bfhi(xr[j].y)}; } \
            __builtin_amdgcn_sched_barrier(0); \
            Row y; _Pragma("unroll") for (int j = 0; j < 8; ++j) y.v[j] = (f32x4){bflo(yr[j].x), bfhi(yr[j].x), bflo(yr[j].y), bfhi(yr[j].y)}; \
            const float ry = rsqrtf(row_ss(y) * (1.f / D) + EPS); \
            _Pragma("unroll") for (int j = 0; j < 8; ++j) x.v[j] = x.v[j] + pg[j] * (y.v[j] * ry); \
            row_store_bf16(x, XC + (size_t)t * D, lane); \
            { const float r = rsqrtf(row_ss(x) * (1.f / D) + EPS); _Pragma("unroll") for (int j = 0; j < 8; ++j) x.v[j] = (x.v[j] * r) * ps[j] + sh[j]; } \
            row_store_bf16(x, XN + (size_t)t * D, lane); \
            float lg[NE]; \
            {     \
                const LAS float* wl = wt + 4 * lane; f32x4 wA[4], wB[4]; \
                _Pragma("unroll") for (int j = 0; j < 4; ++j) wA[j] = *(const LAS f32x4*)(wl + 256 * j); \
                _Pragma("unroll") for (int e = 0; e < NE; ++e) { float s = 0.f; \
                    _Pragma("unroll") for (int j = 0; j < 4; ++j) wB[j] = *(const LAS f32x4*)(wl + e * D + 256 * (4 + j)); \
                    __builtin_amdgcn_sched_barrier(0); \
                    _Pragma("unroll") for (int j = 0; j < 4; ++j) s += (x.v[j].x * wA[j].x + x.v[j].y * wA[j].y) + (x.v[j].z * wA[j].z + x.v[j].w * wA[j].w); \
                    if (e + 1 < NE) { _Pragma("unroll") for (int j = 0; j < 4; ++j) wA[j] = *(const LAS f32x4*)(wl + (e + 1) * D + 256 * j); } \
                    __builtin_amdgcn_sched_barrier(0); \
                    _Pragma("unroll") for (int j = 0; j < 4; ++j) s += (x.v[4 + j].x * wB[j].x + x.v[4 + j].y * wB[j].y) + (x.v[4 + j].z * wB[j].z + x.v[4 + j].w * wB[j].w); \
                    lg[e] = s; } \
                _Pragma("unroll") for (int e = 0; e < NE; ++e) lg[e] = wave_sum(lg[e]); } \
            float mx = lg[0]; _Pragma("unroll") for (int e = 1; e < NE; ++e) mx = fmaxf(mx, lg[e]); \
            float sm = 0.f; _Pragma("unroll") for (int e = 0; e < NE; ++e) { lg[e] = __expf(lg[e] - mx); sm += lg[e]; } \
            const float inv = 1.f / sm; float mine = 0.f; \
            _Pragma("unroll") for (int e = 0; e < NE; ++e) mine = (lane == e) ? lg[e] * inv : mine; \
            if (lane < NE) AFFT[(size_t)lane * T + t] = mine; \
        } \
        __syncthreads(); \
    } while (0)

#define PHASE_TOPK(NTASK) do { \
        LAS unsigned* shc = (LAS unsigned*)lds;                         \
        for (int task = bx; task < (NTASK); task += G) { \
            const int e = task & 15, set = task >> 4; \
            const int n = set ? CTXL : SEQ, cap = set ? 32 : 2048, tbase = set ? 0 : CTXL, slot0 = set ? 2048 : 0; \
            const bool own = 32 * tid < n; \
            unsigned key[32]; \
            { const float* src = AFFT + (size_t)e * T + tbase + 32 * tid; \
              _Pragma("unroll") for (int j8 = 0; j8 < 8; ++j8) { f32x4 v = (f32x4){0.f, 0.f, 0.f, 0.f}; if (own) v = *(const f32x4*)(src + 4 * j8); \
                  key[4 * j8] = __float_as_uint(v.x); key[4 * j8 + 1] = __float_as_uint(v.y); key[4 * j8 + 2] = __float_as_uint(v.z); key[4 * j8 + 3] = __float_as_uint(v.w); } } \
            unsigned thr = 0u; \
            for (int bit = 30; bit >= 0; --bit) { \
                const unsigned cand = thr | (1u << bit); int cnt = 0; \
                _Pragma("unroll") for (int j = 0; j < 32; ++j) cnt += (key[j] >= cand) ? 1 : 0; \
                cnt = wave_sum_i(cnt); \
                if (lane == 0) shc[(bit & 1) * 8 + wave] = (unsigned)cnt; \
                __syncthreads(); \
                unsigned tot = 0u; _Pragma("unroll") for (int w2 = 0; w2 < NWAVES; ++w2) tot += shc[(bit & 1) * 8 + w2]; \
                if (tot >= (unsigned)cap) thr = cand; \
            } \
            int gtc = 0, eqc = 0; \
            _Pragma("unroll") for (int j = 0; j < 32; ++j) { gtc += (key[j] > thr) ? 1 : 0; eqc += (key[j] == thr) ? 1 : 0; } \
              \
            int inc = eqc, gsum = gtc; \
            _Pragma("unroll") for (int o = 1; o < 64; o <<= 1) { const int v = __shfl_up(inc, o); if (lane >= o) inc += v; gsum += __shfl_xor(gsum, o); } \
            __syncthreads(); \
            if (lane == 63) shc[16 + wave] = (unsigned)inc; if (lane == 0) shc[24 + wave] = (unsigned)gsum; \
            __syncthreads(); \
            int ex_eq = inc - eqc, tot_gt = 0; \
            _Pragma("unroll") for (int w2 = 0; w2 < NWAVES; ++w2) { if (w2 < wave) ex_eq += (int)shc[16 + w2]; tot_gt += (int)shc[24 + w2]; } \
            const int krem = cap - tot_gt;                              \
            int allow = krem - ex_eq; allow = allow < 0 ? 0 : (allow > eqc ? eqc : allow); \
            const int takec = gtc + allow; \
            int inc2 = takec; \
            _Pragma("unroll") for (int o = 1; o < 64; o <<= 1) { const int v = __shfl_up(inc2, o); if (lane >= o) inc2 += v; } \
            if (lane == 63) shc[32 + wave] = (unsigned)inc2; \
            __syncthreads(); \
            int slot = slot0 + inc2 - takec; \
            _Pragma("unroll") for (int w2 = 0; w2 < NWAVES; ++w2) { if (w2 < wave) slot += (int)shc[32 + w2]; } \
            if (own) { int eqs = 0; int invv[32]; \
                _Pragma("unroll") for (int j = 0; j < 32; ++j) { const unsigned k = key[j]; const bool eq = k == thr; const bool take = k > thr || (eq && eqs < allow); eqs += eq ? 1 : 0; \
                    invv[j] = take ? slot : -1; \
                    if (take) { IDX[e * IDXS + slot] = tbase + 32 * tid + j; GATEV[e * IDXS + slot] = __uint_as_float(k); ++slot; } } \
                int* ip = INV + (size_t)e * T + tbase + 32 * tid; \
                _Pragma("unroll") for (int j4 = 0; j4 < 8; ++j4) *(u32x4*)(ip + 4 * j4) = (u32x4){(unsigned)invv[4 * j4], (unsigned)invv[4 * j4 + 1], (unsigned)invv[4 * j4 + 2], (unsigned)invv[4 * j4 + 3]}; } \
            __syncthreads(); \
        } \
    } while (0)

#define PHASE_GATHER(RPE, NVALID) do { \
        for (int r = gw; r < NE * (RPE); r += NGW) { \
            const int e = r / (RPE), slot = r - e * (RPE); \
            u32x4 v0 = {0u, 0u, 0u, 0u}, v1 = v0, v2 = v0, v3 = v0; \
            if (slot < (NVALID)) { const bf16_t* s = XN + (size_t)IDX[e * IDXS + slot] * D; \
                v0 = *(const u32x4*)(s + 8 * lane); v1 = *(const u32x4*)(s + 512 + 8 * lane); v2 = *(const u32x4*)(s + 1024 + 8 * lane); v3 = *(const u32x4*)(s + 1536 + 8 * lane); } \
            bf16_t* dd = XE + (size_t)r * D; \
            *(u32x4*)(dd + 8 * lane) = v0; *(u32x4*)(dd + 512 + 8 * lane) = v1; *(u32x4*)(dd + 1024 + 8 * lane) = v2; *(u32x4*)(dd + 1536 + 8 * lane) = v3; \
        } \
    } while (0)

#define COMBINE_LOOP(LAYER, RPE, G_POSTFFN, T0, BODY) do { \
        int cur_set = -1; f32x4 pq[8]; \
        int slot_n = -1; u32x2 xr_n[8]; \
        { const int t = (T0) + gw; if (t < T) { slot_n = lane < NE ? INV[(size_t)lane * T + t] : -1; \
            const bf16_t* xp = XC + (size_t)t * D + 4 * lane; _Pragma("unroll") for (int j = 0; j < 8; ++j) xr_n[j] = *(const u32x2*)(xp + 256 * j); } } \
        for (int t = (T0) + gw; t < T; t += NGW) { \
            const int slotv = slot_n; u32x2 xr[8]; _Pragma("unroll") for (int j = 0; j < 8; ++j) xr[j] = xr_n[j]; \
            { const int t2 = t + NGW; if (t2 < T) { slot_n = lane < NE ? INV[(size_t)lane * T + t2] : -1; \
                const bf16_t* xp = XC + (size_t)t2 * D + 4 * lane; _Pragma("unroll") for (int j = 0; j < 8; ++j) xr_n[j] = *(const u32x2*)(xp + 256 * j); } } \
            const int set_ = t < CTXL ? 1 : 0; \
            if (set_ != cur_set) { cur_set = set_; const float* md_ = MOD + (size_t)((LAYER) * 2 + set_) * 12288; \
                _Pragma("unroll") for (int j = 0; j < 8; ++j) { const int c = 4 * lane + 256 * j; pq[j] = *(const f32x4*)((G_POSTFFN) + c) * *(const f32x4*)(md_ + 5 * D + c); } } \
            Row mo; _Pragma("unroll") for (int j = 0; j < 8; ++j) mo.v[j] = (f32x4){0.f, 0.f, 0.f, 0.f}; \
            unsigned mask = (unsigned)__ballot(slotv >= 0) & 0xffffu; \
            while (mask) { \
                const int e0 = __builtin_ctz(mask); mask &= mask - 1u; const bool two = mask != 0u; const int e1 = two ? __builtin_ctz(mask) : e0; mask &= mask - 1u; \
                const int s0 = __builtin_amdgcn_readlane(slotv, e0), s1 = __builtin_amdgcn_readlane(slotv, e1); \
                const bf16_t* y0 = YE + ((size_t)e0 * (RPE) + s0) * D + 4 * lane; const bf16_t* y1 = YE + ((size_t)e1 * (RPE) + s1) * D + 4 * lane; \
                u32x2 w0[8], w1[8]; \
                _Pragma("unroll") for (int j = 0; j < 8; ++j) w0[j] = *(const u32x2*)(y0 + 256 * j); \
                _Pragma("unroll") for (int j = 0; j < 8; ++j) w1[j] = *(const u32x2*)(y1 + 256 * j); \
                __builtin_amdgcn_sched_barrier(0); \
                _Pragma("unroll") for (int j = 0; j < 8; ++j) { mo.v[j].x += bflo(w0[j].x); mo.v[j].y += bfhi(w0[j].x); mo.v[j].z += bflo(w0[j].y); mo.v[j].w += bfhi(w0[j].y); } \
                if (two) { _Pragma("unroll") for (int j = 0; j < 8; ++j) { mo.v[j].x += bflo(w1[j].x); mo.v[j].y += bfhi(w1[j].x); mo.v[j].z += bflo(w1[j].y); mo.v[j].w += bfhi(w1[j].y); } } \
            } \
            const float rm = rsqrtf(row_ss(mo) * (1.f / D) + EPS); \
            Row x; _Pragma("unroll") for (int j = 0; j < 8; ++j) { const f32x4 xv = {bflo(xr[j].x), bfhi(xr[j].x), bflo(xr[j].y), bfhi(xr[j].y)}; x.v[j] = xv + pq[j] * (mo.v[j] * rm); } \
            BODY \
        } \
    } while (0)

    if (IN(6)) { const int lane = lane_fresh(), tid = wave * 64 + lane; PHASE_POSTMIX(0, Y, 0, a.in[I_GPOSTMIX0], a.in[I_GPREFFN0], a.in[I_WROUTER0]);
        conv_dyn(ctl + CW_C0, NE * 3 * 2048, 0, a.in[I_WGATE0], a.in[I_WUP0], a.in[I_WDOWN0], WGU, WD, nullptr, 0u, (LAS float*)(lds + wave * 16384), lane);
        SEAM(6); }
    if (IN(7)) { const int lane = lane_fresh(), tid = wave * 64 + lane; PHASE_TOPK(32); SEAM(7); }
    if (IN(9)) { const int lane = lane_fresh(), tid = wave * 64 + lane;
        pg8::Gemm g{XN, WGU, D, IDX, 2304, 2080}; pg8::GroupedOrder S; S.init(9, 16, G, bx);
        pg8::EpiSwiGLU E{HID};
        pg8::gemm_phase<pg8::EpiSwiGLU, pg8::GroupedOrder, true>(lds, g, S, E, wave);
        SEAM(9);
    }
    if (IN(10)) { const int lane = lane_fresh(), tid = wave * 64 + lane;
        const int GE = gemm_wgs(NE * 9 * 8, G);
        if (bx < GE) {
            pg8::Gemm g{HID, WD, D, nullptr, 1, 0}; pg8::GroupedOrder S; S.init(9, 8, GE, bx);
            pg8::EpiDown E{YE, GATEV, 2304};
            pg8::gemm_phase<pg8::EpiDown, pg8::GroupedOrder>(lds, g, S, E, wave);
            if (tid == 0) __hip_atomic_fetch_add(ctl + CW_DONE10, 1u, __ATOMIC_RELAXED, __HIP_MEMORY_SCOPE_AGENT);
        } else conv_dyn(ctl + CW_C1A, NE * 2 * 2048, 1, a.in[I_WGATE1], a.in[I_WUP1], a.in[I_WDOWN1], WGU, WD, ctl + CW_DONE10, (unsigned)GE, (LAS float*)(lds + wave * 16384), lane);
        SEAM(10);
    }
    if (IN(11)) { const int lane = lane_fresh(), tid = wave * 64 + lane;
        int nset = -1; f32x4 ps[8], sh[8];
        COMBINE_LOOP(0, 2304, a.in[I_GPOSTFFN0], 0, {
            row_store_bf16(x, XC2 + (size_t)t * D, lane);
            if (set_ != nset) { nset = set_; const float* md = MOD + (size_t)(1 * 2 + set_) * 12288;
_Pragma("unroll")
                for (int j = 0; j < 8; ++j) { const int c = 4 * lane + 256 * j; ps[j] = *(const f32x4*)(a.in[I_GPREMIX1] + c) * (*(const f32x4*)(md + 1 * D + c) + 1.f); sh[j] = *(const f32x4*)(md + c); } }
            { const float r = rsqrtf(row_ss(x) * (1.f / D) + EPS);
_Pragma("unroll")
              for (int j = 0; j < 8; ++j) x.v[j] = (x.v[j] * r) * ps[j] + sh[j]; }
            row_store_bf16(x, XN + (size_t)t * D, lane); });
        SEAM(11);
    }

    if (IN(12)) { const int lane = lane_fresh(), tid = wave * 64 + lane;
        const int GE = gemm_wgs((T / 256) * (NPROJ_PAD / 256), G);
        if (bx < GE) {
            pg8::Gemm g{XN, WIN1, D, nullptr, 1, 0}; pg8::StaticOrder S; S.init(T / 256, NPROJ_PAD / 256, GE, bx);
            pg8::EpiBf16 E{PROJ, NPROJ, 32, GATES};
            pg8::gemm_phase<pg8::EpiBf16, pg8::StaticOrder>(lds, g, S, E, wave);
            if (tid == 0) __hip_atomic_fetch_add(ctl + CW_DONE12, 1u, __ATOMIC_RELAXED, __HIP_MEMORY_SCOPE_AGENT);
        } else {
            conv_dyn(ctl + CW_C1A, NE * 2 * 2048, 1, a.in[I_WGATE1], a.in[I_WUP1], a.in[I_WDOWN1], WGU, WD, ctl + CW_DONE12, (unsigned)GE, (LAS float*)(lds + wave * 16384), lane);
            conv_dyn(ctl + CW_C1B, NE * 2048, 2, a.in[I_WGATE1], a.in[I_WUP1], a.in[I_WDOWN1], WGU, WD, ctl + CW_DONE12, (unsigned)GE, (LAS float*)(lds + wave * 16384), lane);
        }
        SEAM(12);
    }

    if (IN(13)) { const int lane = lane_fresh(), tid = wave * 64 + lane;
        {
            const int c0 = tid * 8;
            const float* wc = a.in[I_WCONV1] + c0; const float* bc = a.in[I_BCONV1] + c0;
            const f32x4 wma = *(const f32x4*)(wc), wmb = *(const f32x4*)(wc + 4), w0a = *(const f32x4*)(wc + 4096), w0b = *(const f32x4*)(wc + 4100), wpa = *(const f32x4*)(wc + 8192), wpb = *(const f32x4*)(wc + 8196);
            const f32x4 bca = *(const f32x4*)(bc), bcb = *(const f32x4*)(bc + 4);
            const float wm[8] = {wma.x, wma.y, wma.z, wma.w, wmb.x, wmb.y, wmb.z, wmb.w}, w0[8] = {w0a.x, w0a.y, w0a.z, w0a.w, w0b.x, w0b.y, w0b.z, w0b.w};
            const float wp[8] = {wpa.x, wpa.y, wpa.z, wpa.w, wpb.x, wpb.y, wpb.z, wpb.w}, bb[8] = {bca.x, bca.y, bca.z, bca.w, bcb.x, bcb.y, bcb.z, bcb.w};
            const float osc = c0 >= 2048 ? 0.0625f : 1.f;
            bf16_t* dst = c0 < 2048 ? QC + c0 : KC + (c0 - 2048);
            const bf16_t* src = PROJ + c0;
            const int TPW = (T + G - 1) / G; const int t0 = bx * TPW, t1 = (t0 + TPW < T) ? t0 + TPW : T;
            const u32x4 z = {0u, 0u, 0u, 0u};
            u32x4 prev = z, cur = z;
            if (t0 < t1) { if (t0 > 0) prev = *(const u32x4*)(src + (size_t)(t0 - 1) * NPROJ); cur = *(const u32x4*)(src + (size_t)t0 * NPROJ); }
            u32x4 nn[8];
#pragma unroll
            for (int i = 0; i < 8; ++i) { const int row = t0 + 1 + i; nn[i] = (t0 < t1 && row <= t1 && row < T) ? *(const u32x4*)(src + (size_t)row * NPROJ) : z; }
            for (int t = t0; t < t1; t += 8) {
                u32x4 nx[8];
#pragma unroll
                for (int i = 0; i < 8; ++i) nx[i] = nn[i];
                if (t + 8 < t1) {
#pragma unroll
                    for (int i = 0; i < 8; ++i) { const int row = t + 9 + i; nn[i] = (row <= t1 && row < T) ? *(const u32x4*)(src + (size_t)row * NPROJ) : z; }
                }
                __builtin_amdgcn_sched_barrier(0);
#pragma unroll
                for (int i = 0; i < 8; ++i) { const int tt = t + i;
                    if (tt < t1) {
                        const u32x4 xm = (tt == 0 || tt == CTXL) ? z : prev, xp = (tt + 1 == CTXL || tt + 1 == T) ? z : nx[i];
                        const unsigned am[4] = {xm.x, xm.y, xm.z, xm.w}, a0[4] = {cur.x, cur.y, cur.z, cur.w}, ap[4] = {xp.x, xp.y, xp.z, xp.w};
                        float yv[8];
#pragma unroll
                        for (int j = 0; j < 8; ++j) { const int w = j >> 1; const bool hh = j & 1;
                            const float vm = hh ? bfhi(am[w]) : bflo(am[w]), v0 = hh ? bfhi(a0[w]) : bflo(a0[w]), vp = hh ? bfhi(ap[w]) : bflo(ap[w]);
                            float y = wm[j] * vm + w0[j] * v0 + wp[j] * vp + bb[j];
                            y = y * sigmoidf_(y); yv[j] = y * osc; }
                        u32x4 o; o.x = cvtpk(yv[0], yv[1]); o.y = cvtpk(yv[2], yv[3]); o.z = cvtpk(yv[4], yv[5]); o.w = cvtpk(yv[6], yv[7]);
                        *(u32x4*)(dst + (size_t)tt * D) = o;
                        prev = cur; cur = nx[i];
                    } }
            }
        }
        const float* bg = a.in[I_BGATE1];
        for (int it = gw; it < 16 * NCH; it += NGW) {
            const int hd = it / NCH, i = it % NCH, d = hd >> 3, h = hd & 7;
            const int cc = d ? (i < 2 ? 1 - i : 131 - i) : i; const int base = cc * 128;
            const int s0 = 2 * lane, s1 = 2 * lane + 1;
            const int r0 = base + (d ? 127 - s0 : s0), r1 = base + (d ? 127 - s1 : s1);
            const float ig0 = GATES[(size_t)r0 * 32 + d * 16 + h] + bg[d * 16 + h], ig1 = GATES[(size_t)r1 * 32 + d * 16 + h] + bg[d * 16 + h];
            const float f0 = GATES[(size_t)r0 * 32 + d * 16 + 8 + h] + bg[d * 16 + 8 + h], f1 = GATES[(size_t)r1 * 32 + d * 16 + 8 + h] + bg[d * 16 + 8 + h];
            const float lf0 = fminf(f0, 0.f) - log1pf(__expf(-fabsf(f0))), lf1 = fminf(f1, 0.f) - log1pf(__expf(-fabsf(f1)));
            const float c1 = lf0 + lf1; float inc = c1;
#pragma unroll
            for (int ofs = 1; ofs < 64; ofs <<= 1) { const float v = __shfl_up(inc, ofs); if (lane >= ofs) inc += v; }
            const float ex = inc - c1;
            float* gbp = GB + (size_t)it * 128; float* gip = GI + (size_t)it * 128;
            *(f32x2*)(gbp + s0) = (f32x2){ex + lf0, ex + c1}; *(f32x2*)(gip + s0) = (f32x2){ig0, ig1};
        }
        conv_dyn(ctl + CW_C1A, NE * 2 * 2048, 1, a.in[I_WGATE1], a.in[I_WUP1], a.in[I_WDOWN1], WGU, WD, nullptr, 0u, (LAS float*)(lds + wave * 16384), lane);
        conv_dyn(ctl + CW_C1B, NE * 2048, 2, a.in[I_WGATE1], a.in[I_WUP1], a.in[I_WDOWN1], WGU, WD, nullptr, 0u, (LAS float*)(lds + wave * 16384), lane);
        SEAM(13);
    }

    if (IN(14)) { const int lane = lane_fresh(), tid = wave * 64 + lane;
        LAS char* tiles = (LAS char*)lds;
        LAS float* wbuf = (LAS float*)(lds + 131072);
        LAS float* nred = (LAS float*)(lds + 131072 + 2048);
#define M1_BAR() do { asm volatile("s_waitcnt lgkmcnt(0)" ::: "memory"); __builtin_amdgcn_s_barrier(); asm volatile("" ::: "memory"); } while (0)
        for (int vb_ = bx; vb_ < 256; vb_ += G) {
            const int h = vb_ & 7, lx = vb_ >> 3, d = lx >> 4, tile = lx & 15, idk = tile >> 2, idv = tile & 3, hd = d * 8 + h;
            __syncthreads();
            if (wave < 4) {
                const int r32 = lane & 31, hi5 = lane >> 5, tm = wave & 1, tn = wave >> 1;
                f32x16 acc = f32x16{};
                float nacc = 0.f, decay_prev = 0.f;
                float bl_next = GB[((size_t)hd * NCH + 0) * 128 + 127];
                float gb_n = 0.f, gi_n = 0.f, bl_n = 0.f;
                if (tid < 128) { const size_t g0 = ((size_t)hd * NCH + 0) * 128; wbuf[tid] = __expf(GB[g0 + 127] - GB[g0 + tid] + GI[g0 + tid]);
                                 const size_t g1 = g0 + 128; gb_n = GB[g1 + tid]; gi_n = GI[g1 + tid]; bl_n = GB[g1 + 127]; }
                for (int i = 0; i < NCH; ++i) {
                    const int cur = i & 3;
                    const float decay = __expf(bl_next);
                    if (i + 1 < NCH) bl_next = GB[((size_t)hd * NCH + i + 1) * 128 + 127];
                    M1_BAR();
                    if (tid < 128) { if (i + 1 < NCH) wbuf[((i + 1) & 3) * 128 + tid] = __expf(bl_n - gb_n + gi_n);
                                     if (i + 2 < NCH) { const size_t g2 = ((size_t)hd * NCH + i + 2) * 128; gb_n = GB[g2 + tid]; gi_n = GI[g2 + tid]; bl_n = GB[g2 + 127]; } }
                    if (idv == 0 && wave == 0) {
                        if (i > 0) { const LAS float* nr = nred + ((i - 1) & 1) * 256;
                            nacc = decay_prev * nacc + ((nr[lane] + nr[64 + lane]) + (nr[128 + lane] + nr[192 + lane])); }
                        NST[((size_t)hd * NCH + i) * 256 + idk * 64 + lane] = nacc;
                    }
                    decay_prev = decay;
                    if (i >= 2) { bf16_t* cp = CST + (((size_t)hd * NCH + i) * 256 + idk * 64 + 32 * tm) * 256 + idv * 64 + 32 * tn + r32;
#pragma unroll
                        for (int r = 0; r < 16; ++r) cp[(size_t)crow(r, hi5) * 256] = (bf16_t)(cvtpk(acc[r], acc[r]) & 0xffffu); }
#pragma unroll
                    for (int r = 0; r < 16; ++r) acc[r] *= decay;
#pragma unroll
                    for (int kh = 0; kh < 2; ++kh) {
                        const int vbase = (int)(uintptr_t)(tiles + cur * 32768 + kh * 16384) + att::v_rd_base(lane);
                        bf16x8 A[4], B[4];
                        if (tm == 0) { A[0] = att::vfragc<0, 0>(vbase); A[1] = att::vfragc<0, 1>(vbase); A[2] = att::vfragc<0, 2>(vbase); A[3] = att::vfragc<0, 3>(vbase); }
                        else         { A[0] = att::vfragc<1, 0>(vbase); A[1] = att::vfragc<1, 1>(vbase); A[2] = att::vfragc<1, 2>(vbase); A[3] = att::vfragc<1, 3>(vbase); }
                        if (tn == 0) { B[0] = att::vfragc<2, 0>(vbase); B[1] = att::vfragc<2, 1>(vbase); B[2] = att::vfragc<2, 2>(vbase); B[3] = att::vfragc<2, 3>(vbase); }
                        else         { B[0] = att::vfragc<3, 0>(vbase); B[1] = att::vfragc<3, 1>(vbase); B[2] = att::vfragc<3, 2>(vbase); B[3] = att::vfragc<3, 3>(vbase); }
#pragma unroll
                        for (int ks = 0; ks < 4; ++ks) {
                            const LAS float* wp = wbuf + cur * 128 + 64 * kh + 16 * ks + 8 * hi5;
                            const f32x4 wa = *(const LAS f32x4*)wp, wb = *(const LAS f32x4*)(wp + 4);
                            u32x4 aw = *reinterpret_cast<u32x4*>(&A[ks]);
                            aw.x = cvtpk_s(bflo(aw.x) * wa.x, bfhi(aw.x) * wa.y); aw.y = cvtpk_s(bflo(aw.y) * wa.z, bfhi(aw.y) * wa.w);
                            aw.z = cvtpk_s(bflo(aw.z) * wb.x, bfhi(aw.z) * wb.y); aw.w = cvtpk_s(bflo(aw.w) * wb.z, bfhi(aw.w) * wb.w);
                            acc = __builtin_amdgcn_mfma_f32_32x32x16_bf16(*reinterpret_cast<bf16x8*>(&aw), B[ks], acc, 0, 0, 0);
                        }
                    }
                }
            } else {
                const int lw = wave - 4, lt = tid - 256;
                int ps_[8]; const char* pb_[8]; int pp_[8];
#pragma unroll
                for (int j_ = 0; j_ < 8; ++j_) { const int P_ = (lw * 8 + j_) * 64 + lane; const int th_ = P_ >> 10; const int o_ = (P_ & 1023) * 16; const int sub_ = o_ >> 9, wi_ = o_ & 511;
                    const int kk_ = ((sub_ >> 2) << 3) | (wi_ >> 6); const int k_ = (kk_ & ~0xC) | ((kk_ & 4) << 1) | ((kk_ & 8) >> 1); const int c_ = ((sub_ & 3) << 5) | ((wi_ & 63) >> 1);
                    ps_[j_] = 64 * th_ + k_;
                    pb_[j_] = (c_ < 64) ? (const char*)(KC + h * 256 + idk * 64 + c_) : (const char*)(PROJ + 4096 + h * 256 + idv * 64 + (c_ - 64));
                    pp_[j_] = (c_ < 64) ? D * 2 : NPROJ * 2; }
#define M1_DMA(i_) do { const int cc_ = d ? ((i_) < 2 ? 1 - (i_) : 131 - (i_)) : (i_); const int base_ = cc_ * 128; \
                    _Pragma("unroll") for (int j_ = 0; j_ < 8; ++j_) { const int row_ = base_ + (d ? 127 - ps_[j_] : ps_[j_]); \
                        __builtin_amdgcn_global_load_lds((const unsigned*)(pb_[j_] + (size_t)row_ * pp_[j_]), (LAS unsigned*)(lds + ((i_) & 3) * 32768 + (lw * 8 + j_) * 1024), 16, 0, 0); } } while (0)
                M1_DMA(0); M1_DMA(1); M1_DMA(2);
                for (int i = 0; i < NCH; ++i) {
                    const int cur = i & 3;
                    if (i + 2 < NCH) asm volatile("s_waitcnt vmcnt(16)" ::: "memory"); else if (i + 1 < NCH) asm volatile("s_waitcnt vmcnt(8)" ::: "memory"); else asm volatile("s_waitcnt vmcnt(0)" ::: "memory");
                    M1_BAR();
                    if (i + 3 < NCH) M1_DMA(i + 3);
                    if (idv == 0) {
                        const int dk = lt & 63, sg = lt >> 6; float sacc = 0.f;
#pragma unroll 8
                        for (int q = 0; q < 32; ++q) { const int sI = sg * 32 + q;
                            const LAS char* tb_ = tiles + cur * 32768 + (sI >> 6) * 16384;
                            const unsigned short kv = *(const LAS unsigned short*)(tb_ + att::v_st(sI & 63, dk & ~7) + (dk & 7) * 2);
                            sacc += wbuf[cur * 128 + sI] * bf2f(kv); }
                        nred[(i & 1) * 256 + sg * 64 + dk] = sacc;
                    }
                }
#undef M1_DMA
            }
        }
        __syncthreads();
#undef M1_BAR
        SEAM(14);
    }

    if (IN(15)) { const int lane = lane_fresh(), tid = wave * 64 + lane;
        const int tb = wave & 3, vh = wave >> 2;
        LAS float* aS = (LAS float*)(lds + 131072);
        LAS float* nS = (LAS float*)(lds + 131072 + 512);
        LAS float* wsc = (LAS float*)(lds + 131072 + 2048) + wave * 64;
#define KSWZ512(row, colB) ((row) * 512 + ((colB) ^ (((row) & 15) << 4)))
#define M2_LBAR() do { asm volatile("s_waitcnt vmcnt(0) lgkmcnt(0)" ::: "memory"); __builtin_amdgcn_s_barrier(); asm volatile("" ::: "memory"); } while (0)
#define M2_VSLOT(j_, tl_, k_, c_) do { const int P_ = (wave * 4 + (j_)) * 64 + lane; tl_ = P_ >> 10; const int o_ = (P_ & 1023) * 16; const int sub_ = o_ >> 9, wi_ = o_ & 511; \
            const int kk_ = ((sub_ >> 2) << 3) | (wi_ >> 6); k_ = (kk_ & ~0xC) | ((kk_ & 4) << 1) | ((kk_ & 8) >> 1); c_ = ((sub_ & 3) << 5) | ((wi_ & 63) >> 1); } while (0)
#define M2_DMA_C(kt_, b_) do { _Pragma("unroll") for (int j_ = 0; j_ < 4; ++j_) { int tl_, k_, c_; M2_VSLOT(j_, tl_, k_, c_); \
            __builtin_amdgcn_global_load_lds((const unsigned*)(CST + (((size_t)hd * NCH + i) * 256 + 64 * (kt_) + k_) * 256 + 128 * tl_ + c_), (LAS unsigned*)(lds + (b_) * 65536 + (wave * 4 + j_) * 1024), 16, 0, 0); \
            __builtin_amdgcn_global_load_lds((const unsigned*)(CST + (((size_t)hd * NCH + i) * 256 + 64 * ((kt_) + 1) + k_) * 256 + 128 * tl_ + c_), (LAS unsigned*)(lds + (b_) * 65536 + 32768 + (wave * 4 + j_) * 1024), 16, 0, 0); } } while (0)
#define M2_DMA_KV(st_, b_) do { _Pragma("unroll") for (int j_ = 0; j_ < 4; ++j_) { int tl_, k_, c_; M2_VSLOT(j_, tl_, k_, c_); const int sv_ = 64 * (st_) + k_; const int rowv_ = base + (d ? 127 - sv_ : sv_); \
            __builtin_amdgcn_global_load_lds((const unsigned*)(PROJ + (size_t)rowv_ * NPROJ + 4096 + h * 256 + 128 * tl_ + c_), (LAS unsigned*)(lds + (b_) * 65536 + (wave * 4 + j_) * 1024), 16, 0, 0); \
            const int o2_ = ((wave * 4 + j_) * 64 + lane) * 16; const int rk_ = o2_ >> 9; const int cB_ = (o2_ & 511) ^ ((rk_ & 15) << 4); const int sk_ = 64 * (st_) + rk_; const int rowk_ = base + (d ? 127 - sk_ : sk_); \
            __builtin_amdgcn_global_load_lds((const unsigned*)(KC + (size_t)rowk_ * D + h * 256 + (cB_ >> 1)), (LAS unsigned*)(lds + (b_) * 65536 + 32768 + (wave * 4 + j_) * 1024), 16, 0, 0); } } while (0)
        for (int q = 0; ; ++q) {
            const int pr = bx + (q >> 1) * G; if (pr >= 8 * 128) break;
            int tid = tid_fresh(wave); asm volatile("" : "+v"(tid));
            const int lane = tid & 63, r32 = lane & 31, hi5 = lane >> 5;
            const int h = pr >> 7, cc = 2 + (pr & 127), d = q & 1, hd = d * 8 + h;
            const int i = d ? (131 - cc) : cc; const int base = cc * 128;
            const size_t gofs = ((size_t)hd * NCH + i) * 128;
            const int tpos = 32 * tb + r32; const int row_t = base + (d ? 127 - tpos : tpos);
            M2_DMA_C(0, 0);
            bf16x8 qr[16];
#pragma unroll
            for (int k = 0; k < 16; ++k) qr[k] = *(const bf16x8*)(QC + (size_t)row_t * D + h * 256 + 16 * k + 8 * hi5);
            const float bt = GB[gofs + tpos]; const float eb = __expf(bt);
            const float av = (tid < 128) ? GI[gofs + (tid & 127)] - GB[gofs + (tid & 127)] : 0.f;
            const float nv = (tid < 256) ? NST[((size_t)hd * NCH + i) * 256 + (tid & 255)] : 0.f;
            f32x16 o[4];
#pragma unroll
            for (int dd = 0; dd < 4; ++dd) o[dd] = f32x16{};
            const int vbA = (int)(uintptr_t)(lds + vh * 16384) + att::v_rd_base(lane), vbB = vbA + 65536;
            M2_LBAR();
            if (tid < 128) aS[tid] = av;
            if (tid < 256) nS[tid] = nv;
            M2_DMA_C(2, 1);
            att::pv_d0(o, vbA, qr[0], qr[1], qr[2], qr[3]);
            att::pv_d0(o, vbA + 32768, qr[4], qr[5], qr[6], qr[7]);
            M2_LBAR(); M2_DMA_KV(0, 0);
            att::pv_d0(o, vbB, qr[8], qr[9], qr[10], qr[11]);
            att::pv_d0(o, vbB + 32768, qr[12], qr[13], qr[14], qr[15]);
            if (hi5 == 0) wsc[r32] = eb; LDS_WAIT();
#pragma unroll
            for (int dd = 0; dd < 4; ++dd)
#pragma unroll
                for (int r = 0; r < 16; ++r) o[dd][r] *= wsc[crow(r, hi5)];
            float qn = 0.f;
#pragma unroll
            for (int k = 0; k < 16; ++k)
#pragma unroll
                for (int j = 0; j < 8; ++j) qn += bf2f((unsigned short)qr[k][j]) * nS[16 * k + 8 * hi5 + j];
            { auto rr = __builtin_amdgcn_permlane32_swap(__float_as_uint(qn), __float_as_uint(qn), false, false); qn = __uint_as_float(rr[0]) + __uint_as_float(rr[1]); }
            float rs = 0.f;
#pragma unroll 1
            for (int st = 0; st < 2; ++st) {
                M2_LBAR();
                if (st == 0) M2_DMA_KV(1, 1);
                LAS char* KT = (LAS char*)(lds + st * 65536 + 32768);
                const int vb0 = st ? vbB : vbA;
                if (tb >= 2 * st) {
                    f32x16 p0 = f32x16{}, p1 = f32x16{};
#pragma unroll
                    for (int k = 0; k < 16; ++k) { const int cb = (16 * k + 8 * hi5) * 2;
                        const bf16x8 b0 = *(const LAS bf16x8*)(KT + KSWZ512(r32, cb)), b1 = *(const LAS bf16x8*)(KT + KSWZ512(32 + r32, cb));
                        p0 = __builtin_amdgcn_mfma_f32_32x32x16_bf16(b0, qr[k], p0, 0, 0, 0);
                        p1 = __builtin_amdgcn_mfma_f32_32x32x16_bf16(b1, qr[k], p1, 0, 0, 0); }
                    float ps = 0.f;
#pragma unroll
                    for (int r = 0; r < 16; ++r) { const int s0 = 64 * st + crow(r, hi5), s1 = s0 + 32;
                        const float w0 = (s0 <= tpos) ? __expf(bt + aS[s0]) : 0.f, w1 = (s1 <= tpos) ? __expf(bt + aS[s1]) : 0.f;
                        p0[r] = (s0 <= tpos) ? p0[r] * w0 : 0.f; p1[r] = (s1 <= tpos) ? p1[r] * w1 : 0.f; ps += p0[r] + p1[r]; }
                    { auto rr = __builtin_amdgcn_permlane32_swap(__float_as_uint(ps), __float_as_uint(ps), false, false); ps = __uint_as_float(rr[0]) + __uint_as_float(rr[1]); }
                    rs += ps;
                    bf16x8 pa0, pa1, pa2, pa3;
                    PK4(p0, 0, pa0); PK4(p0, 8, pa1); PK4(p1, 0, pa2); PK4(p1, 8, pa3);
                    att::pv_d0(o, vb0, pa0, pa1, pa2, pa3);
                }
            }
            const float den = eb * qn + rs; const float rinv = 1.f / fmaxf(fabsf(den), 1.f);
            if (hi5 == 0) wsc[32 + r32] = rinv; LDS_WAIT();
            if (d == 0) {
                bf16_t* hp = HD + (size_t)base * D + h * 256 + 128 * vh + r32;
#pragma unroll
                for (int r = 0; r < 16; ++r) { const int tq = 32 * tb + crow(r, hi5); const float ri = wsc[32 + crow(r, hi5)];
#pragma unroll
                    for (int dd = 0; dd < 4; ++dd) { const float v = o[dd][r] * ri; hp[(size_t)tq * D + 32 * dd] = (bf16_t)(cvtpk(v, v) & 0xffffu); } }
            } else {
                const bf16_t* hf = HD + (size_t)base * D + h * 256 + 128 * vh + r32;
                LAS float* ssx = (LAS float*)(lds + 131072 + 4096);
                float ssr[16];
                float gh[4];
#pragma unroll
                for (int dd = 0; dd < 4; ++dd) gh[dd] = a.in[I_GHEAD1][h * 256 + 128 * vh + 32 * dd + r32];
                unsigned short hfr[16][4], ogr[16][4];
                const bf16_t* og = PROJ + (size_t)base * NPROJ + 6144 + h * 256 + 128 * vh + r32;
#pragma unroll
                for (int r = 0; r < 16; ++r) { const int rowq = 127 - (32 * tb + crow(r, hi5));
#pragma unroll
                    for (int dd = 0; dd < 4; ++dd) hfr[r][dd] = hf[(size_t)rowq * D + 32 * dd]; }
#pragma unroll
                for (int r = 0; r < 16; ++r) { const int rowq = 127 - (32 * tb + crow(r, hi5));
#pragma unroll
                    for (int dd = 0; dd < 4; ++dd) ogr[r][dd] = og[(size_t)rowq * NPROJ + 32 * dd]; }
                __builtin_amdgcn_sched_barrier(0);
#pragma unroll
                for (int r = 0; r < 16; ++r) { const float ri = wsc[32 + crow(r, hi5)];
                    float sq = 0.f;
#pragma unroll
                    for (int dd = 0; dd < 4; ++dd) { const float v = o[dd][r] * ri + bf2f(hfr[r][dd]); o[dd][r] = v; sq += v * v; }
                    sq += dpp_f<0xB1>(sq); sq += dpp_f<0x4E>(sq); sq += dpp_f<0x124>(sq); sq += dpp_f<0x128>(sq);
                    { auto rr = __builtin_amdgcn_permlane16_swap(__float_as_uint(sq), __float_as_uint(sq), false, false); sq = __uint_as_float(rr[0]) + __uint_as_float(rr[1]); }
                    ssr[r] = sq; }
                { float mine = 0.f;
#pragma unroll
                  for (int r = 0; r < 16; ++r) mine = (r32 == r) ? ssr[r] : mine;
                  if (r32 < 16) ssx[wave * 32 + crow(r32, hi5)] = mine; }
                asm volatile("s_waitcnt lgkmcnt(0)" ::: "memory"); __builtin_amdgcn_s_barrier(); asm volatile("" ::: "memory");
                const LAS float* px = ssx + (wave ^ 4) * 32;
                bf16_t* rp = RO + (size_t)base * D + h * 256 + 128 * vh + r32;
#pragma unroll
                for (int r = 0; r < 16; ++r) { const int rowq = 127 - (32 * tb + crow(r, hi5));
                    const float rn = rsqrtf((ssr[r] + px[crow(r, hi5)]) * (1.f / 256.f) + EPS);
#pragma unroll
                    for (int dd = 0; dd < 4; ++dd) { const float v = o[dd][r] * rn * gh[dd] * sigmoidf_(bf2f(ogr[r][dd]));
                        rp[(size_t)rowq * D + 32 * dd] = (bf16_t)(cvtpk(v, v) & 0xffffu); } }
            }
        }
        __syncthreads();
#undef M2_LBAR
#undef M2_VSLOT
#undef M2_DMA_C
#undef M2_DMA_KV
        SEAM(15);
    }


    if (IN(17)) { const int lane = lane_fresh(), tid = wave * 64 + lane;
        pg8::Gemm g{RO + (size_t)CTXL * D, WOUT1, D, nullptr, 1, 0}; pg8::StaticOrder S; S.init(SEQ / 256, D / 256, G, bx);
        pg8::EpiBf16 E{Y1 + (size_t)CTXL * D, D, 1 << 30, nullptr};
        pg8::gemm_phase<pg8::EpiBf16, pg8::StaticOrder>(lds, g, S, E, wave);
        SEAM(17);
    }

    if (IN(18)) { const int lane = lane_fresh(), tid = wave * 64 + lane; PHASE_POSTMIX(1, Y1, CTXL, a.in[I_GPOSTMIX1], a.in[I_GPREFFN1], a.in[I_WROUTER1]); SEAM(18); }
    if (IN(19)) { const int lane = lane_fresh(), tid = wave * 64 + lane; PHASE_TOPK(16); SEAM(19); }
    if (IN(21)) { const int lane = lane_fresh(), tid = wave * 64 + lane;
        pg8::Gemm g{XN, WGU, D, IDX, 2048, 2048}; pg8::GroupedOrder S; S.init(8, 16, G, bx);
        pg8::EpiSwiGLU E{HID};
        pg8::gemm_phase<pg8::EpiSwiGLU, pg8::GroupedOrder, true>(lds, g, S, E, wave);
        SEAM(21);
    }
    if (IN(22)) { const int lane = lane_fresh(), tid = wave * 64 + lane;
        pg8::Gemm g{HID, WD, D, nullptr, 1, 0}; pg8::GroupedOrder S; S.init(8, 8, G, bx);
        pg8::EpiDown E{YE, GATEV, 2048};
        pg8::gemm_phase<pg8::EpiDown, pg8::GroupedOrder>(lds, g, S, E, wave);
        SEAM(22);
    }
    if (IN(23)) { const int lane = lane_fresh(), tid = wave * 64 + lane;
        COMBINE_LOOP(1, 2048, a.in[I_GPOSTFFN1], CTXL, { row_store_f32(x, a.out + (size_t)(t - CTXL) * D, lane); });
    }
#undef IN
#undef SEAM
}

#ifndef MK_SINGLE
#define MK_SINGLE 1
#define PROBE_REP 1,1,1,1,1,1,1,1,1,1,1, 1, 1, 1, 1, 1, 1, 1, 1, 1, 1, 1, 1, 1
#endif
extern "C" void kernel_launch(void* const* d_in, const int* in_sizes, int n_in, void* d_out, int out_size, void* d_ws, size_t ws_size, hipStream_t stream) {
    static int grid = 0;
    if (grid == 0) {
        int dev = 0, cus = 0;
        if (hipGetDevice(&dev) != hipSuccess || hipDeviceGetAttribute(&cus, hipDeviceAttributeMultiprocessorCount, dev) != hipSuccess) { grid = -1; return; }
        if (hipFuncSetAttribute((const void*)mega, hipFuncAttributeMaxDynamicSharedMemorySize, LDS_BYTES) != hipSuccess) { fprintf(stderr, "hipFuncSetAttribute failed\n"); grid = -1; return; }
        if (n_in != NIN || ws_size < WS_END) { fprintf(stderr, "kernel_launch: n_in %d ws %zu (need %zu)\n", n_in, ws_size, (size_t)WS_END); grid = -1; return; }
        grid = cus;
    }
    if (grid < 0) return;
    (void)hipMemsetAsync(d_ws, 0, CTL_BYTES, stream);
    Args a{};
    for (int i = 0; i < NIN; ++i) a.in[i] = (const float*)d_in[i];
    a.out = (float*)d_out; a.ws = (unsigned char*)d_ws;
#if MK_SINGLE
    a.ph_lo = 0; a.ph_hi = NPHASE;
    hipLaunchKernelGGL(mega, dim3(grid), dim3(NTHREADS), LDS_BYTES, stream, a);
#else
    static const int REP[NPHASE] = {PROBE_REP};
    for (int p = 0; p < NPHASE; ++p) for (int r = 0; r < REP[p]; ++r) { a.ph_lo = p; a.ph_hi = p + 1; hipLaunchKernelGGL(mega, dim3(grid), dim3(NTHREADS), LDS_BYTES, stream, a); }
#endif
}
```

```cpp
#include <hip/hip_runtime.h>
#include <cstdio>
#include <cstdint>

#define GAS __attribute__((address_space(1)))
#define LAS __attribute__((address_space(3)))
typedef unsigned short bf16_t;
typedef short bf16x8 __attribute__((ext_vector_type(8)));
typedef short s16x4 __attribute__((ext_vector_type(4)));
typedef float f32x2 __attribute__((ext_vector_type(2)));
typedef float f32x4 __attribute__((ext_vector_type(4)));
typedef float f32x16 __attribute__((ext_vector_type(16)));
typedef unsigned u32x2 __attribute__((ext_vector_type(2)));
typedef unsigned u32x4 __attribute__((ext_vector_type(4)));

constexpr int D = 2048, SEQ = 16384, CTXL = 256, T = SEQ + CTXL;
constexpr int NQKV = 4608, NQD = 3328, NOF = 3072, NPROJ = 8192, NPROJ_PAD = 8448;
constexpr int NE = 16, IDXS = 2304;
constexpr float EPS = 1e-6f;
constexpr int NTHREADS = 512, NWAVES = 8;
constexpr int NCH = 130;

constexpr size_t MiB = 1u << 20;
constexpr size_t WS_CTL = 0, CTL_BYTES = 1 * MiB;
constexpr size_t WS_MOD   = 1 * MiB;
constexpr size_t WS_AFFT  = 2 * MiB;
constexpr size_t WS_IDX   = 4 * MiB;
constexpr size_t WS_GATEV = 5 * MiB;
constexpr size_t WS_INV   = 6 * MiB;
constexpr size_t WS_GATES = 8 * MiB;
constexpr size_t WS_GB    = 11 * MiB;
constexpr size_t WS_GI    = 13 * MiB;
constexpr size_t WS_NST   = 15 * MiB;
constexpr size_t WS_WIN0  = 32 * MiB;
constexpr size_t WS_WOUT0 = 50 * MiB;
constexpr size_t WS_WIN1  = 58 * MiB;
constexpr size_t WS_WOUT1 = 91 * MiB;
constexpr size_t WS_WGU   = 100 * MiB;
constexpr size_t WS_WD    = 356 * MiB;
constexpr size_t WS_XC    = 484 * MiB;
constexpr size_t WS_XN    = 614 * MiB;
constexpr size_t WS_R     = 680 * MiB;
constexpr size_t WS_QKV   = WS_R;
constexpr size_t WS_QD    = WS_R + 148 * MiB;
constexpr size_t WS_AO    = WS_R + 256 * MiB;
constexpr size_t WS_Y     = WS_R + 322 * MiB;
constexpr size_t WS_OF    = WS_R + 454 * MiB;
constexpr size_t WS_XE    = WS_R;
constexpr size_t WS_HID   = WS_R + 144 * MiB;
constexpr size_t WS_YE    = WS_R + 288 * MiB;
constexpr size_t WS_PROJ  = WS_R;
constexpr size_t WS_QC    = WS_R + 260 * MiB;
constexpr size_t WS_KC    = WS_R + 325 * MiB;
constexpr size_t WS_CST   = WS_R + 390 * MiB;
constexpr size_t WS_HD    = WS_R + 650 * MiB;
constexpr size_t WS_RO    = WS_QC;
constexpr size_t WS_Y1    = WS_CST;
constexpr size_t WS_XC2   = WS_R + 910 * MiB;
constexpr size_t WS_END   = WS_R + 1040 * MiB;

constexpr int CW_BAR = 4096;
constexpr int CW_C0 = 8192, CW_C1A = 8256, CW_C1B = 8320, CW_DONE2 = 8384, CW_DONE5 = 8448, CW_DONE10 = 8512, CW_DONE12 = 8576;

constexpr int LDS_BYTES = 147456;
constexpr int MISC_OFF = LDS_BYTES - 256;

#define LDS_WAIT() asm volatile("s_waitcnt lgkmcnt(0)" ::: "memory")
#define VM_WAIT() asm volatile("s_waitcnt vmcnt(0)" ::: "memory")
#define SBAR() __builtin_amdgcn_sched_barrier(0)
__device__ __forceinline__ unsigned cvtpk(float lo, float hi) { unsigned r; asm volatile("v_cvt_pk_bf16_f32 %0, %1, %2" : "=v"(r) : "v"(lo), "v"(hi)); return r; }
typedef __bf16 bf16x2_t __attribute__((ext_vector_type(2)));
__device__ __forceinline__ unsigned cvtpk_s(float lo, float hi) { f32x2 v = {lo, hi}; bf16x2_t b = __builtin_convertvector(v, bf16x2_t); return __builtin_bit_cast(unsigned, b); }
__device__ __forceinline__ float bf2f(unsigned short b) { return __uint_as_float(((unsigned)b) << 16); }
__device__ __forceinline__ float bflo(unsigned w) { return __uint_as_float(w << 16); }
__device__ __forceinline__ float bfhi(unsigned w) { return __uint_as_float(w & 0xffff0000u); }
__device__ __forceinline__ int wave_id() { return __builtin_amdgcn_readfirstlane((int)threadIdx.x >> 6); }
__device__ __forceinline__ int lane_fresh() { unsigned m = ~0u; asm volatile("" : "+s"(m)); return (int)__builtin_amdgcn_mbcnt_hi(m, __builtin_amdgcn_mbcnt_lo(m, 0u)); }
__device__ __forceinline__ int tid_fresh(int wave) { return wave * 64 + lane_fresh(); }
__device__ __forceinline__ float wave_sum_bp(float v) {
#pragma unroll
    for (int o = 1; o < 64; o <<= 1) v += __shfl_xor(v, o);
    return v;
}
template <int CTRL> __device__ __forceinline__ float dpp_f(float v) { return __builtin_bit_cast(float, __builtin_amdgcn_update_dpp(0, __builtin_bit_cast(int, v), CTRL, 0xF, 0xF, false)); }
__device__ __forceinline__ float wave_sum(float v) {
    v += dpp_f<0xB1>(v);
    v += dpp_f<0x4E>(v);
    v += dpp_f<0x124>(v);
    v += dpp_f<0x128>(v);
    { auto r = __builtin_amdgcn_permlane16_swap(__float_as_uint(v), __float_as_uint(v), false, false); v = __uint_as_float(r[0]) + __uint_as_float(r[1]); }
    { auto r = __builtin_amdgcn_permlane32_swap(__float_as_uint(v), __float_as_uint(v), false, false); v = __uint_as_float(r[0]) + __uint_as_float(r[1]); }
    return v;
}
template <int CTRL> __device__ __forceinline__ int dpp_i(int v) { return __builtin_amdgcn_update_dpp(0, v, CTRL, 0xF, 0xF, false); }
__device__ __forceinline__ int wave_sum_i(int v) {
    v += dpp_i<0xB1>(v); v += dpp_i<0x4E>(v); v += dpp_i<0x124>(v); v += dpp_i<0x128>(v);
    { auto r = __builtin_amdgcn_permlane16_swap((unsigned)v, (unsigned)v, false, false); v = (int)(r[0] + r[1]); }
    { auto r = __builtin_amdgcn_permlane32_swap((unsigned)v, (unsigned)v, false, false); v = (int)(r[0] + r[1]); }
    return v;
}
__device__ __forceinline__ float sigmoidf_(float x) { return __builtin_amdgcn_rcpf(1.f + __expf(-x)); }
__device__ __forceinline__ int crow(int r, int hi) { return (r & 3) + 8 * (r >> 2) + 4 * hi; }

#define XB_TMO      128
#define XB_XCNT(j)  (256  + 64 * (j))
#define XB_XSUB(j)  (1280 + 64 * (j))
#define XB_XGEN(j)  (2304 + 64 * (j))
#define XB_TOP      3328
#define XB_TOPGEN   3392
#define XCD_BAR_WORDS 3456
#define XB_SPIN_CAP (1u << 18)
__device__ __forceinline__ unsigned xb_ld(unsigned* p)              { return __hip_atomic_load(p, __ATOMIC_RELAXED, __HIP_MEMORY_SCOPE_AGENT); }
__device__ __forceinline__ unsigned xb_add(unsigned* p, unsigned v) { return __hip_atomic_fetch_add(p, v, __ATOMIC_RELAXED, __HIP_MEMORY_SCOPE_AGENT); }
__device__ __forceinline__ unsigned xb_xcc_id() { return (unsigned)__builtin_amdgcn_s_getreg((3 << 11) | 20) & 0xFu; }
#define XB_SPIN(cond, bar) do { unsigned _sp = 0; while (cond) { __builtin_amdgcn_s_sleep(1); \
    if ((++_sp & 255u) == 0u) { if (xb_ld(&(bar)[XB_TMO])) break; if (_sp > XB_SPIN_CAP) { atomicAdd(&(bar)[XB_TMO], 1u); break; } } } } while (0)
struct XcdBarrier { unsigned* bar; unsigned x; volatile LAS unsigned* st; int wave; };
__device__ __forceinline__ XcdBarrier xcd_barrier_post(unsigned* bar, volatile LAS unsigned* st, int wave) {
    XcdBarrier b; b.bar = bar; b.x = xb_xcc_id(); b.st = st; b.wave = wave;
    if (tid_fresh(wave) == 0) (void)xb_add(&bar[XB_XCNT(b.x)], 1u);
    return b;
}
__device__ __forceinline__ void xcd_barrier_complete(unsigned* bar, unsigned x, unsigned& nloc, unsigned& nx) {
    const unsigned G = gridDim.x * gridDim.y * gridDim.z;
    unsigned sum, cnt, mine, sp = 0u;
    for (;;) {
        sum = 0u; cnt = 0u; mine = 0u;
#pragma unroll
        for (unsigned j = 0; j < 16; ++j) { const unsigned c = xb_ld(&bar[XB_XCNT(j)]); sum += c; cnt += (c > 0u) ? 1u : 0u; mine = (j == x) ? c : mine; }
        if (sum == G) break;
        __builtin_amdgcn_s_sleep(1);
        if ((++sp & 255u) == 0u) { if (xb_ld(&bar[XB_TMO])) break; if (sp > XB_SPIN_CAP) { atomicAdd(&bar[XB_TMO], 1u); break; } }
    }
    nloc = mine > 0u ? mine : 1u; nx = cnt > 0u ? cnt : 1u;
}
__device__ __forceinline__ void xcd_barrier(const XcdBarrier& b) {
    asm volatile("s_waitcnt vmcnt(0)" ::: "memory");
    __syncthreads();
    if (tid_fresh(b.wave) == 0) {
        unsigned* bar = b.bar;
        __builtin_amdgcn_s_waitcnt(0);
        unsigned nloc = b.st[0], nx = b.st[1];
        if (nloc == 0u) { xcd_barrier_complete(bar, b.x, nloc, nx); b.st[0] = nloc; b.st[1] = nx; }
        const unsigned old = xb_add(&bar[XB_XSUB(b.x)], 1u);
        const unsigned gen = old / nloc;
        if (old + 1u == (gen + 1u) * nloc) {
            __builtin_amdgcn_fence(__ATOMIC_RELEASE, "agent");
            asm volatile("s_waitcnt vmcnt(0)" ::: "memory");
            const unsigned og = xb_add(&bar[XB_TOP], 1u);
            const unsigned tg = og / nx;
            if (og + 1u == (tg + 1u) * nx) xb_add(&bar[XB_TOPGEN], 1u);
            else XB_SPIN(xb_ld(&bar[XB_TOPGEN]) == tg, bar);
            __builtin_amdgcn_fence(__ATOMIC_ACQUIRE, "agent");
            xb_add(&bar[XB_XGEN(b.x)], 1u);
            asm volatile("s_waitcnt vmcnt(0)" ::: "memory");
        } else {
            XB_SPIN(xb_ld(&bar[XB_XGEN(b.x)]) == gen, bar);
            __builtin_amdgcn_fence(__ATOMIC_ACQUIRE, "agent");
            asm volatile("s_waitcnt vmcnt(0)" ::: "memory");
        }
    }
    __syncthreads();
}

namespace pg8 {
constexpr int BM = 256, BK = 64, HALF = 128, HTB = HALF * BK * 2, STAGE_BYTES = 8 * HTB, NXCD = 8, WGM = 8;
__host__ __device__ __forceinline__ int lds_byte(int r, int c) { const int st = (r >> 4) * 2 + (c >> 5), rr = r & 15, cc = c & 31, ob = rr * 64 + cc * 2; return st * 1024 + (ob ^ (((ob >> 9) & 1) << 5)); }
__host__ __device__ __forceinline__ void stage_rc(int b, int& R, int& C) { const int st = b / 1024, sb = b % 1024, swz = sb ^ (((sb >> 9) & 1) << 5); R = (st >> 1) * 16 + swz / 64; C = (st & 1) * 32 + (swz % 64) / 2; }
__host__ __device__ __forceinline__ int perm32(int rho) { const int n = rho >> 4, i = rho & 15; return 8 * (i >> 2) + 4 * n + (i & 3); }
struct Unit { int pm, pn, ta, tb; };
struct Gemm { const bf16_t* A; const bf16_t* Bt; int K; const int* gidx; int rpe, nvalid; };

struct StaticOrder {
    int nM, nN, nwg, G, c;
    __device__ void init(int nM_, int nN_, int G_, int c_) { nM = nM_; nN = nN_; nwg = nM * nN; G = G_; c = c_; }
    __device__ bool next(int i, Unit& u) const {
        const long L = (long)i * G + c; if (L >= nwg) return false;
        int wgid = (int)L; { const int q = nwg / NXCD, r = nwg % NXCD, xcd = wgid % NXCD, off = wgid / NXCD; wgid = (xcd < r ? xcd * (q + 1) : r * (q + 1) + (xcd - r) * q) + off; }
        const int nig = WGM * nN, gid = wgid / nig, fm = gid * WGM, gsz = (nM - fm) < WGM ? (nM - fm) : WGM;
        u.pm = fm + ((wgid % nig) % gsz); u.pn = (wgid % nig) / gsz; u.ta = u.pm; u.tb = u.pn; return true;
    }
};
struct GroupedOrder {
    int TM, TN, share, nloc, j, x;
    __device__ void init(int TM_, int TN_, int G_, int c_) { TM = TM_; TN = TN_; share = NE * TM * TN / NXCD; x = c_ % NXCD; j = c_ / NXCD; nloc = (G_ - x + NXCD - 1) / NXCD; }
    __device__ bool next(int i, Unit& u) const {
        const int v = i * nloc + j; if (v >= share) return false;
        const int L = x * share + v;
        const int per = TM * TN, e = L / per, r = L % per, tm = r % TM, pn = r / TM;
        u.pm = e * TM + tm; u.pn = pn; u.ta = u.pm; u.tb = e * TN + pn; return true;
    }
};

struct EpiF32 {
    static constexpr bool PERM = false;
    float* C; int ldc;
    __device__ __forceinline__ void operator()(const f32x4 (&acc)[2][2][4][2], const Unit& u, int wr, int wc, int fr, int fq) const {
        const int row0 = u.pm * BM + wr * 64 + fr, col0 = u.pn * BM + wc * 32 + 4 * fq;
#pragma unroll
        for (int ai = 0; ai < 2; ++ai)
#pragma unroll
            for (int m = 0; m < 4; ++m) { float* rowp = C + (size_t)(row0 + ai * HALF + m * 16) * ldc + col0;
#pragma unroll
                for (int bj = 0; bj < 2; ++bj)
#pragma unroll
                    for (int n = 0; n < 2; ++n) *(f32x4*)(rowp + bj * HALF + n * 16) = acc[ai][bj][m][n]; }
    }
};
struct EpiBf16 {
    static constexpr bool PERM = true;
    bf16_t* O; int ldc; int gate_pn; float* G;
    __device__ __forceinline__ void operator()(const f32x4 (&acc)[2][2][4][2], const Unit& u, int wr, int wc, int fr, int fq) const {
        const int row0 = u.pm * BM + wr * 64 + fr;
        if (u.pn >= gate_pn) {
            if (wc == 0) {
#pragma unroll
                for (int ai = 0; ai < 2; ++ai)
#pragma unroll
                    for (int m = 0; m < 4; ++m) { float* gp = G + (size_t)(row0 + ai * HALF + m * 16) * 32 + 8 * fq;
                        *(f32x4*)gp = acc[ai][0][m][0]; *(f32x4*)(gp + 4) = acc[ai][0][m][1]; }
            }
            return;
        }
        const int col0 = u.pn * BM + wc * 32 + 8 * fq;
#pragma unroll
        for (int ai = 0; ai < 2; ++ai)
#pragma unroll
            for (int m = 0; m < 4; ++m) { bf16_t* rowp = O + (size_t)(row0 + ai * HALF + m * 16) * ldc + col0;
#pragma unroll
                for (int bj = 0; bj < 2; ++bj) { const f32x4 v0 = acc[ai][bj][m][0], v1 = acc[ai][bj][m][1];
                    u32x4 w; w.x = cvtpk(v0[0], v0[1]); w.y = cvtpk(v0[2], v0[3]); w.z = cvtpk(v1[0], v1[1]); w.w = cvtpk(v1[2], v1[3]);
                    *(u32x4*)(rowp + bj * HALF) = w; } }
    }
};
struct EpiRope {
    static constexpr bool PERM = true;
    bf16_t* QKVp; bf16_t* QDp; const float* gq; const float* gk; LAS float* xch;
    __device__ __forceinline__ void operator()(const f32x4 (&acc)[2][2][4][2], const Unit& u, int wr, int wc, int fr, int fq) const {
        const int pn = u.pn; const int row0 = u.pm * BM + wr * 64 + fr;
        const float L2T = 13.287712379549449f;
        if ((pn >= 8 && pn < 12) || pn == 17) {
            const int col0 = pn * BM + wc * 32 + 8 * fq;
#pragma unroll
            for (int ai = 0; ai < 2; ++ai)
#pragma unroll
                for (int m = 0; m < 4; ++m) { bf16_t* rowp = QKVp + (size_t)(row0 + ai * HALF + m * 16) * NQKV + col0;
#pragma unroll
                    for (int bj = 0; bj < 2; ++bj) { const f32x4 v0 = acc[ai][bj][m][0], v1 = acc[ai][bj][m][1];
                        u32x4 w; w.x = cvtpk(v0[0], v0[1]); w.y = cvtpk(v0[2], v0[3]); w.z = cvtpk(v1[0], v1[1]); w.w = cvtpk(v1[2], v1[3]);
                        *(u32x4*)(rowp + bj * HALF) = w; } }
            return;
        }
        if (pn < 8) {
            const bool isq = pn < 4; const float qs = isq ? 0.18033688011112042f : 1.f;
            bf16_t* dst = QDp + (isq ? 256 * pn : 2048 + 256 * (pn - 4)) + 32 * wc + 8 * fq;
            float fe[4];
#pragma unroll
            for (int e = 0; e < 4; ++e) fe[e] = __builtin_amdgcn_exp2f(-L2T * (float)(2 * (4 * fq + e)) * (1.f / 32.f));
#pragma unroll
            for (int ai = 0; ai < 2; ++ai)
#pragma unroll
                for (int m = 0; m < 4; ++m) { const int row = row0 + ai * HALF + m * 16; const bool lat = row >= CTXL; const int tl = row - CTXL;
                    const float pos = (wc & 1) ? (float)(tl & 63) : (float)(tl >> 6);
                    float sn[4], cs[4];
#pragma unroll
                    for (int e = 0; e < 4; ++e) { sn[e] = 0.f; cs[e] = 1.f; if (lat) { const float ang = pos * fe[e]; sn[e] = __sinf(ang); cs[e] = __cosf(ang); } }
#pragma unroll
                    for (int bj = 0; bj < 2; ++bj) { const f32x4 v0 = acc[ai][bj][m][0], v1 = acc[ai][bj][m][1]; float o1[4], o2[4];
#pragma unroll
                        for (int e = 0; e < 4; ++e) { o1[e] = (v0[e] * cs[e] - v1[e] * sn[e]) * qs; o2[e] = (v1[e] * cs[e] + v0[e] * sn[e]) * qs; }
                        u32x4 w; w.x = cvtpk(o1[0], o1[1]); w.y = cvtpk(o1[2], o1[3]); w.z = cvtpk(o2[0], o2[1]); w.w = cvtpk(o2[2], o2[3]);
                        *(u32x4*)(dst + (size_t)row * NQD + bj * HALF) = w; } }
            return;
        }
        {
            const bool isq = pn < 16; const float qs = isq ? 0.12751743082459868f : 1.f; const float* g = isq ? gq : gk;
            bf16_t* dst = QDp + (isq ? 1024 + 256 * (pn - 12) : 3072) + 32 * wc + 8 * fq;
            float ss[2][4][2];
#pragma unroll
            for (int ai = 0; ai < 2; ++ai)
#pragma unroll
                for (int m = 0; m < 4; ++m)
#pragma unroll
                    for (int bj = 0; bj < 2; ++bj) { const f32x4 v0 = acc[ai][bj][m][0], v1 = acc[ai][bj][m][1];
                        float q2 = (v0[0] * v0[0] + v0[1] * v0[1]) + (v0[2] * v0[2] + v0[3] * v0[3]) + (v1[0] * v1[0] + v1[1] * v1[1]) + (v1[2] * v1[2] + v1[3] * v1[3]);
                        { auto r = __builtin_amdgcn_permlane16_swap(__float_as_uint(q2), __float_as_uint(q2), false, false); q2 = __uint_as_float(r[0]) + __uint_as_float(r[1]); }
                        { auto r = __builtin_amdgcn_permlane32_swap(__float_as_uint(q2), __float_as_uint(q2), false, false); q2 = __uint_as_float(r[0]) + __uint_as_float(r[1]); }
                        ss[ai][m][bj] = q2; }
            LAS float* mine = xch + (wr * 4 + wc) * 256;
            if (fq == 0) {
#pragma unroll
                for (int ai = 0; ai < 2; ++ai)
#pragma unroll
                    for (int m = 0; m < 4; ++m)
#pragma unroll
                        for (int bj = 0; bj < 2; ++bj) mine[((ai * 4 + m) * 2 + bj) * 16 + fr] = ss[ai][m][bj];
            }
            asm volatile("s_waitcnt lgkmcnt(0)" ::: "memory"); __builtin_amdgcn_s_barrier(); asm volatile("" ::: "memory");
            float fe[4], g1[4], g2[4];
#pragma unroll
            for (int e = 0; e < 4; ++e) { const int i = 16 * wc + 4 * fq + e; fe[e] = __builtin_amdgcn_exp2f(-L2T * (float)(2 * (i & 31)) * (1.f / 64.f)); g1[e] = g[i]; g2[e] = g[64 + i]; }
#pragma unroll
            for (int ai = 0; ai < 2; ++ai)
#pragma unroll
                for (int m = 0; m < 4; ++m) { const int row = row0 + ai * HALF + m * 16; const bool lat = row >= CTXL; const int tl = row - CTXL;
                    const float pos = (wc >= 2) ? (float)(tl & 63) : (float)(tl >> 6);
                    float sn[4], cs[4];
#pragma unroll
                    for (int e = 0; e < 4; ++e) { sn[e] = 0.f; cs[e] = 1.f; if (lat) { const float ang = pos * fe[e]; sn[e] = __sinf(ang); cs[e] = __cosf(ang); } }
#pragma unroll
                    for (int bj = 0; bj < 2; ++bj) { const int xi = ((ai * 4 + m) * 2 + bj) * 16 + fr;
                        const float tot = (xch[(wr * 4 + 0) * 256 + xi] + xch[(wr * 4 + 1) * 256 + xi]) + (xch[(wr * 4 + 2) * 256 + xi] + xch[(wr * 4 + 3) * 256 + xi]);
                        const float r = rsqrtf(tot * (1.f / 128.f) + EPS);
                        const f32x4 v0 = acc[ai][bj][m][0], v1 = acc[ai][bj][m][1]; float o1[4], o2[4];
#pragma unroll
                        for (int e = 0; e < 4; ++e) { const float y1 = v0[e] * r * g1[e], y2 = v1[e] * r * g2[e]; o1[e] = (y1 * cs[e] - y2 * sn[e]) * qs; o2[e] = (y2 * cs[e] + y1 * sn[e]) * qs; }
                        u32x4 w; w.x = cvtpk(o1[0], o1[1]); w.y = cvtpk(o1[2], o1[3]); w.z = cvtpk(o2[0], o2[1]); w.w = cvtpk(o2[2], o2[3]);
                        *(u32x4*)(dst + (size_t)row * NQD + bj * HALF) = w; } }
        }
    }
};
struct EpiSwiGLU {
    static constexpr bool PERM = true;
    bf16_t* O;
    __device__ __forceinline__ void operator()(const f32x4 (&acc)[2][2][4][2], const Unit& u, int wr, int wc, int fr, int fq) const {
        const int row0 = u.pm * BM + wr * 64 + fr, col0 = u.pn * HALF + wc * 32 + 8 * fq;
#pragma unroll
        for (int ai = 0; ai < 2; ++ai)
#pragma unroll
            for (int m = 0; m < 4; ++m) { bf16_t* rowp = O + (size_t)(row0 + ai * HALF + m * 16) * D + col0;
                float h[8];
#pragma unroll
                for (int n = 0; n < 2; ++n)
#pragma unroll
                    for (int j = 0; j < 4; ++j) { const float g = acc[ai][0][m][n][j], up = acc[ai][1][m][n][j]; h[4 * n + j] = g * sigmoidf_(g) * up; }
                u32x4 w; w.x = cvtpk(h[0], h[1]); w.y = cvtpk(h[2], h[3]); w.z = cvtpk(h[4], h[5]); w.w = cvtpk(h[6], h[7]);
                *(u32x4*)rowp = w; }
    }
};
struct EpiDown {
    static constexpr bool PERM = true;
    bf16_t* O; const float* gate; int rpe;
    __device__ __forceinline__ void operator()(const f32x4 (&acc)[2][2][4][2], const Unit& u, int wr, int wc, int fr, int fq) const {
        const int row0 = u.pm * BM + wr * 64 + fr, col0 = u.pn * BM + wc * 32 + 8 * fq;
#pragma unroll
        for (int ai = 0; ai < 2; ++ai)
#pragma unroll
            for (int m = 0; m < 4; ++m) { const int row = row0 + ai * HALF + m * 16; const int e = row / rpe, slot = row - e * rpe;
                const float gs = gate[e * IDXS + slot];
                bf16_t* rowp = O + (size_t)row * D + col0;
#pragma unroll
                for (int bj = 0; bj < 2; ++bj) { const f32x4 v0 = acc[ai][bj][m][0] * gs, v1 = acc[ai][bj][m][1] * gs;
                    u32x4 w; w.x = cvtpk(v0[0], v0[1]); w.y = cvtpk(v0[2], v0[3]); w.z = cvtpk(v1[0], v1[1]); w.w = cvtpk(v1[2], v1[3]);
                    *(u32x4*)(rowp + bj * HALF) = w; } }
    }
};

template <class Epi, class Sched, bool GA = false>
__device__ __forceinline__ void gemm_phase(LAS unsigned char* lds, const Gemm g, const Sched& S, const Epi& E, const int wid) {
    const int lane = lane_fresh(), tid = wid * 64 + lane, wr = wid >> 2, wc = wid & 3, fr = lane & 15, fq = lane >> 4;
    const int K = g.K, nt = K / BK;
    unsigned voffA[2], voffB[2]; int RA[2], CA[2];
#pragma unroll
    for (int i = 0; i < 2; ++i) { int R, C; stage_rc(tid * 16 + i * 8192, R, C); const int Rb = Epi::PERM ? ((R & ~31) + perm32(R & 31)) : R; RA[i] = R; CA[i] = C;
        voffA[i] = (unsigned)(R * K + C) * 2u; voffB[i] = (unsigned)(Rb * K + C) * 2u; }
    const size_t kstep = (size_t)(BK * 2);
    const size_t hstep = (size_t)HALF * K * 2;
    const size_t tstep = 2 * hstep;
    const unsigned ldsw = (unsigned)wid * 1024u;
    const int aoff = lds_byte(wr * 64 + fr, fq * 8), boff = lds_byte(wc * 32 + fr, fq * 8);
#define PG8_SA(b, h) (((b) * 2 + (h)) * HTB)
#define PG8_SB(b, h) ((4 + (b) * 2 + (h)) * HTB)
#define PG8_STAGE(bufoff, gbase, voff) do { _Pragma("unroll") for (int _i = 0; _i < 2; ++_i) \
        __builtin_amdgcn_global_load_lds((const unsigned*)((const char*)(gbase) + (voff)[_i]), (LAS unsigned*)(lds + (bufoff) + ldsw + _i * 8192), 16, 0, 0); } while (0)
#define PG8_LDA(dst, b, h) do { _Pragma("unroll") for (int m = 0; m < 4; ++m) _Pragma("unroll") for (int k = 0; k < 2; ++k) dst[m][k] = *(const LAS bf16x8*)(lds + PG8_SA(b, h) + aoff + m * 2048 + k * 1024); } while (0)
#define PG8_LDB(dst, b, h) do { _Pragma("unroll") for (int n = 0; n < 2; ++n) _Pragma("unroll") for (int k = 0; k < 2; ++k) dst[n][k] = *(const LAS bf16x8*)(lds + PG8_SB(b, h) + boff + n * 2048 + k * 1024); } while (0)
#define PG8_MMA(ai, bj, At, Bt) do { __builtin_amdgcn_s_setprio(1); _Pragma("unroll") for (int m = 0; m < 4; ++m) _Pragma("unroll") for (int n = 0; n < 2; ++n) _Pragma("unroll") for (int k = 0; k < 2; ++k) \
        acc[ai][bj][m][n] = __builtin_amdgcn_mfma_f32_16x16x32_bf16(Bt[n][k], At[m][k], acc[ai][bj][m][n], 0, 0, 0); __builtin_amdgcn_s_setprio(0); } while (0)
#define PG8_WAIT_V(n) asm volatile("s_waitcnt vmcnt(" #n ")" ::: "memory")
#define PG8_WAIT_L(n) asm volatile("s_waitcnt lgkmcnt(" #n ")" ::: "memory")
#define PG8_BAR __builtin_amdgcn_s_barrier()
#define PG8_SCHED __builtin_amdgcn_sched_barrier(0)
#define PG8_GIDX(u_, x0, x1) do { _Pragma("unroll") for (int _i = 0; _i < 2; ++_i) { \
        const int r0_ = (u_).pm * BM + RA[_i], r1_ = r0_ + HALF; const int e0_ = r0_ / g.rpe, e1_ = r1_ / g.rpe; int s0_ = r0_ - e0_ * g.rpe, s1_ = r1_ - e1_ * g.rpe; \
        s0_ = s0_ < g.nvalid ? s0_ : g.nvalid - 1; s1_ = s1_ < g.nvalid ? s1_ : g.nvalid - 1;            \
        (x0)[_i] = g.gidx[e0_ * IDXS + s0_]; (x1)[_i] = g.gidx[e1_ * IDXS + s1_]; } } while (0)
#define PG8_GIDX_DMA(u_) do { _Pragma("unroll") for (int _i = 0; _i < 2; ++_i) { \
        const int r0_ = (u_).pm * BM + RA[_i], r1_ = r0_ + HALF; const int e0_ = r0_ / g.rpe, e1_ = r1_ / g.rpe; int s0_ = r0_ - e0_ * g.rpe, s1_ = r1_ - e1_ * g.rpe; \
        s0_ = s0_ < g.nvalid ? s0_ : g.nvalid - 1; s1_ = s1_ < g.nvalid ? s1_ : g.nvalid - 1; \
        __builtin_amdgcn_global_load_lds((const unsigned*)(g.gidx + e0_ * IDXS + s0_), (LAS unsigned*)(lds + STAGE_BYTES + ((_i) * 8 + wid) * 256), 4, 0, 0); \
        __builtin_amdgcn_global_load_lds((const unsigned*)(g.gidx + e1_ * IDXS + s1_), (LAS unsigned*)(lds + STAGE_BYTES + ((2 + _i) * 8 + wid) * 256), 4, 0, 0); } } while (0)
#define PG8_GOFF(x0, x1, o0, o1) do { _Pragma("unroll") for (int _i = 0; _i < 2; ++_i) { (o0)[_i] = (unsigned)((x0)[_i] * K + CA[_i]) * 2u; (o1)[_i] = (unsigned)((x1)[_i] * K + CA[_i]) * 2u; } } while (0)
    Unit cur, nxt; int ui = 0;
    if (!S.next(0, cur)) return;
    f32x4 acc[2][2][4][2];
#pragma unroll
    for (int a = 0; a < 2; ++a)
#pragma unroll
        for (int b = 0; b < 2; ++b)
#pragma unroll
            for (int m = 0; m < 4; ++m)
#pragma unroll
                for (int n = 0; n < 2; ++n) acc[a][b][m][n] = (f32x4){0.f, 0.f, 0.f, 0.f};
    bf16x8 At[4][2], B0[2][2], B1[2][2];
    unsigned vc0[2], vc1[2];
    unsigned vl0[2] = {0u, 0u}, vl1[2] = {0u, 0u};
    const char *cA0, *cA1, *nA0, *nA1;
    if constexpr (GA) { int ic0[2], ic1[2]; cA0 = cA1 = (const char*)g.A; PG8_GIDX(cur, ic0, ic1); PG8_GOFF(ic0, ic1, vc0, vc1); asm volatile("s_waitcnt vmcnt(0)" ::: "memory"); }
    else { cA0 = (const char*)g.A + (size_t)cur.ta * tstep; cA1 = cA0 + hstep; vc0[0] = vc1[0] = voffA[0]; vc0[1] = vc1[1] = voffA[1]; }
    const char* cB = (const char*)g.Bt + (size_t)cur.tb * tstep;
    PG8_STAGE(PG8_SB(0, 0), cB, voffB); PG8_STAGE(PG8_SB(0, 1), cB + hstep, voffB); PG8_STAGE(PG8_SA(0, 0), cA0, vc0); PG8_STAGE(PG8_SA(0, 1), cA1, vc1);
    if (wr == 1) PG8_BAR;
    PG8_WAIT_V(2); PG8_BAR;
    PG8_STAGE(PG8_SB(1, 0), cB + kstep, voffB); PG8_STAGE(PG8_SA(1, 0), cA0 + kstep, vc0); PG8_STAGE(PG8_SB(1, 1), cB + hstep + kstep, voffB);
    PG8_WAIT_V(6); PG8_BAR;
    for (;;) {
        const bool has_next = S.next(ui + 1, nxt);
        const char* nB = has_next ? (const char*)g.Bt + (size_t)nxt.tb * tstep : cB;
        if constexpr (GA) { nA0 = nA1 = (const char*)g.A; if (has_next) PG8_GIDX_DMA(nxt); }
        else { nA0 = has_next ? (const char*)g.A + (size_t)nxt.ta * tstep : cA0; nA1 = nA0 + hstep; }
        for (int t = 0; t < nt; t += 2) {
            const bool last = (t == nt - 2);
            const char* a1_1 = cA1 + (size_t)(t + 1) * kstep;
            const char* a2_0 = last ? nA0 : cA0 + (size_t)(t + 2) * kstep; const char* a2_1 = last ? nA1 : cA1 + (size_t)(t + 2) * kstep;
            const char* b2 = last ? nB : cB + (size_t)(t + 2) * kstep;
            const char* a3_0 = a2_0 + kstep; const char* b3 = b2 + kstep;
            unsigned w0[2], w1[2];
            if constexpr (GA) {
                if (last && has_next) { int j0[2], j1[2];
                    _Pragma("unroll") for (int _i = 0; _i < 2; ++_i) { j0[_i] = (int)*(const LAS unsigned*)(lds + STAGE_BYTES + ((_i) * 8 + wid) * 256 + lane * 4); j1[_i] = (int)*(const LAS unsigned*)(lds + STAGE_BYTES + ((2 + _i) * 8 + wid) * 256 + lane * 4); }
                    PG8_GOFF(j0, j1, w0, w1); vl0[0] = w0[0]; vl0[1] = w0[1]; vl1[0] = w1[0]; vl1[1] = w1[1]; }
                else { w0[0] = vc0[0]; w0[1] = vc0[1]; w1[0] = vc1[0]; w1[1] = vc1[1]; }
            } else { w0[0] = w1[0] = voffA[0]; w0[1] = w1[1] = voffA[1]; }
            PG8_LDB(B0, 0, 0); PG8_LDB(B1, 0, 1); PG8_SCHED; PG8_LDA(At, 0, 0); PG8_STAGE(PG8_SA(1, 1), a1_1, vc1);
            PG8_WAIT_V(8); PG8_WAIT_L(0); PG8_BAR; PG8_MMA(0, 0, At, B0); PG8_MMA(0, 1, At, B1); PG8_BAR; PG8_SCHED;
            PG8_LDA(At, 0, 1); PG8_STAGE(PG8_SB(0, 0), b2, voffB); PG8_STAGE(PG8_SB(0, 1), b2 + hstep, voffB); PG8_STAGE(PG8_SA(0, 0), a2_0, w0);
            PG8_WAIT_V(8); PG8_WAIT_L(0); PG8_BAR; PG8_MMA(1, 0, At, B0); PG8_MMA(1, 1, At, B1); PG8_BAR; PG8_SCHED;
            PG8_LDB(B0, 1, 0); PG8_LDB(B1, 1, 1); PG8_SCHED; PG8_LDA(At, 1, 0); PG8_STAGE(PG8_SA(0, 1), a2_1, w1);
            PG8_WAIT_V(8); PG8_WAIT_L(0); PG8_BAR; PG8_MMA(0, 0, At, B0); PG8_MMA(0, 1, At, B1); PG8_BAR; PG8_SCHED;
            PG8_LDA(At, 1, 1); PG8_STAGE(PG8_SB(1, 0), b3, voffB); PG8_STAGE(PG8_SB(1, 1), b3 + hstep, voffB); PG8_STAGE(PG8_SA(1, 0), a3_0, w0);
            PG8_WAIT_V(8); PG8_WAIT_L(0); PG8_BAR; PG8_MMA(1, 0, At, B0); PG8_MMA(1, 1, At, B1); PG8_BAR; PG8_SCHED;
        }
        if (wr == 0) PG8_BAR;
        E(acc, cur, wr, wc, fr, fq);
        if (!has_next) break;
#pragma unroll
        for (int a = 0; a < 2; ++a)
#pragma unroll
            for (int b = 0; b < 2; ++b)
#pragma unroll
                for (int m = 0; m < 4; ++m)
#pragma unroll
                    for (int n = 0; n < 2; ++n) acc[a][b][m][n] = (f32x4){0.f, 0.f, 0.f, 0.f};
        cur = nxt; cA0 = nA0; cA1 = nA1; cB = nB; ++ui;
        if constexpr (GA) { vc0[0] = vl0[0]; vc0[1] = vl0[1]; vc1[0] = vl1[0]; vc1[1] = vl1[1]; }
        if (wr == 1) PG8_BAR;
    }
    PG8_WAIT_V(0);
    PG8_BAR;
#undef PG8_GIDX
#undef PG8_GIDX_DMA
#undef PG8_GOFF
#undef PG8_SA
#undef PG8_SB
#undef PG8_STAGE
#undef PG8_LDA
#undef PG8_LDB
#undef PG8_MMA
#undef PG8_WAIT_V
#undef PG8_WAIT_L
#undef PG8_BAR
#undef PG8_SCHED
}
}

namespace att {
using bf16 = unsigned short;
constexpr int   NW = 8, QBLK = 32, KVBLK = 64;
constexpr int   D = 128;
constexpr float THR = 8.f;
constexpr int LDQ = NQD, LDKK = NQD, LDV = NQKV, LDO = NOF;
constexpr size_t SHM_V = KVBLK * D * 2, SHM_K = KVBLK * D * 2, SHM_ATTN = 2 * SHM_V + 2 * SHM_K + NW * 64 * 4;
using bf16x8 = ::bf16x8; using s16x4 = ::s16x4; using f32x16 = ::f32x16; using u32x4 = ::u32x4;
template <int DQK> __device__ __forceinline__ int kswz(int row, int colB) { return DQK == 128 ? row * 256 + (colB ^ ((row & 7) << 4)) : row * 128 + (colB ^ (((row >> 1) & 7) << 4)); }

template <bool FIRST> __device__ __forceinline__ void partialSM(f32x16& p0, f32x16& p1, float& m_reg, float& alpha) {
  constexpr float THR2 = THR * 1.4426950408889634f;
  float pmax = p0[0]; for (int r = 1; r < 16; ++r) pmax = fmaxf(pmax, p0[r]); for (int r = 0; r < 16; ++r) pmax = fmaxf(pmax, p1[r]);
  { auto rr = __builtin_amdgcn_permlane32_swap(__float_as_uint(pmax), __float_as_uint(pmax), false, false);
    pmax = fmaxf(__uint_as_float(rr[0]), __uint_as_float(rr[1])); }
  if (!FIRST && __builtin_expect(__all(pmax <= THR2), 1)) { alpha = 1.f; }
  else { const float sh = FIRST ? pmax : fmaxf(pmax, 0.f); alpha = FIRST ? 1.f : __builtin_amdgcn_exp2f(-sh); m_reg += sh;
    for (int r = 0; r < 16; ++r) p0[r] -= sh; for (int r = 0; r < 16; ++r) p1[r] -= sh; }
  for (int r = 0; r < 16; ++r) p0[r] = __builtin_amdgcn_exp2f(p0[r]);
}
__device__ __forceinline__ void finishSM(f32x16& p0, f32x16& p1, float alpha, float& l_reg, bf16x8& pa0, bf16x8& pa1, bf16x8& pa2, bf16x8& pa3) {
  for (int r = 0; r < 16; ++r) p1[r] = __builtin_amdgcn_exp2f(p1[r]);
  float ps = 0; for (int r = 0; r < 16; ++r) ps += p0[r]; for (int r = 0; r < 16; ++r) ps += p1[r];
  { auto rr = __builtin_amdgcn_permlane32_swap(__float_as_uint(ps), __float_as_uint(ps), false, false);
    ps = __uint_as_float(rr[0]) + __uint_as_float(rr[1]); }
  l_reg = l_reg * alpha + ps;
#define PK4(P, BASE, OUT) do { unsigned a0 = cvtpk_s(P[BASE + 0], P[BASE + 1]), a1 = cvtpk_s(P[BASE + 2], P[BASE + 3]);   \
    unsigned b0 = cvtpk_s(P[BASE + 4], P[BASE + 5]), b1 = cvtpk_s(P[BASE + 6], P[BASE + 7]);                              \
    auto r0 = __builtin_amdgcn_permlane32_swap(a0, b0, false, false); auto r1 = __builtin_amdgcn_permlane32_swap(a1, b1, false, false); \
    u32x4 w = {r0[0], r1[0], r0[1], r1[1]}; OUT = *reinterpret_cast<bf16x8*>(&w); } while (0)
  PK4(p0, 0, pa0); PK4(p0, 8, pa1); PK4(p1, 0, pa2); PK4(p1, 8, pa3);
#undef PK4
}
template <int DQK> __device__ __forceinline__ void qkt(f32x16& p0, f32x16& p1, const bf16* Ks, const bf16x8* qr, int r32, int hi, float negm) {
  for (int r = 0; r < 16; ++r) { p0[r] = negm; p1[r] = negm; }
  for (int d0 = 0; d0 < DQK / 16; ++d0) { int cb = (d0 * 16 + hi * 8) * 2;
    bf16x8 b0 = *reinterpret_cast<const bf16x8*>((const char*)Ks + kswz<DQK>(r32, cb));
    bf16x8 b1 = *reinterpret_cast<const bf16x8*>((const char*)Ks + kswz<DQK>(32 + r32, cb));
    p0 = __builtin_amdgcn_mfma_f32_32x32x16_bf16(b0, qr[d0], p0, 0, 0, 0);
    p1 = __builtin_amdgcn_mfma_f32_32x32x16_bf16(b1, qr[d0], p1, 0, 0, 0); }
}
__device__ __forceinline__ int v_st(int k, int c) { const int kk = (k & ~0xC) | ((k & 4) << 1) | ((k & 8) >> 1); return ((kk >> 3) * 4 + (c >> 5)) * 512 + ((kk & 7) * 32 + (c & 31)) * 2; }
__device__ __forceinline__ int v_rd_base(int lane) { return ((lane & 3) << 3) | (((lane >> 2) & 3) << 6) | (((lane >> 4) & 1) << 5) | (((lane >> 5) & 1) << 8); }
constexpr int v_rd_off(int d0, int ks, int half) { return d0 * 512 + ks * 4096 + half * 2048; }
template <int OFF> __device__ __forceinline__ s16x4 tr_read(int vb) {
  s16x4 r; asm volatile("ds_read_b64_tr_b16 %0, %1 offset:%2" : "=&v"(r) : "v"(vb), "i"(OFF) : "memory"); return r;
}
template <int D0> __device__ __forceinline__ void pv_one(f32x16& od, int vb, bf16x8 pa0, bf16x8 pa1, bf16x8 pa2, bf16x8 pa3) {
  const s16x4 l0 = tr_read<v_rd_off(D0, 0, 0)>(vb), h0 = tr_read<v_rd_off(D0, 0, 1)>(vb), l1 = tr_read<v_rd_off(D0, 1, 0)>(vb), h1 = tr_read<v_rd_off(D0, 1, 1)>(vb);
  const s16x4 l2 = tr_read<v_rd_off(D0, 2, 0)>(vb), h2 = tr_read<v_rd_off(D0, 2, 1)>(vb), l3 = tr_read<v_rd_off(D0, 3, 0)>(vb), h3 = tr_read<v_rd_off(D0, 3, 1)>(vb);
  asm volatile("s_waitcnt lgkmcnt(0)" ::: "memory"); SBAR();
#define PK(L, H) (bf16x8){L[0], L[1], L[2], L[3], H[0], H[1], H[2], H[3]}
  od = __builtin_amdgcn_mfma_f32_32x32x16_bf16(pa0, PK(l0, h0), od, 0, 0, 0);
  od = __builtin_amdgcn_mfma_f32_32x32x16_bf16(pa1, PK(l1, h1), od, 0, 0, 0);
  od = __builtin_amdgcn_mfma_f32_32x32x16_bf16(pa2, PK(l2, h2), od, 0, 0, 0);
  od = __builtin_amdgcn_mfma_f32_32x32x16_bf16(pa3, PK(l3, h3), od, 0, 0, 0);
#undef PK
}
#define PV_READ8(D0, l0, h0, l1, h1, l2, h2, l3, h3) \
  const s16x4 l0 = tr_read<v_rd_off(D0, 0, 0)>(vb), h0 = tr_read<v_rd_off(D0, 0, 1)>(vb), l1 = tr_read<v_rd_off(D0, 1, 0)>(vb), h1 = tr_read<v_rd_off(D0, 1, 1)>(vb); \
  const s16x4 l2 = tr_read<v_rd_off(D0, 2, 0)>(vb), h2 = tr_read<v_rd_off(D0, 2, 1)>(vb), l3 = tr_read<v_rd_off(D0, 3, 0)>(vb), h3 = tr_read<v_rd_off(D0, 3, 1)>(vb);
#define PV_MMA4(od, l0, h0, l1, h1, l2, h2, l3, h3) do { \
  od = __builtin_amdgcn_mfma_f32_32x32x16_bf16(pa0, (bf16x8){l0[0], l0[1], l0[2], l0[3], h0[0], h0[1], h0[2], h0[3]}, od, 0, 0, 0); \
  od = __builtin_amdgcn_mfma_f32_32x32x16_bf16(pa1, (bf16x8){l1[0], l1[1], l1[2], l1[3], h1[0], h1[1], h1[2], h1[3]}, od, 0, 0, 0); \
  od = __builtin_amdgcn_mfma_f32_32x32x16_bf16(pa2, (bf16x8){l2[0], l2[1], l2[2], l2[3], h2[0], h2[1], h2[2], h2[3]}, od, 0, 0, 0); \
  od = __builtin_amdgcn_mfma_f32_32x32x16_bf16(pa3, (bf16x8){l3[0], l3[1], l3[2], l3[3], h3[0], h3[1], h3[2], h3[3]}, od, 0, 0, 0); } while (0)
__device__ __forceinline__ void pv_d0p(f32x16* o, int vb, bf16x8 pa0, bf16x8 pa1, bf16x8 pa2, bf16x8 pa3) {
  SBAR();
  PV_READ8(0, a0, b0, a1, b1, a2, b2, a3, b3)
  PV_READ8(1, c0, d0, c1, d1, c2, d2, c3, d3)
  asm volatile("s_waitcnt lgkmcnt(8)" ::: "memory"); SBAR();
  PV_MMA4(o[0], a0, b0, a1, b1, a2, b2, a3, b3);
  PV_READ8(2, e0, f0, e1, f1, e2, f2, e3, f3)
  asm volatile("s_waitcnt lgkmcnt(8)" ::: "memory"); SBAR();
  PV_MMA4(o[1], c0, d0, c1, d1, c2, d2, c3, d3);
  PV_READ8(3, g0, h0, g1, h1, g2, h2, g3, h3)
  asm volatile("s_waitcnt lgkmcnt(8)" ::: "memory"); SBAR();
  PV_MMA4(o[2], e0, f0, e1, f1, e2, f2, e3, f3);
  asm volatile("s_waitcnt lgkmcnt(0)" ::: "memory"); SBAR();
  PV_MMA4(o[3], g0, h0, g1, h1, g2, h2, g3, h3);
}
__device__ __forceinline__ void pv_d0(f32x16* o, int vb, bf16x8 pa0, bf16x8 pa1, bf16x8 pa2, bf16x8 pa3) {
  pv_one<0>(o[0], vb, pa0, pa1, pa2, pa3); pv_one<1>(o[1], vb, pa0, pa1, pa2, pa3); pv_one<2>(o[2], vb, pa0, pa1, pa2, pa3); pv_one<3>(o[3], vb, pa0, pa1, pa2, pa3);
}

template <int DQK>
__device__ __forceinline__ void attn_dense_body(const bf16* __restrict__ Qb, const bf16* __restrict__ Kh, const bf16* __restrict__ Vh,
                                                float* __restrict__ Ob, int seq, char* lds, int wave_) {
  constexpr int NQ = DQK / 16;
  int tid = tid_fresh(wave_); asm volatile("" : "+v"(tid));
  const int wid = tid >> 6, lane = tid & 63, r32 = lane & 31, hi = lane >> 5;
  bf16* V_lds = (bf16*)lds; bf16* K_lds = (bf16*)(lds + 2 * SHM_V);
  float* ws = (float*)(lds + 2 * SHM_V + 2 * SHM_K) + wid * 64; float* li_l = ws; float* al_l = ws + 32;
  float m_reg = 0.f  , l_reg = 0; f32x16 o[4] = {}; bf16x8 qr[NQ];
  const bf16* Qw = Qb + (long)(wid * QBLK + r32) * LDQ + hi * 8;
#pragma unroll
  for (int d0 = 0; d0 < NQ; ++d0) qr[d0] = *reinterpret_cast<const bf16x8*>(Qw + d0 * 16);
  const int sr = tid >> 4, sc = (tid & 15) * 8, vst0 = v_st(sr, sc), vst1 = v_st(32 + sr, sc);
  const int kr = tid >> 3, kc8 = (tid & 7) * 8;
  const int vb0 = (int)(uintptr_t)V_lds + v_rd_base(lane);
  struct { bf16x8 vs0, vs1, ks0, ks1; } sr_[2];
#define SLOAD(i, k0) do { sr_[i].vs0 = *reinterpret_cast<const bf16x8*>(&Vh[(long)((k0) + sr) * LDV + sc]); sr_[i].vs1 = *reinterpret_cast<const bf16x8*>(&Vh[(long)((k0) + 32 + sr) * LDV + sc]); \
    if constexpr (DQK == 128) { sr_[i].ks0 = *reinterpret_cast<const bf16x8*>(&Kh[(long)((k0) + sr) * LDKK + sc]); sr_[i].ks1 = *reinterpret_cast<const bf16x8*>(&Kh[(long)((k0) + 32 + sr) * LDKK + sc]); } \
    else { sr_[i].ks0 = *reinterpret_cast<const bf16x8*>(&Kh[(long)((k0) + kr) * LDKK + kc8]); } } while (0)
#define SWRITE(b, i) do { *(bf16x8*)((char*)V_lds + (b) * SHM_V + vst0) = sr_[i].vs0;          \
    *(bf16x8*)((char*)V_lds + (b) * SHM_V + vst1) = sr_[i].vs1;               \
    if constexpr (DQK == 128) { *(bf16x8*)((char*)K_lds + (b) * SHM_K + kswz<128>(sr, sc * 2)) = sr_[i].ks0;                       \
    *(bf16x8*)((char*)K_lds + (b) * SHM_K + kswz<128>(32 + sr, sc * 2)) = sr_[i].ks1; } \
    else { *(bf16x8*)((char*)K_lds + (b) * SHM_K + kswz<64>(kr, kc8 * 2)) = sr_[i].ks0; } } while (0)
#define SWAIT() do { if constexpr (DQK == 128) asm volatile("s_waitcnt vmcnt(4)" ::: "memory"); else asm volatile("s_waitcnt vmcnt(3)" ::: "memory"); } while (0)
#define RESC(a) do { if (__any((a) < 1.f)) { if (hi == 0) al_l[r32] = (a); asm volatile("s_waitcnt lgkmcnt(0)" ::: "memory"); \
    for (int d = 0; d < 4; ++d) for (int r = 0; r < 16; ++r) o[d][r] *= al_l[crow(r, hi)]; } } while (0)
  f32x16 pA0, pA1, pB0, pB1; float alA, alB; bf16x8 pa0, pa1, pa2, pa3; const int NT = seq / KVBLK;
  constexpr int SE = 0, SO = 1;
  SLOAD(SE, 0); asm volatile("s_waitcnt vmcnt(0)" ::: "memory"); SWRITE(0, SE); __syncthreads();
  qkt<DQK>(pA0, pA1, K_lds, qr, r32, hi, 0.f); partialSM<true>(pA0, pA1, m_reg, alA);
  SLOAD(SO, KVBLK); SLOAD(SE, 2 * KVBLK);
  SWAIT(); SWRITE(1, SO); __syncthreads();
  for (int j = 1; j + 1 < NT; j += 2) {
    SBAR(); qkt<DQK>(pB0, pB1, (bf16*)((char*)K_lds + SHM_K), qr, r32, hi, -m_reg);
    finishSM(pA0, pA1, alA, l_reg, pa0, pa1, pa2, pa3); SBAR();
    SLOAD(SO, (j + 2) * KVBLK); SBAR();
    pv_d0(o, vb0, pa0, pa1, pa2, pa3); partialSM<false>(pB0, pB1, m_reg, alB);
    __syncthreads(); SWAIT(); SWRITE(0, SE);
    RESC(alB); __syncthreads();
    SBAR(); qkt<DQK>(pA0, pA1, K_lds, qr, r32, hi, -m_reg);
    finishSM(pB0, pB1, alB, l_reg, pa0, pa1, pa2, pa3); SBAR();
    { const int jn = (j + 3 < NT) ? j + 3 : NT - 1; SLOAD(SE, jn * KVBLK); } SBAR();
    pv_d0(o, vb0 + (int)SHM_V, pa0, pa1, pa2, pa3); partialSM<false>(pA0, pA1, m_reg, alA);
    __syncthreads(); SWAIT(); SWRITE(1, SO);
    RESC(alA); __syncthreads();
  }
  SBAR(); qkt<DQK>(pB0, pB1, (bf16*)((char*)K_lds + SHM_K), qr, r32, hi, -m_reg);
  finishSM(pA0, pA1, alA, l_reg, pa0, pa1, pa2, pa3); SBAR();
  pv_d0(o, vb0, pa0, pa1, pa2, pa3); partialSM<false>(pB0, pB1, m_reg, alB);
  __syncthreads(); RESC(alB);
  finishSM(pB0, pB1, alB, l_reg, pa0, pa1, pa2, pa3); SBAR();
  pv_d0(o, vb0 + (int)SHM_V, pa0, pa1, pa2, pa3);
  if (hi == 0) li_l[r32] = l_reg; asm volatile("s_waitcnt lgkmcnt(0)" ::: "memory");
  float rli[16];
#pragma unroll
  for (int r = 0; r < 16; ++r) rli[r] = __builtin_amdgcn_rcpf(li_l[crow(r, hi)]);
  float* Ow = Ob + (long)(wid * QBLK) * LDO;
#pragma unroll
  for (int r = 0; r < 16; ++r) { int orow = crow(r, hi);
    for (int d0 = 0; d0 < 4; ++d0) Ow[(long)orow * LDO + d0 * 32 + r32] = o[d0][r] * rli[r]; }
#undef SLOAD
#undef SWRITE
#undef SWAIT
#undef RESC
}


template <int DQK>
__device__ __forceinline__ void attn_dense_body2(const bf16* __restrict__ Qb, const bf16* __restrict__ Kh, const bf16* __restrict__ Vh,
                                                 float* __restrict__ Ob, int seq, char* lds, int wave_) {
  constexpr int NQ = DQK / 16;
  int tid = tid_fresh(wave_); asm volatile("" : "+v"(tid));
  const int wid = tid >> 6, lane = tid & 63, r32 = lane & 31, hi = lane >> 5;
  const int widu = __builtin_amdgcn_readfirstlane(wid);
  char* V_ring = lds; char* K_ring = lds + 65536;
  float* ws = (float*)(lds + 65536 + 49152) + wid * 64; float* li_l = ws; float* al_l = ws + 32;
  float m_reg = 0.f, l_reg = 0; f32x16 o[4] = {}; bf16x8 qr[NQ];
  const bf16* Qw = Qb + (long)(wid * QBLK + r32) * LDQ + hi * 8;
#pragma unroll
  for (int d0 = 0; d0 < NQ; ++d0) qr[d0] = *reinterpret_cast<const bf16x8*>(Qw + d0 * 16);
  int voff[2], koff[2];
#pragma unroll
  for (int i = 0; i < 2; ++i) { const int o_ = (((wid * 2 + i) * 64 + lane) & 1023) * 16, sub = o_ >> 9, wi = o_ & 511, kk = ((sub >> 2) << 3) | (wi >> 6);
    const int k = (kk & ~0xC) | ((kk & 4) << 1) | ((kk & 8) >> 1), c = ((sub & 3) << 5) | ((wi & 63) >> 1); voff[i] = k * LDV + c;
    if constexpr (DQK == 128) { const int row = o_ >> 8, cB = (o_ & 255) ^ ((row & 7) << 4); koff[i] = row * LDKK + (cB >> 1); }
    else { const int o2 = ((wid * 64 + lane) & 511) * 16, row = o2 >> 7, cB = (o2 & 127) ^ (((row >> 1) & 7) << 4); koff[i] = row * LDKK + (cB >> 1); } }
  const int vrd = (int)(uintptr_t)V_ring + v_rd_base(lane);
#define ADMA(t_, kb_, vb_) do { const long k0_ = (long)(t_) * KVBLK; \
    _Pragma("unroll") for (int i_ = 0; i_ < 2; ++i_) __builtin_amdgcn_global_load_lds((const unsigned*)(Vh + k0_ * LDV + voff[i_]), (__attribute__((address_space(3))) unsigned*)(uintptr_t)((unsigned)(uintptr_t)V_ring + (vb_) * 16384 + (widu * 2 + i_) * 1024), 16, 0, 0); \
    if constexpr (DQK == 128) { _Pragma("unroll") for (int i_ = 0; i_ < 2; ++i_) __builtin_amdgcn_global_load_lds((const unsigned*)(Kh + k0_ * LDKK + koff[i_]), (__attribute__((address_space(3))) unsigned*)(uintptr_t)((unsigned)(uintptr_t)K_ring + (kb_) * 16384 + (widu * 2 + i_) * 1024), 16, 0, 0); } \
    else __builtin_amdgcn_global_load_lds((const unsigned*)(Kh + k0_ * LDKK + koff[0]), (__attribute__((address_space(3))) unsigned*)(uintptr_t)((unsigned)(uintptr_t)K_ring + (kb_) * 16384 + widu * 1024), 16, 0, 0); } while (0)
#define AWAIT() do { if constexpr (DQK == 128) asm volatile("s_waitcnt vmcnt(4) lgkmcnt(0)" ::: "memory"); else asm volatile("s_waitcnt vmcnt(3) lgkmcnt(0)" ::: "memory"); \
    __builtin_amdgcn_s_barrier(); asm volatile("" ::: "memory"); } while (0)
#define RESC(a) do { if (__any((a) < 1.f)) { if (hi == 0) al_l[r32] = (a); asm volatile("s_waitcnt lgkmcnt(0)" ::: "memory"); \
    for (int d = 0; d < 4; ++d) for (int r = 0; r < 16; ++r) o[d][r] *= al_l[crow(r, hi)]; } } while (0)
#define KB3(x) ((x) >= 3 ? (x) - 3 : (x))
#define VB4(x) ((x) & 3)
  f32x16 pA0, pA1, pB0, pB1; float alA, alB; bf16x8 pa0, pa1, pa2, pa3; const int NT = seq / KVBLK;
  asm volatile("s_waitcnt vmcnt(0)" ::: "memory");
  ADMA(0, 0, 0); ADMA(1, 1, 1);
  AWAIT();
  ADMA(2, 2, 2);
  qkt<DQK>(pA0, pA1, (const bf16*)K_ring, qr, r32, hi, 0.f); partialSM<true>(pA0, pA1, m_reg, alA);
  int kb = 1, vb = 1;
  for (int j = 1; j + 1 < NT; j += 2) {
    AWAIT();
    { const int jn = (j + 2 < NT) ? j + 2 : NT - 1; ADMA(jn, KB3(kb + 2), VB4(vb + 2)); }
    SBAR(); __builtin_amdgcn_s_setprio(1); qkt<DQK>(pB0, pB1, (const bf16*)(K_ring + kb * 16384), qr, r32, hi, -m_reg);
    finishSM(pA0, pA1, alA, l_reg, pa0, pa1, pa2, pa3); SBAR();
    pv_d0p(o, vrd + VB4(vb + 3) * 16384, pa0, pa1, pa2, pa3); partialSM<false>(pB0, pB1, m_reg, alB); __builtin_amdgcn_s_setprio(0);
    RESC(alB);
    kb = KB3(kb + 1); vb = VB4(vb + 1);
    AWAIT();
    { const int jn = (j + 3 < NT) ? j + 3 : NT - 1; ADMA(jn, KB3(kb + 2), VB4(vb + 2)); }
    SBAR(); __builtin_amdgcn_s_setprio(1); qkt<DQK>(pA0, pA1, (const bf16*)(K_ring + kb * 16384), qr, r32, hi, -m_reg);
    finishSM(pB0, pB1, alB, l_reg, pa0, pa1, pa2, pa3); SBAR();
    pv_d0p(o, vrd + VB4(vb + 3) * 16384, pa0, pa1, pa2, pa3); partialSM<false>(pA0, pA1, m_reg, alA); __builtin_amdgcn_s_setprio(0);
    RESC(alA);
    kb = KB3(kb + 1); vb = VB4(vb + 1);
  }
  asm volatile("s_waitcnt vmcnt(0) lgkmcnt(0)" ::: "memory"); __builtin_amdgcn_s_barrier(); asm volatile("" ::: "memory");
  SBAR(); __builtin_amdgcn_s_setprio(1); qkt<DQK>(pB0, pB1, (const bf16*)(K_ring + kb * 16384), qr, r32, hi, -m_reg);
  finishSM(pA0, pA1, alA, l_reg, pa0, pa1, pa2, pa3); SBAR();
  pv_d0p(o, vrd + VB4(vb + 3) * 16384, pa0, pa1, pa2, pa3); partialSM<false>(pB0, pB1, m_reg, alB); __builtin_amdgcn_s_setprio(0);
  RESC(alB);
  finishSM(pB0, pB1, alB, l_reg, pa0, pa1, pa2, pa3); SBAR();
  pv_d0p(o, vrd + vb * 16384, pa0, pa1, pa2, pa3);
  if (hi == 0) li_l[r32] = l_reg; asm volatile("s_waitcnt lgkmcnt(0)" ::: "memory");
  float rli[16];
#pragma unroll
  for (int r = 0; r < 16; ++r) rli[r] = __builtin_amdgcn_rcpf(li_l[crow(r, hi)]);
  if constexpr (DQK == 128) {
    bf16_t* Ow = (bf16_t*)Ob + (long)(wid * QBLK) * 2048;
#pragma unroll
    for (int r = 0; r < 16; ++r) { int orow = crow(r, hi);
      for (int d0 = 0; d0 < 4; ++d0) { const float v = o[d0][r] * rli[r]; Ow[(long)orow * 2048 + d0 * 32 + r32] = (bf16_t)(cvtpk(v, v) & 0xffffu); } }
  } else {
    float* Ow = Ob + (long)(wid * QBLK) * LDO;
#pragma unroll
    for (int r = 0; r < 16; ++r) { int orow = crow(r, hi);
      for (int d0 = 0; d0 < 4; ++d0) Ow[(long)orow * LDO + d0 * 32 + r32] = o[d0][r] * rli[r]; }
  }
#undef ADMA
#undef AWAIT
#undef RESC
#undef KB3
#undef VB4
}

__device__ __forceinline__ void attn_diff512(const bf16* __restrict__ Qb, const bf16* __restrict__ Kh, const bf16* __restrict__ Vh,
                                             float* __restrict__ Ob, int seq, char* lds, int wave_) {
  int tid = tid_fresh(wave_); asm volatile("" : "+v"(tid));
  const int wid = tid >> 6, lane = tid & 63, r32 = lane & 31, hi = lane >> 5;
  const int widu = __builtin_amdgcn_readfirstlane(wid);
  char* V_ring = lds; char* K_ring = lds + 65536;
  __attribute__((address_space(3))) float* al_l = (__attribute__((address_space(3))) float*)(uintptr_t)((unsigned)(uintptr_t)lds + 65536 + 49152) + wid * 128 + 64;
  float m0 = 0.f, m1 = 0.f, l0 = 0.f, l1 = 0.f; f32x16 oa[4] = {}, ob[4] = {}; bf16x8 qa[4], qb[4];
  { const bf16* Qw = Qb + (long)(wid * 64 + r32) * LDQ + hi * 8;
#pragma unroll
    for (int d0 = 0; d0 < 4; ++d0) { qa[d0] = *reinterpret_cast<const bf16x8*>(Qw + d0 * 16); qb[d0] = *reinterpret_cast<const bf16x8*>(Qw + (long)32 * LDQ + d0 * 16); } }
#define VOFF(i) ({ const int o_ = (((wid * 2 + (i)) * 64 + lane) & 1023) * 16, sub = o_ >> 9, wi = o_ & 511, kk = ((sub >> 2) << 3) | (wi >> 6); \
    const int k = (kk & ~0xC) | ((kk & 4) << 1) | ((kk & 8) >> 1), c = ((sub & 3) << 5) | ((wi & 63) >> 1); k * LDV + c; })
#define KOFF() ({ const int o2 = ((wid * 64 + lane) & 511) * 16, row = o2 >> 7, cB = (o2 & 127) ^ (((row >> 1) & 7) << 4); row * LDKK + (cB >> 1); })
#define ADMA(t_, kb_, vb_) do { const long k0_ = (long)(t_) * KVBLK; \
    _Pragma("unroll") for (int i_ = 0; i_ < 2; ++i_) __builtin_amdgcn_global_load_lds((const unsigned*)(Vh + k0_ * LDV + VOFF(i_)), (__attribute__((address_space(3))) unsigned*)(uintptr_t)((unsigned)(uintptr_t)V_ring + (vb_) * 16384 + (widu * 2 + i_) * 1024), 16, 0, 0); \
    __builtin_amdgcn_global_load_lds((const unsigned*)(Kh + k0_ * LDKK + KOFF()), (__attribute__((address_space(3))) unsigned*)(uintptr_t)((unsigned)(uintptr_t)K_ring + (kb_) * 16384 + widu * 1024), 16, 0, 0); } while (0)
#define AWAIT() do { asm volatile("s_waitcnt vmcnt(3) lgkmcnt(0)" ::: "memory"); __builtin_amdgcn_s_barrier(); asm volatile("" ::: "memory"); } while (0)
#define KB3(x) ((x) >= 3 ? (x) - 3 : (x))
#define VB4(x) ((x) & 3)
#define SMG(p, mreg, lreg, oacc, G_, FIRST_, q0, q1) do { \
    float pmax = p[0]; _Pragma("unroll") for (int r = 1; r < 16; ++r) pmax = fmaxf(pmax, p[r]); \
    { auto rr = __builtin_amdgcn_permlane32_swap(__float_as_uint(pmax), __float_as_uint(pmax), false, false); pmax = fmaxf(__uint_as_float(rr[0]), __uint_as_float(rr[1])); } \
    float alpha = 1.f; \
    if ((FIRST_) || !__all(pmax <= THR * 1.4426950408889634f)) { const float sh = (FIRST_) ? pmax : fmaxf(pmax, 0.f); alpha = (FIRST_) ? 1.f : __builtin_amdgcn_exp2f(-sh); mreg += sh; \
        _Pragma("unroll") for (int r = 0; r < 16; ++r) p[r] -= sh; \
        if (!(FIRST_) && __any(alpha < 1.f)) { if (hi == 0) al_l[(G_) * 32 + r32] = alpha; asm volatile("s_waitcnt lgkmcnt(0)" ::: "memory"); \
            _Pragma("unroll") for (int d = 0; d < 4; ++d) _Pragma("unroll") for (int r = 0; r < 16; ++r) oacc[d][r] *= al_l[(G_) * 32 + crow(r, hi)]; } } \
    float ps = 0.f; \
    _Pragma("unroll") for (int r = 0; r < 16; ++r) { p[r] = __builtin_amdgcn_exp2f(p[r]); ps += p[r]; } \
    { auto rr = __builtin_amdgcn_permlane32_swap(__float_as_uint(ps), __float_as_uint(ps), false, false); ps = __uint_as_float(rr[0]) + __uint_as_float(rr[1]); } \
    lreg = lreg * alpha + ps; \
    PK4(p, 0, q0); PK4(p, 8, q1); } while (0)
#define PK4(P, BASE, OUT) do { unsigned a0_ = cvtpk_s(P[BASE + 0], P[BASE + 1]), a1_ = cvtpk_s(P[BASE + 2], P[BASE + 3]);   \
    unsigned b0_ = cvtpk_s(P[BASE + 4], P[BASE + 5]), b1_ = cvtpk_s(P[BASE + 6], P[BASE + 7]);                              \
    auto r0_ = __builtin_amdgcn_permlane32_swap(a0_, b0_, false, false); auto r1_ = __builtin_amdgcn_permlane32_swap(a1_, b1_, false, false); \
    u32x4 w_ = {r0_[0], r1_[0], r0_[1], r1_[1]}; OUT = *reinterpret_cast<bf16x8*>(&w_); } while (0)
#define PV_READ4(D0, H, l0, h0, l1, h1) \
  const s16x4 l0 = tr_read<v_rd_off(D0, 2 * (H), 0)>(vb), h0 = tr_read<v_rd_off(D0, 2 * (H), 1)>(vb), l1 = tr_read<v_rd_off(D0, 2 * (H) + 1, 0)>(vb), h1 = tr_read<v_rd_off(D0, 2 * (H) + 1, 1)>(vb);
#define PV_MM4(oA, oB, l0, h0, l1, h1) do { \
  const bf16x8 v0_ = (bf16x8){l0[0], l0[1], l0[2], l0[3], h0[0], h0[1], h0[2], h0[3]}, v1_ = (bf16x8){l1[0], l1[1], l1[2], l1[3], h1[0], h1[1], h1[2], h1[3]}; \
  oA = __builtin_amdgcn_mfma_f32_32x32x16_bf16(fa0, v0_, oA, 0, 0, 0); oB = __builtin_amdgcn_mfma_f32_32x32x16_bf16(fb0, v0_, oB, 0, 0, 0); \
  oA = __builtin_amdgcn_mfma_f32_32x32x16_bf16(fa1, v1_, oA, 0, 0, 0); oB = __builtin_amdgcn_mfma_f32_32x32x16_bf16(fb1, v1_, oB, 0, 0, 0); } while (0)
#define HALF(kb_, vb_, H, FIRST_) do { \
    f32x16 pa_, pb_; \
    _Pragma("unroll") for (int r = 0; r < 16; ++r) { pa_[r] = -m0; pb_[r] = -m1; } \
    if (widu >= 4) __builtin_amdgcn_s_setprio(2); else __builtin_amdgcn_s_setprio(1); \
    { const char* Ks_ = K_ring + (kb_) * 16384; \
      _Pragma("unroll") for (int d0 = 0; d0 < 4; ++d0) { const int cb = (d0 * 16 + hi * 8) * 2; \
        const bf16x8 kf = *reinterpret_cast<const bf16x8*>(Ks_ + kswz<64>(32 * (H) + r32, cb)); \
        pa_ = __builtin_amdgcn_mfma_f32_32x32x16_bf16(kf, qa[d0], pa_, 0, 0, 0); pb_ = __builtin_amdgcn_mfma_f32_32x32x16_bf16(kf, qb[d0], pb_, 0, 0, 0); } } \
    if (widu >= 4) __builtin_amdgcn_s_setprio(1); else __builtin_amdgcn_s_setprio(0); \
    bf16x8 fa0, fa1, fb0, fb1; \
    SMG(pa_, m0, l0, oa, 0, FIRST_, fa0, fa1); \
    SMG(pb_, m1, l1, ob, 1, FIRST_, fb0, fb1); \
    { const int vb = (int)(uintptr_t)V_ring + v_rd_base(lane) + (vb_) * 16384; SBAR(); if (widu >= 4) __builtin_amdgcn_s_setprio(2); else __builtin_amdgcn_s_setprio(1); \
      PV_READ4(0, H, a0, b0, a1, b1) \
      PV_READ4(1, H, c0, d0, c1, d1) \
      asm volatile("s_waitcnt lgkmcnt(4)" ::: "memory"); SBAR(); \
      PV_MM4(oa[0], ob[0], a0, b0, a1, b1); \
      PV_READ4(2, H, e0, f0, e1, f1) \
      asm volatile("s_waitcnt lgkmcnt(4)" ::: "memory"); SBAR(); \
      PV_MM4(oa[1], ob[1], c0, d0, c1, d1); \
      PV_READ4(3, H, g0, h0, g1, h1) \
      asm volatile("s_waitcnt lgkmcnt(4)" ::: "memory"); SBAR(); \
      PV_MM4(oa[2], ob[2], e0, f0, e1, f1); \
      asm volatile("s_waitcnt lgkmcnt(0)" ::: "memory"); SBAR(); \
      PV_MM4(oa[3], ob[3], g0, h0, g1, h1); if (widu >= 4) __builtin_amdgcn_s_setprio(1); else __builtin_amdgcn_s_setprio(0); } } while (0)
#define TILE(kb_, vb_, FIRST_) do { HALF(kb_, vb_, 0, FIRST_); HALF(kb_, vb_, 1, false); } while (0)
  const int NT = seq / KVBLK;
  asm volatile("s_waitcnt vmcnt(0)" ::: "memory");
  ADMA(0, 0, 0); ADMA(1, 1, 1);
  AWAIT();
  ADMA(2, 2, 2);
  TILE(0, 0, true);
  int kb = 1, vb4 = 1;
  for (int j = 1; j < NT; ++j) {
    if (j + 1 < NT) { AWAIT(); } else { asm volatile("s_waitcnt vmcnt(0) lgkmcnt(0)" ::: "memory"); __builtin_amdgcn_s_barrier(); asm volatile("" ::: "memory"); }
    if (j + 1 < NT) { const int jn = (j + 2 < NT) ? j + 2 : NT - 1; ADMA(jn, KB3(kb + 2), VB4(vb4 + 2)); }
    TILE(kb, vb4, false);
    kb = KB3(kb + 1); vb4 = VB4(vb4 + 1);
  }
  __builtin_amdgcn_s_setprio(0);
  if (hi == 0) { al_l[r32 - 64] = l0; al_l[r32 - 32] = l1; } asm volatile("s_waitcnt lgkmcnt(0)" ::: "memory");
  float* Ow = Ob + (long)(wid * 64) * LDO;
#pragma unroll
  for (int r = 0; r < 16; ++r) { const int orow = crow(r, hi); const float ra = __builtin_amdgcn_rcpf(al_l[orow - 64]);
#pragma unroll
    for (int d0 = 0; d0 < 4; ++d0) Ow[(long)orow * LDO + d0 * 32 + r32] = oa[d0][r] * ra; }
  SBAR();
#pragma unroll
  for (int r = 0; r < 16; ++r) { const int orow = crow(r, hi); const float rb = __builtin_amdgcn_rcpf(al_l[orow - 32]);
#pragma unroll
    for (int d0 = 0; d0 < 4; ++d0) Ow[(long)(32 + orow) * LDO + d0 * 32 + r32] = ob[d0][r] * rb; }
#undef ADMA
#undef AWAIT
#undef KB3
#undef VB4
#undef SMG
#undef PK4
#undef TILE
#undef HALF
#undef VOFF
#undef KOFF
#undef PV_MM4
#undef PV_READ4
}

typedef short v4i16_t __attribute__((ext_vector_type(4)));
__device__ __forceinline__ s16x4 vtr(int addr) { return __builtin_bit_cast(s16x4, __builtin_amdgcn_ds_read_tr16_b64_v4i16((__attribute__((address_space(3))) v4i16_t*)(uintptr_t)(unsigned)addr)); }
#define PKF(L, H) (bf16x8){L[0], L[1], L[2], L[3], H[0], H[1], H[2], H[3]}
template <int D0, int KS> __device__ __forceinline__ bf16x8 vfragc(int vb) {
  const s16x4 l = vtr(vb + v_rd_off(D0, KS, 0)), h = vtr(vb + v_rd_off(D0, KS, 1));
  return (bf16x8){l[0], l[1], l[2], l[3], h[0], h[1], h[2], h[3]};
}
template <int D0, int KS> __device__ __forceinline__ bf16x8 vfrag(int vb) {
  const s16x4 l = tr_read<v_rd_off(D0, KS, 0)>(vb), h = tr_read<v_rd_off(D0, KS, 1)>(vb);
  asm volatile("s_waitcnt lgkmcnt(0)" ::: "memory"); SBAR();
  return PKF(l, h);
}
#define PK4(P, BASE, OUT) do { unsigned a0 = cvtpk_s(P[BASE + 0], P[BASE + 1]), a1 = cvtpk_s(P[BASE + 2], P[BASE + 3]);   \
    unsigned b0 = cvtpk_s(P[BASE + 4], P[BASE + 5]), b1 = cvtpk_s(P[BASE + 6], P[BASE + 7]);                              \
    auto r0 = __builtin_amdgcn_permlane32_swap(a0, b0, false, false); auto r1 = __builtin_amdgcn_permlane32_swap(a1, b1, false, false); \
    u32x4 w = {r0[0], r1[0], r0[1], r1[1]}; OUT = *reinterpret_cast<bf16x8*>(&w); } while (0)
}

constexpr int NIN = 39;
constexpr int NPHASE = 24;
struct Args { const float* in[NIN]; float* out; unsigned char* ws; int ph_lo, ph_hi; };
enum { I_X = 0, I_C, I_CTX, I_CCTX,
       I_WMOD0, I_BMOD0, I_GPREMIX0, I_GPOSTMIX0, I_WIN0, I_LQ1, I_LK1, I_LQ2, I_LK2, I_GSUBLN, I_GQ, I_GK, I_WOUT0, I_GPREFFN0, I_GPOSTFFN0, I_WROUTER0, I_WGATE0, I_WUP0, I_WDOWN0,
       I_WMOD1, I_BMOD1, I_GPREMIX1, I_GPOSTMIX1, I_WIN1, I_BGATE1, I_WCONV1, I_BCONV1, I_GHEAD1, I_WOUT1, I_GPREFFN1, I_GPOSTFFN1, I_WROUTER1, I_WGATE1, I_WUP1, I_WDOWN1 };

__device__ __forceinline__ void tr_load(const float* __restrict__ W, int N, int k0, int n0, int lane, float (&v)[32]) {
#pragma unroll
    for (int i = 0; i < 32; ++i) { const int kk = 2 * i + (lane >> 5); v[i] = W[(size_t)(k0 + kk) * N + n0 + (lane & 31)]; }
}
__device__ __forceinline__ int win0_phys(int c) {
    if (c < 2048) { const int l = c & 63, n = l >> 5, i = l & 31; return (c & ~63) + 32 * (i >> 4) + 8 * ((i >> 2) & 3) + 4 * n + (i & 3); }
    if (c >= 3072 && c < 4352) { const int l = (c - 3072) & 127, n = l >> 6, i = l & 63; return 3072 + ((c - 3072) & ~127) + 32 * (i >> 4) + 8 * ((i >> 2) & 3) + 4 * n + (i & 3); }
    return c;
}
template <bool QKPERM = false>
__device__ __forceinline__ void tr_store(const float (&v)[32], int k0, bf16_t* WT, size_t out_row0, LAS float* scr, int lane) {
#pragma unroll
    for (int i = 0; i < 32; ++i) { const int kk = 2 * i + (lane >> 5); scr[kk * 33 + (lane & 31)] = v[i]; }
    LDS_WAIT(); asm volatile("" ::: "memory");
    const int c = lane & 7;
#pragma unroll
    for (int j = 0; j < 4; ++j) { const int n = (lane >> 3) + 8 * j; const LAS float* s = scr + (8 * c) * 33 + n;
        u32x4 o; o.x = cvtpk(s[0 * 33], s[1 * 33]); o.y = cvtpk(s[2 * 33], s[3 * 33]); o.z = cvtpk(s[4 * 33], s[5 * 33]); o.w = cvtpk(s[6 * 33], s[7 * 33]);
        const size_t orow = QKPERM ? (size_t)win0_phys((int)out_row0 + n) : out_row0 + n;
        *(u32x4*)(WT + orow * (size_t)D + k0 + 8 * c) = o; }
    LDS_WAIT(); asm volatile("" ::: "memory");
}
template <bool QKPERM = false>
__device__ __forceinline__ void tr_item(const float* __restrict__ W, int N, int k0, int n0, bf16_t* WT, size_t out_row0, LAS float* scr, int lane) {
    float v[32]; tr_load(W, N, k0, n0, lane, v); tr_store<QKPERM>(v, k0, WT, out_row0, scr, lane);
}
struct ExpItem { const float* W; bf16_t* WT; size_t row0; int k0, n0; };
__device__ __forceinline__ ExpItem exp_item(int it, int kind, const float* wg, const float* wu, const float* wd, bf16_t* WGUp, bf16_t* WDp) {
    const int mat = it >> 11, r = it & 2047, kb = r >> 6, nb = r & 63, n0 = 32 * nb;
    const int e = kind == 0 ? mat / 3 : (kind == 1 ? mat >> 1 : mat), which = kind == 0 ? mat % 3 : (kind == 1 ? (mat & 1) : 2);
    ExpItem x; x.k0 = 64 * kb; x.n0 = n0; const size_t eoff = (size_t)e * D * D;
    if (which == 0) { x.W = wg + eoff; x.WT = WGUp; x.row0 = (size_t)e * 4096 + (n0 >> 7) * 256 + (n0 & 127); }
    else if (which == 1) { x.W = wu + eoff; x.WT = WGUp; x.row0 = (size_t)e * 4096 + (n0 >> 7) * 256 + 128 + (n0 & 127); }
    else { x.W = wd + eoff; x.WT = WDp; x.row0 = (size_t)e * 2048 + n0; }
    return x;
}
__device__ __forceinline__ void conv_dyn(unsigned* counter, int total, int kind, const float* wg, const float* wu, const float* wd, bf16_t* WGUp, bf16_t* WDp,
                                         const unsigned* done, unsigned target, LAS float* scr, int lane) {
    for (;;) {
        if (done && __builtin_amdgcn_readfirstlane((int)__hip_atomic_load(done, __ATOMIC_RELAXED, __HIP_MEMORY_SCOPE_AGENT)) >= (int)target) break;
        int it0 = 0; if (lane == 0) it0 = (int)__hip_atomic_fetch_add(counter, 8u, __ATOMIC_RELAXED, __HIP_MEMORY_SCOPE_AGENT);
        it0 = __builtin_amdgcn_readfirstlane(it0);
        if (it0 >= total) break;
#pragma unroll 1
        for (int p = 0; p < 8; p += 2) {
            const ExpItem xa = exp_item(it0 + p, kind, wg, wu, wd, WGUp, WDp), xb = exp_item(it0 + p + 1, kind, wg, wu, wd, WGUp, WDp);
            float va[32], vb[32];
            tr_load(xa.W, D, xa.k0, xa.n0, lane, va); tr_load(xb.W, D, xb.k0, xb.n0, lane, vb);
            tr_store(va, xa.k0, xa.WT, xa.row0, scr, lane); tr_store(vb, xb.k0, xb.WT, xb.row0, scr, lane);
        }
    }
}
__device__ __forceinline__ int gemm_wgs(int nunits, int G) { const int rounds = (nunits + G - 1) / G; return (nunits + rounds - 1) / rounds; }
template <bool QKPERM = false>
__device__ __forceinline__ void conv_plain(const float* W, int N, bf16_t* WT, int item, LAS float* scr, int lane) {
    const int nblk = N / 32, kb = item / nblk, nb = item % nblk;
    tr_item<QKPERM>(W, N, 64 * kb, 32 * nb, WT, (size_t)32 * nb, scr, lane);
}
struct Row { f32x4 v[8]; };
__device__ __forceinline__ void row_load(Row& r, const float* p, int lane) {
#pragma unroll
    for (int j = 0; j < 8; ++j) r.v[j] = *(const f32x4*)(p + 4 * lane + 256 * j);
}
__device__ __forceinline__ void row_load_bf16(Row& r, const bf16_t* p, int lane) {
#pragma unroll
    for (int j = 0; j < 8; ++j) { const u32x2 w = *(const u32x2*)(p + 4 * lane + 256 * j); r.v[j] = (f32x4){bflo(w.x), bfhi(w.x), bflo(w.y), bfhi(w.y)}; }
}
__device__ __forceinline__ float row_ss(const Row& r) { float s = 0.f;
#pragma unroll
    for (int j = 0; j < 8; ++j) s += (r.v[j].x * r.v[j].x + r.v[j].y * r.v[j].y) + (r.v[j].z * r.v[j].z + r.v[j].w * r.v[j].w);
    return wave_sum(s); }
__device__ __forceinline__ void row_store_bf16(const Row& r, bf16_t* p, int lane) {
#pragma unroll
    for (int j = 0; j < 8; ++j) { u32x2 w; w.x = cvtpk(r.v[j].x, r.v[j].y); w.y = cvtpk(r.v[j].z, r.v[j].w); *(u32x2*)(p + 4 * lane + 256 * j) = w; }
}
__device__ __forceinline__ void row_store_f32(const Row& r, float* p, int lane) {
#pragma unroll
    for (int j = 0; j < 8; ++j) *(f32x4*)(p + 4 * lane + 256 * j) = r.v[j];
}
__device__ __forceinline__ void row_norm_mod(Row& x, const float* g, const float* shift, const float* scale, int lane) {
    const float r = rsqrtf(row_ss(x) * (1.f / D) + EPS);
#pragma unroll
    for (int j = 0; j < 8; ++j) { const f32x4 gg = *(const f32x4*)(g + 4 * lane + 256 * j), sh = *(const f32x4*)(shift + 4 * lane + 256 * j), sc = *(const f32x4*)(scale + 4 * lane + 256 * j);
        x.v[j] = (x.v[j] * r) * gg * (sc + 1.f) + sh; }
}

#define MOD ((float*)(ws + WS_MOD))
#define AFFT ((float*)(ws + WS_AFFT))
#define IDX ((int*)(ws + WS_IDX))
#define GATEV ((float*)(ws + WS_GATEV))
#define INV ((int*)(ws + WS_INV))
#define GATES ((float*)(ws + WS_GATES))
#define GB ((float*)(ws + WS_GB))
#define GI ((float*)(ws + WS_GI))
#define NST ((float*)(ws + WS_NST))
#define WIN0 ((bf16_t*)(ws + WS_WIN0))
#define WOUT0 ((bf16_t*)(ws + WS_WOUT0))
#define WIN1 ((bf16_t*)(ws + WS_WIN1))
#define WOUT1 ((bf16_t*)(ws + WS_WOUT1))
#define WGU ((bf16_t*)(ws + WS_WGU))
#define WD ((bf16_t*)(ws + WS_WD))
#define XC ((bf16_t*)(ws + WS_XC))
#define XC2 ((bf16_t*)(ws + WS_XC2))
#define XN ((bf16_t*)(ws + WS_XN))
#define QKV ((bf16_t*)(ws + WS_QKV))
#define QD ((bf16_t*)(ws + WS_QD))
#define AO ((bf16_t*)(ws + WS_AO))
#define Y ((bf16_t*)(ws + WS_Y))
#define OF ((float*)(ws + WS_OF))
#define XE ((bf16_t*)(ws + WS_XE))
#define HID ((bf16_t*)(ws + WS_HID))
#define YE ((bf16_t*)(ws + WS_YE))
#define PROJ ((bf16_t*)(ws + WS_PROJ))
#define QC ((bf16_t*)(ws + WS_QC))
#define KC ((bf16_t*)(ws + WS_KC))
#define CST ((bf16_t*)(ws + WS_CST))
#define HD ((bf16_t*)(ws + WS_HD))
#define RO ((bf16_t*)(ws + WS_RO))
#define Y1 ((bf16_t*)(ws + WS_Y1))
__global__ void __launch_bounds__(NTHREADS, 2) mega(Args a) {
    extern __shared__ __attribute__((aligned(16))) unsigned char lds_raw[];
    LAS unsigned char* lds = (LAS unsigned char*)lds_raw;
    volatile LAS unsigned* MISC = (volatile LAS unsigned*)(lds + MISC_OFF);
    const int wave = wave_id();
    const int G = gridDim.x, bx = blockIdx.x;
    const int gw = bx * NWAVES + wave, NGW = G * NWAVES;
    { const int t0_ = tid_fresh(wave); if (t0_ < 64) MISC[t0_] = 0u; }
    __syncthreads();
    unsigned char* ws = a.ws;
    unsigned* ctl = (unsigned*)(ws + WS_CTL);
    const int lo = a.ph_lo, hi = a.ph_hi;
    const bool use_bar = (hi - lo) > 1;
    XcdBarrier bar; bar.bar = ctl + CW_BAR; bar.x = 0; bar.st = MISC + 8; bar.wave = wave;
    if (use_bar) bar = xcd_barrier_post(ctl + CW_BAR, MISC + 8, wave);
#ifndef PH_MASK
#define PH_MASK 0xFFFFFFu
#endif
#define IN(k) ((((unsigned)PH_MASK >> (k)) & 1u) && lo <= (k) && (k) < hi)
#define SEAM(k) do { if (IN((k) + 1)) xcd_barrier(bar); } while (0)

    if (IN(0)) { const int lane = lane_fresh(), tid = wave * 64 + lane;
        LAS float* scr = (LAS float*)(lds + wave * 16384);
        {
            constexpr int I0 = 32 * (NQKV / 32), I1 = 32 * 64, I2 = 32 * 257, I3 = 32 * 64;
            for (int it = gw; it < I0 + I1 + I2 + I3; it += NGW) {
                int r = it;
                if (r < I0) { conv_plain<true>(a.in[I_WIN0], NQKV, WIN0, r, scr, lane); continue; } r -= I0;
                if (r < I1) { conv_plain(a.in[I_WOUT0], D, WOUT0, r, scr, lane); continue; } r -= I1;
                if (r < I2) { conv_plain(a.in[I_WIN1], 8224, WIN1, r, scr, lane); continue; } r -= I2;
                conv_plain(a.in[I_WOUT1], D, WOUT1, r, scr, lane);
            }
            for (size_t i = (size_t)bx * NTHREADS + tid; i < (size_t)224 * D / 8; i += (size_t)G * NTHREADS) *(u32x4*)(WIN1 + (size_t)8224 * D + i * 8) = (u32x4){0u, 0u, 0u, 0u};
        }
        __syncthreads();
        LAS float* sv = (LAS float*)lds;
        LAS float* red = (LAS float*)(lds + 16384);
        for (int i = tid; i < D; i += NTHREADS) { const float c0 = a.in[I_C][i], c1 = a.in[I_CCTX][i]; sv[i] = c0 * sigmoidf_(c0); sv[D + i] = c1 * sigmoidf_(c1); }
        __syncthreads();
        for (int cb = bx; cb < 256; cb += G) {
            for (int l = 0; l < 2; ++l) {
                const float* W = a.in[l ? I_WMOD1 : I_WMOD0]; const float* bm = a.in[l ? I_BMOD1 : I_BMOD0];
                const int c4 = tid % 12, kg = tid / 12;
                f32x4 a0 = (f32x4){0.f, 0.f, 0.f, 0.f}, a1 = a0;
                if (tid < 504) {
#pragma unroll 8
                    for (int k = kg; k < D; k += 42) { const f32x4 w = *(const f32x4*)(W + (size_t)k * 12288 + 48 * cb + 4 * c4); a0 += w * sv[k]; a1 += w * sv[D + k]; }
                    LAS float* rp = red + (kg * 12 + c4) * 8;
                    *(LAS f32x4*)rp = a0; *(LAS f32x4*)(rp + 4) = a1;
                }
                __syncthreads();
                if (tid < 96) { const int col = tid % 48, set = tid / 48; float s = 0.f;
                    for (int k2 = 0; k2 < 42; ++k2) s += red[(k2 * 12 + col / 4) * 8 + set * 4 + (col & 3)];
                    MOD[(size_t)(l * 2 + set) * 12288 + 48 * cb + col] = s + bm[48 * cb + col]; }
                __syncthreads();
            }
        }
        SEAM(0);
    }

    if (IN(1)) { const int lane = lane_fresh(), tid = wave * 64 + lane;
        for (int t = gw; t < T; t += NGW) {
            const int set = t < CTXL ? 1 : 0;
            const float* src = t < CTXL ? a.in[I_CTX] + (size_t)t * D : a.in[I_X] + (size_t)(t - CTXL) * D;
            const float* md = MOD + (size_t)(0 * 2 + set) * 12288;
            Row x; row_load(x, src, lane);
            row_norm_mod(x, a.in[I_GPREMIX0], md + 0 * D, md + 1 * D, lane);
            row_store_bf16(x, XN + (size_t)t * D, lane);
        }
        SEAM(1);
    }

    if (IN(2)) { const int lane = lane_fresh(), tid = wave * 64 + lane;
        const int GE = gemm_wgs((T / 256) * (NQKV / 256), G);
        if (bx < GE) {
            pg8::Gemm g{XN, WIN0, D, nullptr, 1, 0}; pg8::StaticOrder S; S.init(T / 256, NQKV / 256, GE, bx);
            pg8::EpiRope E{QKV, QD, a.in[I_GQ], a.in[I_GK], (LAS float*)(lds + pg8::STAGE_BYTES)};
            pg8::gemm_phase<pg8::EpiRope, pg8::StaticOrder>(lds, g, S, E, wave);
            if (tid == 0) __hip_atomic_fetch_add(ctl + CW_DONE2, 1u, __ATOMIC_RELAXED, __HIP_MEMORY_SCOPE_AGENT);
        } else conv_dyn(ctl + CW_C0, NE * 3 * 2048, 0, a.in[I_WGATE0], a.in[I_WUP0], a.in[I_WDOWN0], WGU, WD, ctl + CW_DONE2, (unsigned)GE, (LAS float*)(lds + wave * 16384), lane);
        SEAM(2);
    }


    if (IN(4)) { const int lane = lane_fresh(), tid = wave * 64 + lane;
        float lam;
        { int ln = lane_fresh();
          const float p1 = a.in[I_LQ1][ln] * a.in[I_LK1][ln], p2 = a.in[I_LQ2][ln] * a.in[I_LK2][ln];
          lam = __expf(wave_sum_bp(p1)) - __expf(wave_sum_bp(p2)) + 0.2f; }
        const int vbx = (G % 8 == 0) ? (bx % 8) * (G / 8) + bx / 8 : bx;
        for (int u = vbx; u < 784; u += G) {
            const bool isctx = u >= 768; const bool big = u < 256;
            const int uu = isctx ? u - 768 : (big ? u : u - 256);
            const bool diff = big || (isctx && uu < 8);
            const int h = isctx ? (uu & 7) : (big ? (uu >> 5) : ((uu >> 6) & 7)), qb = isctx ? 0 : (big ? (uu & 31) : (uu & 63));
            const int row0 = isctx ? 0 : CTXL + qb * (big ? 512 : 256), seq = isctx ? CTXL : T;
            const int nm = diff ? 2 : 1;
            for (int m = 0; m < nm; ++m) {
                const int hc = diff ? (2 * h + m) * 128 : 2048 + h * 128;
                const bf16_t* Qb = QD + (size_t)row0 * NQD + (diff ? (2 * h + m) * 64 : 1024 + h * 128);
                const bf16_t* Kh = QD + (diff ? 2048 + (2 * h + m) * 64 : 3072 + (h >> 2) * 128);
                const bf16_t* Vh = QKV + (diff ? 2048 + h * 128 : 4352 + (h >> 2) * 128);
                if (big) att::attn_diff512(Qb, Kh, Vh, OF + (size_t)row0 * NOF + hc, seq, (char*)lds_raw, wave);
                else if (diff) att::attn_dense_body2<64>(Qb, Kh, Vh, OF + (size_t)row0 * NOF + hc, seq, (char*)lds_raw, wave);
                else att::attn_dense_body2<128>(Qb, Kh, Vh, (float*)(AO + (size_t)row0 * D + 1024 + h * 128), seq, (char*)lds_raw, wave);
                __syncthreads();
            }
            if (!diff) continue;
            VM_WAIT();
            int lane = lane_fresh();
            const float g0 = a.in[I_GSUBLN][2 * lane] * 0.8f, g1 = a.in[I_GSUBLN][2 * lane + 1] * 0.8f;
            const int nr = big ? 64 : 32;
            for (int rr = 0; rr < nr; ++rr) {
                const int row = row0 + wave * nr + rr;
                const f32x2 o1 = *(const f32x2*)(OF + (size_t)row * NOF + (2 * h) * 128 + 2 * lane), o2 = *(const f32x2*)(OF + (size_t)row * NOF + (2 * h + 1) * 128 + 2 * lane);
                const float v0 = o1.x - lam * o2.x, v1 = o1.y - lam * o2.y;
                const float rn = rsqrtf(wave_sum_bp(v0 * v0 + v1 * v1) * (1.f / 128.f) + EPS);
                *(unsigned*)(AO + (size_t)row * D + h * 128 + 2 * lane) = cvtpk(v0 * rn * g0, v1 * rn * g1);
            }
        }
        SEAM(4);
    }

    if (IN(5)) { const int lane = lane_fresh(), tid = wave * 64 + lane;
        const int GE = gemm_wgs((T / 256) * (D / 256), G);
        if (bx < GE) {
            pg8::Gemm g{AO, WOUT0, D, nullptr, 1, 0}; pg8::StaticOrder S; S.init(T / 256, D / 256, GE, bx);
            pg8::EpiBf16 E{Y, D, 1 << 30, nullptr};
            pg8::gemm_phase<pg8::EpiBf16, pg8::StaticOrder>(lds, g, S, E, wave);
            if (tid == 0) __hip_atomic_fetch_add(ctl + CW_DONE5, 1u, __ATOMIC_RELAXED, __HIP_MEMORY_SCOPE_AGENT);
        } else conv_dyn(ctl + CW_C0, NE * 3 * 2048, 0, a.in[I_WGATE0], a.in[I_WUP0], a.in[I_WDOWN0], WGU, WD, ctl + CW_DONE5, (unsigned)GE, (LAS float*)(lds + wave * 16384), lane);
        SEAM(5);
    }

#define PHASE_POSTMIX(LAYER, YBUF, T0, G_POST, G_PREFFN, W_ROUTER) do { \
        LAS float* wt = (LAS float*)lds;                                    \
        _Pragma("unroll") for (int rb = 0; rb < 2; ++rb) { f32x4 wv[8]; \
            _Pragma("unroll") for (int r = 0; r < 8; ++r) wv[r] = *(const f32x4*)((W_ROUTER) + 4 * (tid + NTHREADS * (rb * 8 + r))); \
            _Pragma("unroll") for (int r = 0; r < 8; ++r) { const int i4 = tid + NTHREADS * (rb * 8 + r); const int k = i4 >> 2, e0 = (i4 & 3) * 4; \
                wt[(e0 + 0) * D + k] = wv[r].x; wt[(e0 + 1) * D + k] = wv[r].y; wt[(e0 + 2) * D + k] = wv[r].z; wt[(e0 + 3) * D + k] = wv[r].w; } } \
        __syncthreads(); \
          \
        int cur_set = -1; f32x4 pg[8], ps[8], sh[8]; \
        for (int t = (T0) + gw; t < T; t += NGW) { \
            const int set = t < CTXL ? 1 : 0; \
            if (set != cur_set) { cur_set = set; const float* md = MOD + (size_t)((LAYER) * 2 + set) * 12288; \
                _Pragma("unroll") for (int j = 0; j < 8; ++j) { const int c = 4 * lane + 256 * j; \
                    pg[j] = *(const f32x4*)((G_POST) + c) * *(const f32x4*)(md + 2 * D + c); ps[j] = *(const f32x4*)((G_PREFFN) + c) * (*(const f32x4*)(md + 4 * D + c) + 1.f); sh[j] = *(const f32x4*)(md + 3 * D + c); } } \
            u32x2 yr[8]; Row x; \
            { const bf16_t* yp = (YBUF) + (size_t)t * D + 4 * lane; _Pragma("unroll") for (int j = 0; j < 8; ++j) yr[j] = *(const u32x2*)(yp + 256 * j); } \
            if ((LAYER) == 0) row_load(x, t < CTXL ? a.in[I_CTX] + (size_t)t * D : a.in[I_X] + (size_t)(t - CTXL) * D, lane); \
            else { u32x2 xr[8]; const bf16_t* xp = XC2 + (size_t)t * D + 4 * lane; _Pragma("unroll") for (int j = 0; j < 8; ++j) xr[j] = *(const u32x2*)(xp + 256 * j); \
                   __builtin_amdgcn_sched_barrier(0); \
                   _Pragma("unroll") for (int j = 0; j < 8; ++j) x.v[j] = (f32x4){bflo(xr[j].x), bfhi(xr[j].x), bflo(xr[j].y), bfhi(xr[j].y)}; } \
            __builtin_amdgcn_sched_barrier(0); \
            Row y; _Pragma("unroll") for (int j = 0; j < 8; ++j) y.v[j] = (f32x4){bflo(yr[j].x), bfhi(yr[j].x), bflo(yr[j].y), bfhi(yr[j].y)}; \
            const float ry = rsqrtf(row_ss(y) * (1.f / D) + EPS); \
            _Pragma("unroll") for (int j = 0; j < 8; ++j) x.v[j] = x.v[j] + pg[j] * (y.v[j] * ry); \
            row_store_bf16(x, XC + (size_t)t * D, lane); \
            { const float r = rsqrtf(row_ss(x) * (1.f / D) + EPS); _Pragma("unroll") for (int j = 0; j < 8; ++j) x.v[j] = (x.v[j] * r) * ps[j] + sh[j]; } \
            row_store_bf16(x, XN + (size_t)t * D, lane); \
            float lg[NE]; \
            {     \
                const LAS float* wl = wt + 4 * lane; f32x4 wA[4], wB[4]; \
                _Pragma("unroll") for (int j = 0; j < 4; ++j) wA[j] = *(const LAS f32x4*)(wl + 256 * j); \
                _Pragma("unroll") for (int e = 0; e < NE; ++e) { float s = 0.f; \
                    _Pragma("unroll") for (int j = 0; j < 4; ++j) wB[j] = *(const LAS f32x4*)(wl + e * D + 256 * (4 + j)); \
                    __builtin_amdgcn_sched_barrier(0); \
                    _Pragma("unroll") for (int j = 0; j < 4; ++j) s += (x.v[j].x * wA[j].x + x.v[j].y * wA[j].y) + (x.v[j].z * wA[j].z + x.v[j].w * wA[j].w); \
                    if (e + 1 < NE) { _Pragma("unroll") for (int j = 0; j < 4; ++j) wA[j] = *(const LAS f32x4*)(wl + (e + 1) * D + 256 * j); } \
                    __builtin_amdgcn_sched_barrier(0); \
                    _Pragma("unroll") for (int j = 0; j < 4; ++j) s += (x.v[4 + j].x * wB[j].x + x.v[4 + j].y * wB[j].y) + (x.v[4 + j].z * wB[j].z + x.v[4 + j].w * wB[j].w); \
                    lg[e] = s; } \
                _Pragma("unroll") for (int e = 0; e < NE; ++e) lg[e] = wave_sum(lg[e]); } \
            float mx = lg[0]; _Pragma("unroll") for (int e = 1; e < NE; ++e) mx = fmaxf(mx, lg[e]); \
            float sm = 0.f; _Pragma("unroll") for (int e = 0; e < NE; ++e) { lg[e] = __expf(lg[e] - mx); sm += lg[e]; } \
            const float inv = 1.f / sm; float mine = 0.f; \
            _Pragma("unroll") for (int e = 0; e < NE; ++e) mine = (lane == e) ? lg[e] * inv : mine; \
            if (lane < NE) AFFT[(size_t)lane * T + t] = mine; \
        } \
        __syncthreads(); \
    } while (0)

#define PHASE_TOPK(NTASK) do { \
        LAS unsigned* shc = (LAS unsigned*)lds;                         \
        for (int task = bx; task < (NTASK); task += G) { \
            const int e = task & 15, set = task >> 4; \
            const int n = set ? CTXL : SEQ, cap = set ? 32 : 2048, tbase = set ? 0 : CTXL, slot0 = set ? 2048 : 0; \
            const bool own = 32 * tid < n; \
            unsigned key[32]; \
            { const float* src = AFFT + (size_t)e * T + tbase + 32 * tid; \
              _Pragma("unroll") for (int j8 = 0; j8 < 8; ++j8) { f32x4 v = (f32x4){0.f, 0.f, 0.f, 0.f}; if (own) v = *(const f32x4*)(src + 4 * j8); \
                  key[4 * j8] = __float_as_uint(v.x); key[4 * j8 + 1] = __float_as_uint(v.y); key[4 * j8 + 2] = __float_as_uint(v.z); key[4 * j8 + 3] = __float_as_uint(v.w); } } \
            unsigned thr = 0u; \
            for (int bit = 30; bit >= 0; --bit) { \
                const unsigned cand = thr | (1u << bit); int cnt = 0; \
                _Pragma("unroll") for (int j = 0; j < 32; ++j) cnt += (key[j] >= cand) ? 1 : 0; \
                cnt = wave_sum_i(cnt); \
                if (lane == 0) shc[(bit & 1) * 8 + wave] = (unsigned)cnt; \
                __syncthreads(); \
                unsigned tot = 0u; _Pragma("unroll") for (int w2 = 0; w2 < NWAVES; ++w2) tot += shc[(bit & 1) * 8 + w2]; \
                if (tot >= (unsigned)cap) thr = cand; \
            } \
            int gtc = 0, eqc = 0; \
            _Pragma("unroll") for (int j = 0; j < 32; ++j) { gtc += (key[j] > thr) ? 1 : 0; eqc += (key[j] == thr) ? 1 : 0; } \
              \
            int inc = eqc, gsum = gtc; \
            _Pragma("unroll") for (int o = 1; o < 64; o <<= 1) { const int v = __shfl_up(inc, o); if (lane >= o) inc += v; gsum += __shfl_xor(gsum, o); } \
            __syncthreads(); \
            if (lane == 63) shc[16 + wave] = (unsigned)inc; if (lane == 0) shc[24 + wave] = (unsigned)gsum; \
            __syncthreads(); \
            int ex_eq = inc - eqc, tot_gt = 0; \
            _Pragma("unroll") for (int w2 = 0; w2 < NWAVES; ++w2) { if (w2 < wave) ex_eq += (int)shc[16 + w2]; tot_gt += (int)shc[24 + w2]; } \
            const int krem = cap - tot_gt;                              \
            int allow = krem - ex_eq; allow = allow < 0 ? 0 : (allow > eqc ? eqc : allow); \
            const int takec = gtc + allow; \
            int inc2 = takec; \
            _Pragma("unroll") for (int o = 1; o < 64; o <<= 1) { const int v = __shfl_up(inc2, o); if (lane >= o) inc2 += v; } \
            if (lane == 63) shc[32 + wave] = (unsigned)inc2; \
            __syncthreads(); \
            int slot = slot0 + inc2 - takec; \
            _Pragma("unroll") for (int w2 = 0; w2 < NWAVES; ++w2) { if (w2 < wave) slot += (int)shc[32 + w2]; } \
            if (own) { int eqs = 0; int invv[32]; \
                _Pragma("unroll") for (int j = 0; j < 32; ++j) { const unsigned k = key[j]; const bool eq = k == thr; const bool take = k > thr || (eq && eqs < allow); eqs += eq ? 1 : 0; \
                    invv[j] = take ? slot : -1; \
                    if (take) { IDX[e * IDXS + slot] = tbase + 32 * tid + j; GATEV[e * IDXS + slot] = __uint_as_float(k); ++slot; } } \
                int* ip = INV + (size_t)e * T + tbase + 32 * tid; \
                _Pragma("unroll") for (int j4 = 0; j4 < 8; ++j4) *(u32x4*)(ip + 4 * j4) = (u32x4){(unsigned)invv[4 * j4], (unsigned)invv[4 * j4 + 1], (unsigned)invv[4 * j4 + 2], (unsigned)invv[4 * j4 + 3]}; } \
            __syncthreads(); \
        } \
    } while (0)

#define PHASE_GATHER(RPE, NVALID) do { \
        for (int r = gw; r < NE * (RPE); r += NGW) { \
            const int e = r / (RPE), slot = r - e * (RPE); \
            u32x4 v0 = {0u, 0u, 0u, 0u}, v1 = v0, v2 = v0, v3 = v0; \
            if (slot < (NVALID)) { const bf16_t* s = XN + (size_t)IDX[e * IDXS + slot] * D; \
                v0 = *(const u32x4*)(s + 8 * lane); v1 = *(const u32x4*)(s + 512 + 8 * lane); v2 = *(const u32x4*)(s + 1024 + 8 * lane); v3 = *(const u32x4*)(s + 1536 + 8 * lane); } \
            bf16_t* dd = XE + (size_t)r * D; \
            *(u32x4*)(dd + 8 * lane) = v0; *(u32x4*)(dd + 512 + 8 * lane) = v1; *(u32x4*)(dd + 1024 + 8 * lane) = v2; *(u32x4*)(dd + 1536 + 8 * lane) = v3; \
        } \
    } while (0)

#define COMBINE_LOOP(LAYER, RPE, G_POSTFFN, T0, BODY) do { \
        int cur_set = -1; f32x4 pq[8]; \
        int slot_n = -1; u32x2 xr_n[8]; \
        { const int t = (T0) + gw; if (t < T) { slot_n = lane < NE ? INV[(size_t)lane * T + t] : -1; \
            const bf16_t* xp = XC + (size_t)t * D + 4 * lane; _Pragma("unroll") for (int j = 0; j < 8; ++j) xr_n[j] = *(const u32x2*)(xp + 256 * j); } } \
        for (int t = (T0) + gw; t < T; t += NGW) { \
            const int slotv = slot_n; u32x2 xr[8]; _Pragma("unroll") for (int j = 0; j < 8; ++j) xr[j] = xr_n[j]; \
            { const int t2 = t + NGW; if (t2 < T) { slot_n = lane < NE ? INV[(size_t)lane * T + t2] : -1; \
                const bf16_t* xp = XC + (size_t)t2 * D + 4 * lane; _Pragma("unroll") for (int j = 0; j < 8; ++j) xr_n[j] = *(const u32x2*)(xp + 256 * j); } } \
            const int set_ = t < CTXL ? 1 : 0; \
            if (set_ != cur_set) { cur_set = set_; const float* md_ = MOD + (size_t)((LAYER) * 2 + set_) * 12288; \
                _Pragma("unroll") for (int j = 0; j < 8; ++j) { const int c = 4 * lane + 256 * j; pq[j] = *(const f32x4*)((G_POSTFFN) + c) * *(const f32x4*)(md_ + 5 * D + c); } } \
            Row mo; _Pragma("unroll") for (int j = 0; j < 8; ++j) mo.v[j] = (f32x4){0.f, 0.f, 0.f, 0.f}; \
            unsigned mask = (unsigned)__ballot(slotv >= 0) & 0xffffu; \
            while (mask) { \
                const int e0 = __builtin_ctz(mask); mask &= mask - 1u; const bool two = mask != 0u; const int e1 = two ? __builtin_ctz(mask) : e0; mask &= mask - 1u; \
                const int s0 = __builtin_amdgcn_readlane(slotv, e0), s1 = __builtin_amdgcn_readlane(slotv, e1); \
                const bf16_t* y0 = YE + ((size_t)e0 * (RPE) + s0) * D + 4 * lane; const bf16_t* y1 = YE + ((size_t)e1 * (RPE) + s1) * D + 4 * lane; \
                u32x2 w0[8], w1[8]; \
                _Pragma("unroll") for (int j = 0; j < 8; ++j) w0[j] = *(const u32x2*)(y0 + 256 * j); \
                _Pragma("unroll") for (int j = 0; j < 8; ++j) w1[j] = *(const u32x2*)(y1 + 256 * j); \
                __builtin_amdgcn_sched_barrier(0); \
                _Pragma("unroll") for (int j = 0; j < 8; ++j) { mo.v[j].x += bflo(w0[j].x); mo.v[j].y += bfhi(w0[j].x); mo.v[j].z += bflo(w0[j].y); mo.v[j].w += bfhi(w0[j].y); } \
                if (two) { _Pragma("unroll") for (int j = 0; j < 8; ++j) { mo.v[j].x += bflo(w1[j].x); mo.v[j].y += bfhi(w1[j].x); mo.v[j].z += bflo(w1[j].y); mo.v[j].w += bfhi(w1[j].y); } } \
            } \
            const float rm = rsqrtf(row_ss(mo) * (1.f / D) + EPS); \
            Row x; _Pragma("unroll") for (int j = 0; j < 8; ++j) { const f32x4 xv = {bflo(xr[j].x), bfhi(xr[j].x), bflo(xr[j].y), bfhi(xr[j].y)}; x.v[j] = xv + pq[j] * (mo.v[j] * rm); } \
            BODY \
        } \
    } while (0)

    if (IN(6)) { const int lane = lane_fresh(), tid = wave * 64 + lane; PHASE_POSTMIX(0, Y, 0, a.in[I_GPOSTMIX0], a.in[I_GPREFFN0], a.in[I_WROUTER0]);
        conv_dyn(ctl + CW_C0, NE * 3 * 2048, 0, a.in[I_WGATE0], a.in[I_WUP0], a.in[I_WDOWN0], WGU, WD, nullptr, 0u, (LAS float*)(lds + wave * 16384), lane);
        SEAM(6); }
    if (IN(7)) { const int lane = lane_fresh(), tid = wave * 64 + lane; PHASE_TOPK(32); SEAM(7); }
    if (IN(9)) { const int lane = lane_fresh(), tid = wave * 64 + lane;
        pg8::Gemm g{XN, WGU, D, IDX, 2304, 2080}; pg8::GroupedOrder S; S.init(9, 16, G, bx);
        pg8::EpiSwiGLU E{HID};
        pg8::gemm_phase<pg8::EpiSwiGLU, pg8::GroupedOrder, true>(lds, g, S, E, wave);
        SEAM(9);
    }
    if (IN(10)) { const int lane = lane_fresh(), tid = wave * 64 + lane;
        const int GE = gemm_wgs(NE * 9 * 8, G);
        if (bx < GE) {
            pg8::Gemm g{HID, WD, D, nullptr, 1, 0}; pg8::GroupedOrder S; S.init(9, 8, GE, bx);
            pg8::EpiDown E{YE, GATEV, 2304};
            pg8::gemm_phase<pg8::EpiDown, pg8::GroupedOrder>(lds, g, S, E, wave);
            if (tid == 0) __hip_atomic_fetch_add(ctl + CW_DONE10, 1u, __ATOMIC_RELAXED, __HIP_MEMORY_SCOPE_AGENT);
        } else conv_dyn(ctl + CW_C1A, NE * 2 * 2048, 1, a.in[I_WGATE1], a.in[I_WUP1], a.in[I_WDOWN1], WGU, WD, ctl + CW_DONE10, (unsigned)GE, (LAS float*)(lds + wave * 16384), lane);
        SEAM(10);
    }
    if (IN(11)) { const int lane = lane_fresh(), tid = wave * 64 + lane;
        int nset = -1; f32x4 ps[8], sh[8];
        COMBINE_LOOP(0, 2304, a.in[I_GPOSTFFN0], 0, {
            row_store_bf16(x, XC2 + (size_t)t * D, lane);
            if (set_ != nset) { nset = set_; const float* md = MOD + (size_t)(1 * 2 + set_) * 12288;
_Pragma("unroll")
                for (int j = 0; j < 8; ++j) { const int c = 4 * lane + 256 * j; ps[j] = *(const f32x4*)(a.in[I_GPREMIX1] + c) * (*(const f32x4*)(md + 1 * D + c) + 1.f); sh[j] = *(const f32x4*)(md + c); } }
            { const float r = rsqrtf(row_ss(x) * (1.f / D) + EPS);
_Pragma("unroll")
              for (int j = 0; j < 8; ++j) x.v[j] = (x.v[j] * r) * ps[j] + sh[j]; }
            row_store_bf16(x, XN + (size_t)t * D, lane); });
        SEAM(11);
    }

    if (IN(12)) { const int lane = lane_fresh(), tid = wave * 64 + lane;
        const int GE = gemm_wgs((T / 256) * (NPROJ_PAD / 256), G);
        if (bx < GE) {
            pg8::Gemm g{XN, WIN1, D, nullptr, 1, 0}; pg8::StaticOrder S; S.init(T / 256, NPROJ_PAD / 256, GE, bx);
            pg8::EpiBf16 E{PROJ, NPROJ, 32, GATES};
            pg8::gemm_phase<pg8::EpiBf16, pg8::StaticOrder>(lds, g, S, E, wave);
            if (tid == 0) __hip_atomic_fetch_add(ctl + CW_DONE12, 1u, __ATOMIC_RELAXED, __HIP_MEMORY_SCOPE_AGENT);
        } else {
            conv_dyn(ctl + CW_C1A, NE * 2 * 2048, 1, a.in[I_WGATE1], a.in[I_WUP1], a.in[I_WDOWN1], WGU, WD, ctl + CW_DONE12, (unsigned)GE, (LAS float*)(lds + wave * 16384), lane);
            conv_dyn(ctl + CW_C1B, NE * 2048, 2, a.in[I_WGATE1], a.in[I_WUP1], a.in[I_WDOWN1], WGU, WD, ctl + CW_DONE12, (unsigned)GE, (LAS float*)(lds + wave * 16384), lane);
        }
        SEAM(12);
    }

    if (IN(13)) { const int lane = lane_fresh(), tid = wave * 64 + lane;
        {
            const int c0 = tid * 8;
            const float* wc = a.in[I_WCONV1] + c0; const float* bc = a.in[I_BCONV1] + c0;
            const f32x4 wma = *(const f32x4*)(wc), wmb = *(const f32x4*)(wc + 4), w0a = *(const f32x4*)(wc + 4096), w0b = *(const f32x4*)(wc + 4100), wpa = *(const f32x4*)(wc + 8192), wpb = *(const f32x4*)(wc + 8196);
            const f32x4 bca = *(const f32x4*)(bc), bcb = *(const f32x4*)(bc + 4);
            const float wm[8] = {wma.x, wma.y, wma.z, wma.w, wmb.x, wmb.y, wmb.z, wmb.w}, w0[8] = {w0a.x, w0a.y, w0a.z, w0a.w, w0b.x, w0b.y, w0b.z, w0b.w};
            const float wp[8] = {wpa.x, wpa.y, wpa.z, wpa.w, wpb.x, wpb.y, wpb.z, wpb.w}, bb[8] = {bca.x, bca.y, bca.z, bca.w, bcb.x, bcb.y, bcb.z, bcb.w};
            const float osc = c0 >= 2048 ? 0.0625f : 1.f;
            bf16_t* dst = c0 < 2048 ? QC + c0 : KC + (c0 - 2048);
            const bf16_t* src = PROJ + c0;
            const int TPW = (T + G - 1) / G; const int t0 = bx * TPW, t1 = (t0 + TPW < T) ? t0 + TPW : T;
            const u32x4 z = {0u, 0u, 0u, 0u};
            u32x4 prev = z, cur = z;
            if (t0 < t1) { if (t0 > 0) prev = *(const u32x4*)(src + (size_t)(t0 - 1) * NPROJ); cur = *(const u32x4*)(src + (size_t)t0 * NPROJ); }
            u32x4 nn[8];
#pragma unroll
            for (int i = 0; i < 8; ++i) { const int row = t0 + 1 + i; nn[i] = (t0 < t1 && row <= t1 && row < T) ? *(const u32x4*)(src + (size_t)row * NPROJ) : z; }
            for (int t = t0; t < t1; t += 8) {
                u32x4 nx[8];
#pragma unroll
                for (int i = 0; i < 8; ++i) nx[i] = nn[i];
                if (t + 8 < t1) {
#pragma unroll
                    for (int i = 0; i < 8; ++i) { const int row = t + 9 + i; nn[i] = (row <= t1 && row < T) ? *(const u32x4*)(src + (size_t)row * NPROJ) : z; }
                }
                __builtin_amdgcn_sched_barrier(0);
#pragma unroll
                for (int i = 0; i < 8; ++i) { const int tt = t + i;
                    if (tt < t1) {
                        const u32x4 xm = (tt == 0 || tt == CTXL) ? z : prev, xp = (tt + 1 == CTXL || tt + 1 == T) ? z : nx[i];
                        const unsigned am[4] = {xm.x, xm.y, xm.z, xm.w}, a0[4] = {cur.x, cur.y, cur.z, cur.w}, ap[4] = {xp.x, xp.y, xp.z, xp.w};
                        float yv[8];
#pragma unroll
                        for (int j = 0; j < 8; ++j) { const int w = j >> 1; const bool hh = j & 1;
                            const float vm = hh ? bfhi(am[w]) : bflo(am[w]), v0 = hh ? bfhi(a0[w]) : bflo(a0[w]), vp = hh ? bfhi(ap[w]) : bflo(ap[w]);
                            float y = wm[j] * vm + w0[j] * v0 + wp[j] * vp + bb[j];
                            y = y * sigmoidf_(y); yv[j] = y * osc; }
                        u32x4 o; o.x = cvtpk(yv[0], yv[1]); o.y = cvtpk(yv[2], yv[3]); o.z = cvtpk(yv[4], yv[5]); o.w = cvtpk(yv[6], yv[7]);
                        *(u32x4*)(dst + (size_t)tt * D) = o;
                        prev = cur; cur = nx[i];
                    } }
            }
        }
        const float* bg = a.in[I_BGATE1];
        for (int it = gw; it < 16 * NCH; it += NGW) {
            const int hd = it / NCH, i = it % NCH, d = hd >> 3, h = hd & 7;
            const int cc = d ? (i < 2 ? 1 - i : 131 - i) : i; const int base = cc * 128;
            const int s0 = 2 * lane, s1 = 2 * lane + 1;
            const int r0 = base + (d ? 127 - s0 : s0), r1 = base + (d ? 127 - s1 : s1);
            const float ig0 = GATES[(size_t)r0 * 32 + d * 16 + h] + bg[d * 16 + h], ig1 = GATES[(size_t)r1 * 32 + d * 16 + h] + bg[d * 16 + h];
            const float f0 = GATES[(size_t)r0 * 32 + d * 16 + 8 + h] + bg[d * 16 + 8 + h], f1 = GATES[(size_t)r1 * 32 + d * 16 + 8 + h] + bg[d * 16 + 8 + h];
            const float lf0 = fminf(f0, 0.f) - log1pf(__expf(-fabsf(f0))), lf1 = fminf(f1, 0.f) - log1pf(__expf(-fabsf(f1)));
            const float c1 = lf0 + lf1; float inc = c1;
#pragma unroll
            for (int ofs = 1; ofs < 64; ofs <<= 1) { const float v = __shfl_up(inc, ofs); if (lane >= ofs) inc += v; }
            const float ex = inc - c1;
            float* gbp = GB + (size_t)it * 128; float* gip = GI + (size_t)it * 128;
            *(f32x2*)(gbp + s0) = (f32x2){ex + lf0, ex + c1}; *(f32x2*)(gip + s0) = (f32x2){ig0, ig1};
        }
        conv_dyn(ctl + CW_C1A, NE * 2 * 2048, 1, a.in[I_WGATE1], a.in[I_WUP1], a.in[I_WDOWN1], WGU, WD, nullptr, 0u, (LAS float*)(lds + wave * 16384), lane);
        conv_dyn(ctl + CW_C1B, NE * 2048, 2, a.in[I_WGATE1], a.in[I_WUP1], a.in[I_WDOWN1], WGU, WD, nullptr, 0u, (LAS float*)(lds + wave * 16384), lane);
        SEAM(13);
    }

    if (IN(14)) { const int lane = lane_fresh(), tid = wave * 64 + lane;
        LAS char* tiles = (LAS char*)lds;
        LAS float* wbuf = (LAS float*)(lds + 131072);
        LAS float* nred = (LAS float*)(lds + 131072 + 2048);
#define M1_BAR() do { asm volatile("s_waitcnt lgkmcnt(0)" ::: "memory"); __builtin_amdgcn_s_barrier(); asm volatile("" ::: "memory"); } while (0)
        for (int vb_ = bx; vb_ < 256; vb_ += G) {
            const int h = vb_ & 7, lx = vb_ >> 3, d = lx >> 4, tile = lx & 15, idk = tile >> 2, idv = tile & 3, hd = d * 8 + h;
            __syncthreads();
            if (wave < 4) {
                const int r32 = lane & 31, hi5 = lane >> 5, tm = wave & 1, tn = wave >> 1;
                f32x16 acc = f32x16{};
                float nacc = 0.f, decay_prev = 0.f;
                float bl_next = GB[((size_t)hd * NCH + 0) * 128 + 127];
                float gb_n = 0.f, gi_n = 0.f, bl_n = 0.f;
                if (tid < 128) { const size_t g0 = ((size_t)hd * NCH + 0) * 128; wbuf[tid] = __expf(GB[g0 + 127] - GB[g0 + tid] + GI[g0 + tid]);
                                 const size_t g1 = g0 + 128; gb_n = GB[g1 + tid]; gi_n = GI[g1 + tid]; bl_n = GB[g1 + 127]; }
                for (int i = 0; i < NCH; ++i) {
                    const int cur = i & 3;
                    const float decay = __expf(bl_next);
                    if (i + 1 < NCH) bl_next = GB[((size_t)hd * NCH + i + 1) * 128 + 127];
                    M1_BAR();
                    if (tid < 128) { if (i + 1 < NCH) wbuf[((i + 1) & 3) * 128 + tid] = __expf(bl_n - gb_n + gi_n);
                                     if (i + 2 < NCH) { const size_t g2 = ((size_t)hd * NCH + i + 2) * 128; gb_n = GB[g2 + tid]; gi_n = GI[g2 + tid]; bl_n = GB[g2 + 127]; } }
                    if (idv == 0 && wave == 0) {
                        if (i > 0) { const LAS float* nr = nred + ((i - 1) & 1) * 256;
                            nacc = decay_prev * nacc + ((nr[lane] + nr[64 + lane]) + (nr[128 + lane] + nr[192 + lane])); }
                        NST[((size_t)hd * NCH + i) * 256 + idk * 64 + lane] = nacc;
                    }
                    decay_prev = decay;
                    if (i >= 2) { bf16_t* cp = CST + (((size_t)hd * NCH + i) * 256 + idk * 64 + 32 * tm) * 256 + idv * 64 + 32 * tn + r32;
#pragma unroll
                        for (int r = 0; r < 16; ++r) cp[(size_t)crow(r, hi5) * 256] = (bf16_t)(cvtpk(acc[r], acc[r]) & 0xffffu); }
#pragma unroll
                    for (int r = 0; r < 16; ++r) acc[r] *= decay;
#pragma unroll
                    for (int kh = 0; kh < 2; ++kh) {
                        const int vbase = (int)(uintptr_t)(tiles + cur * 32768 + kh * 16384) + att::v_rd_base(lane);
                        bf16x8 A[4], B[4];
                        if (tm == 0) { A[0] = att::vfragc<0, 0>(vbase); A[1] = att::vfragc<0, 1>(vbase); A[2] = att::vfragc<0, 2>(vbase); A[3] = att::vfragc<0, 3>(vbase); }
                        else         { A[0] = att::vfragc<1, 0>(vbase); A[1] = att::vfragc<1, 1>(vbase); A[2] = att::vfragc<1, 2>(vbase); A[3] = att::vfragc<1, 3>(vbase); }
                        if (tn == 0) { B[0] = att::vfragc<2, 0>(vbase); B[1] = att::vfragc<2, 1>(vbase); B[2] = att::vfragc<2, 2>(vbase); B[3] = att::vfragc<2, 3>(vbase); }
                        else         { B[0] = att::vfragc<3, 0>(vbase); B[1] = att::vfragc<3, 1>(vbase); B[2] = att::vfragc<3, 2>(vbase); B[3] = att::vfragc<3, 3>(vbase); }
#pragma unroll
                        for (int ks = 0; ks < 4; ++ks) {
                            const LAS float* wp = wbuf + cur * 128 + 64 * kh + 16 * ks + 8 * hi5;
                            const f32x4 wa = *(const LAS f32x4*)wp, wb = *(const LAS f32x4*)(wp + 4);
                            u32x4 aw = *reinterpret_cast<u32x4*>(&A[ks]);
                            aw.x = cvtpk_s(bflo(aw.x) * wa.x, bfhi(aw.x) * wa.y); aw.y = cvtpk_s(bflo(aw.y) * wa.z, bfhi(aw.y) * wa.w);
                            aw.z = cvtpk_s(bflo(aw.z) * wb.x, bfhi(aw.z) * wb.y); aw.w = cvtpk_s(bflo(aw.w) * wb.z, bfhi(aw.w) * wb.w);
                            acc = __builtin_amdgcn_mfma_f32_32x32x16_bf16(*reinterpret_cast<bf16x8*>(&aw), B[ks], acc, 0, 0, 0);
                        }
                    }
                }
            } else {
                const int lw = wave - 4, lt = tid - 256;
                int ps_[8]; const char* pb_[8]; int pp_[8];
#pragma unroll
                for (int j_ = 0; j_ < 8; ++j_) { const int P_ = (lw * 8 + j_) * 64 + lane; const int th_ = P_ >> 10; const int o_ = (P_ & 1023) * 16; const int sub_ = o_ >> 9, wi_ = o_ & 511;
                    const int kk_ = ((sub_ >> 2) << 3) | (wi_ >> 6); const int k_ = (kk_ & ~0xC) | ((kk_ & 4) << 1) | ((kk_ & 8) >> 1); const int c_ = ((sub_ & 3) << 5) | ((wi_ & 63) >> 1);
                    ps_[j_] = 64 * th_ + k_;
                    pb_[j_] = (c_ < 64) ? (const char*)(KC + h * 256 + idk * 64 + c_) : (const char*)(PROJ + 4096 + h * 256 + idv * 64 + (c_ - 64));
                    pp_[j_] = (c_ < 64) ? D * 2 : NPROJ * 2; }
#define M1_DMA(i_) do { const int cc_ = d ? ((i_) < 2 ? 1 - (i_) : 131 - (i_)) : (i_); const int base_ = cc_ * 128; \
                    _Pragma("unroll") for (int j_ = 0; j_ < 8; ++j_) { const int row_ = base_ + (d ? 127 - ps_[j_] : ps_[j_]); \
                        __builtin_amdgcn_global_load_lds((const unsigned*)(pb_[j_] + (size_t)row_ * pp_[j_]), (LAS unsigned*)(lds + ((i_) & 3) * 32768 + (lw * 8 + j_) * 1024), 16, 0, 0); } } while (0)
                M1_DMA(0); M1_DMA(1); M1_DMA(2);
                for (int i = 0; i < NCH; ++i) {
                    const int cur = i & 3;
                    if (i + 2 < NCH) asm volatile("s_waitcnt vmcnt(16)" ::: "memory"); else if (i + 1 < NCH) asm volatile("s_waitcnt vmcnt(8)" ::: "memory"); else asm volatile("s_waitcnt vmcnt(0)" ::: "memory");
                    M1_BAR();
                    if (i + 3 < NCH) M1_DMA(i + 3);
                    if (idv == 0) {
                        const int dk = lt & 63, sg = lt >> 6; float sacc = 0.f;
#pragma unroll 8
                        for (int q = 0; q < 32; ++q) { const int sI = sg * 32 + q;
                            const LAS char* tb_ = tiles + cur * 32768 + (sI >> 6) * 16384;
                            const unsigned short kv = *(const LAS unsigned short*)(tb_ + att::v_st(sI & 63, dk & ~7) + (dk & 7) * 2);
                            sacc += wbuf[cur * 128 + sI] * bf2f(kv); }
                        nred[(i & 1) * 256 + sg * 64 + dk] = sacc;
                    }
                }
#undef M1_DMA
            }
        }
        __syncthreads();
#undef M1_BAR
        SEAM(14);
    }

    if (IN(15)) { const int lane = lane_fresh(), tid = wave * 64 + lane;
        const int tb = wave & 3, vh = wave >> 2;
        LAS float* aS = (LAS float*)(lds + 131072);
        LAS float* nS = (LAS float*)(lds + 131072 + 512);
        LAS float* wsc = (LAS float*)(lds + 131072 + 2048) + wave * 64;
#define KSWZ512(row, colB) ((row) * 512 + ((colB) ^ (((row) & 15) << 4)))
#define M2_LBAR() do { asm volatile("s_waitcnt vmcnt(0) lgkmcnt(0)" ::: "memory"); __builtin_amdgcn_s_barrier(); asm volatile("" ::: "memory"); } while (0)
#define M2_VSLOT(j_, tl_, k_, c_) do { const int P_ = (wave * 4 + (j_)) * 64 + lane; tl_ = P_ >> 10; const int o_ = (P_ & 1023) * 16; const int sub_ = o_ >> 9, wi_ = o_ & 511; \
            const int kk_ = ((sub_ >> 2) << 3) | (wi_ >> 6); k_ = (kk_ & ~0xC) | ((kk_ & 4) << 1) | ((kk_ & 8) >> 1); c_ = ((sub_ & 3) << 5) | ((wi_ & 63) >> 1); } while (0)
#define M2_DMA_C(kt_, b_) do { _Pragma("unroll") for (int j_ = 0; j_ < 4; ++j_) { int tl_, k_, c_; M2_VSLOT(j_, tl_, k_, c_); \
            __builtin_amdgcn_global_load_lds((const unsigned*)(CST + (((size_t)hd * NCH + i) * 256 + 64 * (kt_) + k_) * 256 + 128 * tl_ + c_), (LAS unsigned*)(lds + (b_) * 65536 + (wave * 4 + j_) * 1024), 16, 0, 0); \
            __builtin_amdgcn_global_load_lds((const unsigned*)(CST + (((size_t)hd * NCH + i) * 256 + 64 * ((kt_) + 1) + k_) * 256 + 128 * tl_ + c_), (LAS unsigned*)(lds + (b_) * 65536 + 32768 + (wave * 4 + j_) * 1024), 16, 0, 0); } } while (0)
#define M2_DMA_KV(st_, b_) do { _Pragma("unroll") for (int j_ = 0; j_ < 4; ++j_) { int tl_, k_, c_; M2_VSLOT(j_, tl_, k_, c_); const int sv_ = 64 * (st_) + k_; const int rowv_ = base + (d ? 127 - sv_ : sv_); \
            __builtin_amdgcn_global_load_lds((const unsigned*)(PROJ + (size_t)rowv_ * NPROJ + 4096 + h * 256 + 128 * tl_ + c_), (LAS unsigned*)(lds + (b_) * 65536 + (wave * 4 + j_) * 1024), 16, 0, 0); \
            const int o2_ = ((wave * 4 + j_) * 64 + lane) * 16; const int rk_ = o2_ >> 9; const int cB_ = (o2_ & 511) ^ ((rk_ & 15) << 4); const int sk_ = 64 * (st_) + rk_; const int rowk_ = base + (d ? 127 - sk_ : sk_); \
            __builtin_amdgcn_global_load_lds((const unsigned*)(KC + (size_t)rowk_ * D + h * 256 + (cB_ >> 1)), (LAS unsigned*)(lds + (b_) * 65536 + 32768 + (wave * 4 + j_) * 1024), 16, 0, 0); } } while (0)
        for (int q = 0; ; ++q) {
            const int pr = bx + (q >> 1) * G; if (pr >= 8 * 128) break;
            int tid = tid_fresh(wave); asm volatile("" : "+v"(tid));
            const int lane = tid & 63, r32 = lane & 31, hi5 = lane >> 5;
            const int h = pr >> 7, cc = 2 + (pr & 127), d = q & 1, hd = d * 8 + h;
            const int i = d ? (131 - cc) : cc; const int base = cc * 128;
            const size_t gofs = ((size_t)hd * NCH + i) * 128;
            const int tpos = 32 * tb + r32; const int row_t = base + (d ? 127 - tpos : tpos);
            M2_DMA_C(0, 0);
            bf16x8 qr[16];
#pragma unroll
            for (int k = 0; k < 16; ++k) qr[k] = *(const bf16x8*)(QC + (size_t)row_t * D + h * 256 + 16 * k + 8 * hi5);
            const float bt = GB[gofs + tpos]; const float eb = __expf(bt);
            const float av = (tid < 128) ? GI[gofs + (tid & 127)] - GB[gofs + (tid & 127)] : 0.f;
            const float nv = (tid < 256) ? NST[((size_t)hd * NCH + i) * 256 + (tid & 255)] : 0.f;
            f32x16 o[4];
#pragma unroll
            for (int dd = 0; dd < 4; ++dd) o[dd] = f32x16{};
            const int vbA = (int)(uintptr_t)(lds + vh * 16384) + att::v_rd_base(lane), vbB = vbA + 65536;
            M2_LBAR();
            if (tid < 128) aS[tid] = av;
            if (tid < 256) nS[tid] = nv;
            M2_DMA_C(2, 1);
            att::pv_d0(o, vbA, qr[0], qr[1], qr[2], qr[3]);
            att::pv_d0(o, vbA + 32768, qr[4], qr[5], qr[6], qr[7]);
            M2_LBAR(); M2_DMA_KV(0, 0);
            att::pv_d0(o, vbB, qr[8], qr[9], qr[10], qr[11]);
            att::pv_d0(o, vbB + 32768, qr[12], qr[13], qr[14], qr[15]);
            if (hi5 == 0) wsc[r32] = eb; LDS_WAIT();
#pragma unroll
            for (int dd = 0; dd < 4; ++dd)
#pragma unroll
                for (int r = 0; r < 16; ++r) o[dd][r] *= wsc[crow(r, hi5)];
            float qn = 0.f;
#pragma unroll
            for (int k = 0; k < 16; ++k)
#pragma unroll
                for (int j = 0; j < 8; ++j) qn += bf2f((unsigned short)qr[k][j]) * nS[16 * k + 8 * hi5 + j];
            { auto rr = __builtin_amdgcn_permlane32_swap(__float_as_uint(qn), __float_as_uint(qn), false, false); qn = __uint_as_float(rr[0]) + __uint_as_float(rr[1]); }
            float rs = 0.f;
#pragma unroll 1
            for (int st = 0; st < 2; ++st) {
                M2_LBAR();
                if (st == 0) M2_DMA_KV(1, 1);
                LAS char* KT = (LAS char*)(lds + st * 65536 + 32768);
                const int vb0 = st ? vbB : vbA;
                if (tb >= 2 * st) {
                    f32x16 p0 = f32x16{}, p1 = f32x16{};
#pragma unroll
                    for (int k = 0; k < 16; ++k) { const int cb = (16 * k + 8 * hi5) * 2;
                        const bf16x8 b0 = *(const LAS bf16x8*)(KT + KSWZ512(r32, cb)), b1 = *(const LAS bf16x8*)(KT + KSWZ512(32 + r32, cb));
                        p0 = __builtin_amdgcn_mfma_f32_32x32x16_bf16(b0, qr[k], p0, 0, 0, 0);
                        p1 = __builtin_amdgcn_mfma_f32_32x32x16_bf16(b1, qr[k], p1, 0, 0, 0); }
                    float ps = 0.f;
#pragma unroll
                    for (int r = 0; r < 16; ++r) { const int s0 = 64 * st + crow(r, hi5), s1 = s0 + 32;
                        const float w0 = (s0 <= tpos) ? __expf(bt + aS[s0]) : 0.f, w1 = (s1 <= tpos) ? __expf(bt + aS[s1]) : 0.f;
                        p0[r] = (s0 <= tpos) ? p0[r] * w0 : 0.f; p1[r] = (s1 <= tpos) ? p1[r] * w1 : 0.f; ps += p0[r] + p1[r]; }
                    { auto rr = __builtin_amdgcn_permlane32_swap(__float_as_uint(ps), __float_as_uint(ps), false, false); ps = __uint_as_float(rr[0]) + __uint_as_float(rr[1]); }
                    rs += ps;
                    bf16x8 pa0, pa1, pa2, pa3;
                    PK4(p0, 0, pa0); PK4(p0, 8, pa1); PK4(p1, 0, pa2); PK4(p1, 8, pa3);
                    att::pv_d0(o, vb0, pa0, pa1, pa2, pa3);
                }
            }
            const float den = eb * qn + rs; const float rinv = 1.f / fmaxf(fabsf(den), 1.f);
            if (hi5 == 0) wsc[32 + r32] = rinv; LDS_WAIT();
            bf16_t* hp = HD + ((size_t)d * T + base) * D + h * 256 + 128 * vh + r32;
#pragma unroll
            for (int r = 0; r < 16; ++r) { const int tq = 32 * tb + crow(r, hi5); const int rowq = d ? 127 - tq : tq; const float ri = wsc[32 + crow(r, hi5)];
#pragma unroll
                for (int dd = 0; dd < 4; ++dd) { const float v = o[dd][r] * ri; hp[(size_t)rowq * D + 32 * dd] = (bf16_t)(cvtpk(v, v) & 0xffffu); } }
        }
        __syncthreads();
#undef M2_LBAR
#undef M2_VSLOT
#undef M2_DMA_C
#undef M2_DMA_KV
        SEAM(15);
    }

    if (IN(16)) { const int lane = lane_fresh(), tid = wave * 64 + lane;
        for (int t = CTXL + gw; t < T; t += NGW) {
            Row hrow, hb; row_load_bf16(hrow, HD + (size_t)t * D, lane); row_load_bf16(hb, HD + ((size_t)T + t) * D, lane);
#pragma unroll
            for (int j = 0; j < 8; ++j) {
                f32x4 v = hrow.v[j] + hb.v[j];
                const float ss = wave_sum((v.x * v.x + v.y * v.y) + (v.z * v.z + v.w * v.w));
                const float r = rsqrtf(ss * (1.f / 256.f) + EPS);
                const f32x4 gg = *(const f32x4*)(a.in[I_GHEAD1] + 4 * lane + 256 * j);
                const u32x2 ow = *(const u32x2*)(PROJ + (size_t)t * NPROJ + 6144 + 4 * lane + 256 * j);
                v = v * r * gg;
                v.x *= sigmoidf_(bflo(ow.x)); v.y *= sigmoidf_(bfhi(ow.x)); v.z *= sigmoidf_(bflo(ow.y)); v.w *= sigmoidf_(bfhi(ow.y));
                hrow.v[j] = v;
            }
            row_store_bf16(hrow, RO + (size_t)t * D, lane);
        }
        SEAM(16);
    }

    if (IN(17)) { const int lane = lane_fresh(), tid = wave * 64 + lane;
        pg8::Gemm g{RO + (size_t)CTXL * D, WOUT1, D, nullptr, 1, 0}; pg8::StaticOrder S; S.init(SEQ / 256, D / 256, G, bx);
        pg8::EpiBf16 E{Y1 + (size_t)CTXL * D, D, 1 << 30, nullptr};
        pg8::gemm_phase<pg8::EpiBf16, pg8::StaticOrder>(lds, g, S, E, wave);
        SEAM(17);
    }

    if (IN(18)) { const int lane = lane_fresh(), tid = wave * 64 + lane; PHASE_POSTMIX(1, Y1, CTXL, a.in[I_GPOSTMIX1], a.in[I_GPREFFN1], a.in[I_WROUTER1]); SEAM(18); }
    if (IN(19)) { const int lane = lane_fresh(), tid = wave * 64 + lane; PHASE_TOPK(16); SEAM(19); }
    if (IN(21)) { const int lane = lane_fresh(), tid = wave * 64 + lane;
        pg8::Gemm g{XN, WGU, D, IDX, 2048, 2048}; pg8::GroupedOrder S; S.init(8, 16, G, bx);
        pg8::EpiSwiGLU E{HID};
        pg8::gemm_phase<pg8::EpiSwiGLU, pg8::GroupedOrder, true>(lds, g, S, E, wave);
        SEAM(21);
    }
    if (IN(22)) { const int lane = lane_fresh(), tid = wave * 64 + lane;
        pg8::Gemm g{HID, WD, D, nullptr, 1, 0}; pg8::GroupedOrder S; S.init(8, 8, G, bx);
        pg8::EpiDown E{YE, GATEV, 2048};
        pg8::gemm_phase<pg8::EpiDown, pg8::GroupedOrder>(lds, g, S, E, wave);
        SEAM(22);
    }
    if (IN(23)) { const int lane = lane_fresh(), tid = wave * 64 + lane;
        COMBINE_LOOP(1, 2048, a.in[I_GPOSTFFN1], CTXL, { row_store_f32(x, a.out + (size_t)(t - CTXL) * D, lane); });
    }
#undef IN
#undef SEAM
}

#ifndef MK_SINGLE
#define MK_SINGLE 1
#define PROBE_REP 1,1,1,1,1,1,1,1,1,1,1, 1, 1, 1, 1, 1, 1, 1, 1, 1, 1, 1, 1, 1
#endif
extern "C" void kernel_launch(void* const* d_in, const int* in_sizes, int n_in, void* d_out, int out_size, void* d_ws, size_t ws_size, hipStream_t stream) {
    static int grid = 0;
    if (grid == 0) {
        int dev = 0, cus = 0;
        if (hipGetDevice(&dev) != hipSuccess || hipDeviceGetAttribute(&cus, hipDeviceAttributeMultiprocessorCount, dev) != hipSuccess) { grid = -1; return; }
        if (hipFuncSetAttribute((const void*)mega, hipFuncAttributeMaxDynamicSharedMemorySize, LDS_BYTES) != hipSuccess) { fprintf(stderr, "hipFuncSetAttribute failed\n"); grid = -1; return; }
        if (n_in != NIN || ws_size < WS_END) { fprintf(stderr, "kernel_launch: n_in %d ws %zu (need %zu)\n", n_in, ws_size, (size_t)WS_END); grid = -1; return; }
        grid = cus;
    }
    if (grid < 0) return;
    (void)hipMemsetAsync(d_ws, 0, CTL_BYTES, stream);
    Args a{};
    for (int i = 0; i < NIN; ++i) a.in[i] = (const float*)d_in[i];
    a.out = (float*)d_out; a.ws = (unsigned char*)d_ws;
#if MK_SINGLE
    a.ph_lo = 0; a.ph_hi = NPHASE;
    hipLaunchKernelGGL(mega, dim3(grid), dim3(NTHREADS), LDS_BYTES, stream, a);
#else
    static const int REP[NPHASE] = {PROBE_REP};
    for (int p = 0; p < NPHASE; ++p) for (int r = 0; r < REP[p]; ++r) { a.ph_lo = p; a.ph_hi = p + 1; hipLaunchKernelGGL(mega, dim3(grid), dim3(NTHREADS), LDS_BYTES, stream, a); }
#endif
}
```

```cpp
#include <hip/hip_runtime.h>
#include <cstdio>
#include <cstdint>

#define GAS __attribute__((address_space(1)))
#define LAS __attribute__((address_space(3)))
typedef unsigned short bf16_t;
typedef short bf16x8 __attribute__((ext_vector_type(8)));
typedef short s16x4 __attribute__((ext_vector_type(4)));
typedef float f32x2 __attribute__((ext_vector_type(2)));
typedef float f32x4 __attribute__((ext_vector_type(4)));
typedef float f32x16 __attribute__((ext_vector_type(16)));
typedef unsigned u32x2 __attribute__((ext_vector_type(2)));
typedef unsigned u32x4 __attribute__((ext_vector_type(4)));

constexpr int D = 2048, SEQ = 16384, CTXL = 256, T = SEQ + CTXL;
constexpr int NQKV = 4608, NQD = 3328, NOF = 3072, NPROJ = 8192, NPROJ_PAD = 8448;
constexpr int NE = 16, IDXS = 2304;
constexpr float EPS = 1e-6f;
constexpr int NTHREADS = 512, NWAVES = 8;
constexpr int NCH = 130;

constexpr size_t MiB = 1u << 20;
constexpr size_t WS_CTL = 0, CTL_BYTES = 1 * MiB;
constexpr size_t WS_MOD   = 1 * MiB;
constexpr size_t WS_AFFT  = 2 * MiB;
constexpr size_t WS_IDX   = 4 * MiB;
constexpr size_t WS_GATEV = 5 * MiB;
constexpr size_t WS_INV   = 6 * MiB;
constexpr size_t WS_GATES = 8 * MiB;
constexpr size_t WS_GB    = 11 * MiB;
constexpr size_t WS_GI    = 13 * MiB;
constexpr size_t WS_NST   = 15 * MiB;
constexpr size_t WS_WIN0  = 32 * MiB;
constexpr size_t WS_WOUT0 = 50 * MiB;
constexpr size_t WS_WIN1  = 58 * MiB;
constexpr size_t WS_WOUT1 = 91 * MiB;
constexpr size_t WS_WGU   = 100 * MiB;
constexpr size_t WS_WD    = 356 * MiB;
constexpr size_t WS_XC    = 484 * MiB;
constexpr size_t WS_XN    = 614 * MiB;
constexpr size_t WS_R     = 680 * MiB;
constexpr size_t WS_QKV   = WS_R;
constexpr size_t WS_QD    = WS_R + 148 * MiB;
constexpr size_t WS_AO    = WS_R + 256 * MiB;
constexpr size_t WS_Y     = WS_R + 322 * MiB;
constexpr size_t WS_OF    = WS_R + 454 * MiB;
constexpr size_t WS_XE    = WS_R;
constexpr size_t WS_HID   = WS_R + 144 * MiB;
constexpr size_t WS_YE    = WS_R + 288 * MiB;
constexpr size_t WS_PROJ  = WS_R;
constexpr size_t WS_QC    = WS_R + 260 * MiB;
constexpr size_t WS_KC    = WS_R + 325 * MiB;
constexpr size_t WS_CST   = WS_R + 390 * MiB;
constexpr size_t WS_HD    = WS_R + 650 * MiB;
constexpr size_t WS_RO    = WS_QC;
constexpr size_t WS_Y1    = WS_CST;
constexpr size_t WS_XC2   = WS_R + 910 * MiB;
constexpr size_t WS_END   = WS_R + 1040 * MiB;

constexpr int CW_BAR = 4096;
constexpr int CW_C0 = 8192, CW_C1A = 8256, CW_C1B = 8320, CW_DONE2 = 8384, CW_DONE5 = 8448, CW_DONE10 = 8512, CW_DONE12 = 8576;

constexpr int LDS_BYTES = 147456;
constexpr int MISC_OFF = LDS_BYTES - 256;

#define LDS_WAIT() asm volatile("s_waitcnt lgkmcnt(0)" ::: "memory")
#define VM_WAIT() asm volatile("s_waitcnt vmcnt(0)" ::: "memory")
#define SBAR() __builtin_amdgcn_sched_barrier(0)
__device__ __forceinline__ unsigned cvtpk(float lo, float hi) { unsigned r; asm volatile("v_cvt_pk_bf16_f32 %0, %1, %2" : "=v"(r) : "v"(lo), "v"(hi)); return r; }
typedef __bf16 bf16x2_t __attribute__((ext_vector_type(2)));
__device__ __forceinline__ unsigned cvtpk_s(float lo, float hi) { f32x2 v = {lo, hi}; bf16x2_t b = __builtin_convertvector(v, bf16x2_t); return __builtin_bit_cast(unsigned, b); }
__device__ __forceinline__ float bf2f(unsigned short b) { return __uint_as_float(((unsigned)b) << 16); }
__device__ __forceinline__ float bflo(unsigned w) { return __uint_as_float(w << 16); }
__device__ __forceinline__ float bfhi(unsigned w) { return __uint_as_float(w & 0xffff0000u); }
__device__ __forceinline__ int wave_id() { return __builtin_amdgcn_readfirstlane((int)threadIdx.x >> 6); }
__device__ __forceinline__ int lane_fresh() { unsigned m = ~0u; asm volatile("" : "+s"(m)); return (int)__builtin_amdgcn_mbcnt_hi(m, __builtin_amdgcn_mbcnt_lo(m, 0u)); }
__device__ __forceinline__ int tid_fresh(int wave) { return wave * 64 + lane_fresh(); }
__device__ __forceinline__ float wave_sum_bp(float v) {
#pragma unroll
    for (int o = 1; o < 64; o <<= 1) v += __shfl_xor(v, o);
    return v;
}
template <int CTRL> __device__ __forceinline__ float dpp_f(float v) { return __builtin_bit_cast(float, __builtin_amdgcn_update_dpp(0, __builtin_bit_cast(int, v), CTRL, 0xF, 0xF, false)); }
__device__ __forceinline__ float wave_sum(float v) {
    v += dpp_f<0xB1>(v);
    v += dpp_f<0x4E>(v);
    v += dpp_f<0x124>(v);
    v += dpp_f<0x128>(v);
    { auto r = __builtin_amdgcn_permlane16_swap(__float_as_uint(v), __float_as_uint(v), false, false); v = __uint_as_float(r[0]) + __uint_as_float(r[1]); }
    { auto r = __builtin_amdgcn_permlane32_swap(__float_as_uint(v), __float_as_uint(v), false, false); v = __uint_as_float(r[0]) + __uint_as_float(r[1]); }
    return v;
}
template <int CTRL> __device__ __forceinline__ int dpp_i(int v) { return __builtin_amdgcn_update_dpp(0, v, CTRL, 0xF, 0xF, false); }
__device__ __forceinline__ int wave_sum_i(int v) {
    v += dpp_i<0xB1>(v); v += dpp_i<0x4E>(v); v += dpp_i<0x124>(v); v += dpp_i<0x128>(v);
    { auto r = __builtin_amdgcn_permlane16_swap((unsigned)v, (unsigned)v, false, false); v = (int)(r[0] + r[1]); }
    { auto r = __builtin_amdgcn_permlane32_swap((unsigned)v, (unsigned)v, false, false); v = (int)(r[0] + r[1]); }
    return v;
}
__device__ __forceinline__ float sigmoidf_(float x) { return __builtin_amdgcn_rcpf(1.f + __expf(-x)); }
__device__ __forceinline__ int crow(int r, int hi) { return (r & 3) + 8 * (r >> 2) + 4 * hi; }

#define XB_TMO      128
#define XB_XCNT(j)  (256  + 64 * (j))
#define XB_XSUB(j)  (1280 + 64 * (j))
#define XB_XGEN(j)  (2304 + 64 * (j))
#define XB_TOP      3328
#define XB_TOPGEN   3392
#define XCD_BAR_WORDS 3456
#define XB_SPIN_CAP (1u << 18)
__device__ __forceinline__ unsigned xb_ld(unsigned* p)              { return __hip_atomic_load(p, __ATOMIC_RELAXED, __HIP_MEMORY_SCOPE_AGENT); }
__device__ __forceinline__ unsigned xb_add(unsigned* p, unsigned v) { return __hip_atomic_fetch_add(p, v, __ATOMIC_RELAXED, __HIP_MEMORY_SCOPE_AGENT); }
__device__ __forceinline__ unsigned xb_xcc_id() { return (unsigned)__builtin_amdgcn_s_getreg((3 << 11) | 20) & 0xFu; }
#define XB_SPIN(cond, bar) do { unsigned _sp = 0; while (cond) { __builtin_amdgcn_s_sleep(1); \
    if ((++_sp & 255u) == 0u) { if (xb_ld(&(bar)[XB_TMO])) break; if (_sp > XB_SPIN_CAP) { atomicAdd(&(bar)[XB_TMO], 1u); break; } } } } while (0)
struct XcdBarrier { unsigned* bar; unsigned x; volatile LAS unsigned* st; int wave; };
__device__ __forceinline__ XcdBarrier xcd_barrier_post(unsigned* bar, volatile LAS unsigned* st, int wave) {
    XcdBarrier b; b.bar = bar; b.x = xb_xcc_id(); b.st = st; b.wave = wave;
    if (tid_fresh(wave) == 0) (void)xb_add(&bar[XB_XCNT(b.x)], 1u);
    return b;
}
__device__ __forceinline__ void xcd_barrier_complete(unsigned* bar, unsigned x, unsigned& nloc, unsigned& nx) {
    const unsigned G = gridDim.x * gridDim.y * gridDim.z;
    unsigned sum, cnt, mine, sp = 0u;
    for (;;) {
        sum = 0u; cnt = 0u; mine = 0u;
#pragma unroll
        for (unsigned j = 0; j < 16; ++j) { const unsigned c = xb_ld(&bar[XB_XCNT(j)]); sum += c; cnt += (c > 0u) ? 1u : 0u; mine = (j == x) ? c : mine; }
        if (sum == G) break;
        __builtin_amdgcn_s_sleep(1);
        if ((++sp & 255u) == 0u) { if (xb_ld(&bar[XB_TMO])) break; if (sp > XB_SPIN_CAP) { atomicAdd(&bar[XB_TMO], 1u); break; } }
    }
    nloc = mine > 0u ? mine : 1u; nx = cnt > 0u ? cnt : 1u;
}
__device__ __forceinline__ void xcd_barrier(const XcdBarrier& b) {
    asm volatile("s_waitcnt vmcnt(0)" ::: "memory");
    __syncthreads();
    if (tid_fresh(b.wave) == 0) {
        unsigned* bar = b.bar;
        __builtin_amdgcn_s_waitcnt(0);
        unsigned nloc = b.st[0], nx = b.st[1];
        if (nloc == 0u) { xcd_barrier_complete(bar, b.x, nloc, nx); b.st[0] = nloc; b.st[1] = nx; }
        const unsigned old = xb_add(&bar[XB_XSUB(b.x)], 1u);
        const unsigned gen = old / nloc;
        if (old + 1u == (gen + 1u) * nloc) {
            __builtin_amdgcn_fence(__ATOMIC_RELEASE, "agent");
            asm volatile("s_waitcnt vmcnt(0)" ::: "memory");
            const unsigned og = xb_add(&bar[XB_TOP], 1u);
            const unsigned tg = og / nx;
            if (og + 1u == (tg + 1u) * nx) xb_add(&bar[XB_TOPGEN], 1u);
            else XB_SPIN(xb_ld(&bar[XB_TOPGEN]) == tg, bar);
            __builtin_amdgcn_fence(__ATOMIC_ACQUIRE, "agent");
            xb_add(&bar[XB_XGEN(b.x)], 1u);
            asm volatile("s_waitcnt vmcnt(0)" ::: "memory");
        } else {
            XB_SPIN(xb_ld(&bar[XB_XGEN(b.x)]) == gen, bar);
            __builtin_amdgcn_fence(__ATOMIC_ACQUIRE, "agent");
            asm volatile("s_waitcnt vmcnt(0)" ::: "memory");
        }
    }
    __syncthreads();
}

namespace pg8 {
constexpr int BM = 256, BK = 64, HALF = 128, HTB = HALF * BK * 2, STAGE_BYTES = 8 * HTB, NXCD = 8, WGM = 8;
__host__ __device__ __forceinline__ int lds_byte(int r, int c) { const int st = (r >> 4) * 2 + (c >> 5), rr = r & 15, cc = c & 31, ob = rr * 64 + cc * 2; return st * 1024 + (ob ^ (((ob >> 9) & 1) << 5)); }
__host__ __device__ __forceinline__ void stage_rc(int b, int& R, int& C) { const int st = b / 1024, sb = b % 1024, swz = sb ^ (((sb >> 9) & 1) << 5); R = (st >> 1) * 16 + swz / 64; C = (st & 1) * 32 + (swz % 64) / 2; }
__host__ __device__ __forceinline__ int perm32(int rho) { const int n = rho >> 4, i = rho & 15; return 8 * (i >> 2) + 4 * n + (i & 3); }
struct Unit { int pm, pn, ta, tb; };
struct Gemm { const bf16_t* A; const bf16_t* Bt; int K; const int* gidx; int rpe, nvalid; };

struct StaticOrder {
    int nM, nN, nwg, G, c;
    __device__ void init(int nM_, int nN_, int G_, int c_) { nM = nM_; nN = nN_; nwg = nM * nN; G = G_; c = c_; }
    __device__ bool next(int i, Unit& u) const {
        const long L = (long)i * G + c; if (L >= nwg) return false;
        int wgid = (int)L; { const int q = nwg / NXCD, r = nwg % NXCD, xcd = wgid % NXCD, off = wgid / NXCD; wgid = (xcd < r ? xcd * (q + 1) : r * (q + 1) + (xcd - r) * q) + off; }
        const int nig = WGM * nN, gid = wgid / nig, fm = gid * WGM, gsz = (nM - fm) < WGM ? (nM - fm) : WGM;
        u.pm = fm + ((wgid % nig) % gsz); u.pn = (wgid % nig) / gsz; u.ta = u.pm; u.tb = u.pn; return true;
    }
};
struct GroupedOrder {
    int TM, TN, share, nloc, j, x;
    __device__ void init(int TM_, int TN_, int G_, int c_) { TM = TM_; TN = TN_; share = NE * TM * TN / NXCD; x = c_ % NXCD; j = c_ / NXCD; nloc = (G_ - x + NXCD - 1) / NXCD; }
    __device__ bool next(int i, Unit& u) const {
        const int v = i * nloc + j; if (v >= share) return false;
        const int L = x * share + v;
        const int per = TM * TN, e = L / per, r = L % per, tm = r % TM, pn = r / TM;
        u.pm = e * TM + tm; u.pn = pn; u.ta = u.pm; u.tb = e * TN + pn; return true;
    }
};

struct EpiF32 {
    static constexpr bool PERM = false;
    float* C; int ldc;
    __device__ __forceinline__ void operator()(const f32x4 (&acc)[2][2][4][2], const Unit& u, int wr, int wc, int fr, int fq) const {
        const int row0 = u.pm * BM + wr * 64 + fr, col0 = u.pn * BM + wc * 32 + 4 * fq;
#pragma unroll
        for (int ai = 0; ai < 2; ++ai)
#pragma unroll
            for (int m = 0; m < 4; ++m) { float* rowp = C + (size_t)(row0 + ai * HALF + m * 16) * ldc + col0;
#pragma unroll
                for (int bj = 0; bj < 2; ++bj)
#pragma unroll
                    for (int n = 0; n < 2; ++n) *(f32x4*)(rowp + bj * HALF + n * 16) = acc[ai][bj][m][n]; }
    }
};
struct EpiBf16 {
    static constexpr bool PERM = true;
    bf16_t* O; int ldc; int gate_pn; float* G;
    __device__ __forceinline__ void operator()(const f32x4 (&acc)[2][2][4][2], const Unit& u, int wr, int wc, int fr, int fq) const {
        const int row0 = u.pm * BM + wr * 64 + fr;
        if (u.pn >= gate_pn) {
            if (wc == 0) {
#pragma unroll
                for (int ai = 0; ai < 2; ++ai)
#pragma unroll
                    for (int m = 0; m < 4; ++m) { float* gp = G + (size_t)(row0 + ai * HALF + m * 16) * 32 + 8 * fq;
                        *(f32x4*)gp = acc[ai][0][m][0]; *(f32x4*)(gp + 4) = acc[ai][0][m][1]; }
            }
            return;
        }
        const int col0 = u.pn * BM + wc * 32 + 8 * fq;
#pragma unroll
        for (int ai = 0; ai < 2; ++ai)
#pragma unroll
            for (int m = 0; m < 4; ++m) { bf16_t* rowp = O + (size_t)(row0 + ai * HALF + m * 16) * ldc + col0;
#pragma unroll
                for (int bj = 0; bj < 2; ++bj) { const f32x4 v0 = acc[ai][bj][m][0], v1 = acc[ai][bj][m][1];
                    u32x4 w; w.x = cvtpk(v0[0], v0[1]); w.y = cvtpk(v0[2], v0[3]); w.z = cvtpk(v1[0], v1[1]); w.w = cvtpk(v1[2], v1[3]);
                    *(u32x4*)(rowp + bj * HALF) = w; } }
    }
};
struct EpiRope {
    static constexpr bool PERM = true;
    bf16_t* QKVp; bf16_t* QDp; const float* gq; const float* gk; LAS float* xch;
    __device__ __forceinline__ void operator()(const f32x4 (&acc)[2][2][4][2], const Unit& u, int wr, int wc, int fr, int fq) const {
        const int pn = u.pn; const int row0 = u.pm * BM + wr * 64 + fr;
        const float L2T = 13.287712379549449f;
        if ((pn >= 8 && pn < 12) || pn == 17) {
            const int col0 = pn * BM + wc * 32 + 8 * fq;
#pragma unroll
            for (int ai = 0; ai < 2; ++ai)
#pragma unroll
                for (int m = 0; m < 4; ++m) { bf16_t* rowp = QKVp + (size_t)(row0 + ai * HALF + m * 16) * NQKV + col0;
#pragma unroll
                    for (int bj = 0; bj < 2; ++bj) { const f32x4 v0 = acc[ai][bj][m][0], v1 = acc[ai][bj][m][1];
                        u32x4 w; w.x = cvtpk(v0[0], v0[1]); w.y = cvtpk(v0[2], v0[3]); w.z = cvtpk(v1[0], v1[1]); w.w = cvtpk(v1[2], v1[3]);
                        *(u32x4*)(rowp + bj * HALF) = w; } }
            return;
        }
        if (pn < 8) {
            const bool isq = pn < 4; const float qs = isq ? 0.18033688011112042f : 1.f;
            bf16_t* dst = QDp + (isq ? 256 * pn : 2048 + 256 * (pn - 4)) + 32 * wc + 8 * fq;
            float fe[4];
#pragma unroll
            for (int e = 0; e < 4; ++e) fe[e] = __builtin_amdgcn_exp2f(-L2T * (float)(2 * (4 * fq + e)) * (1.f / 32.f));
#pragma unroll
            for (int ai = 0; ai < 2; ++ai)
#pragma unroll
                for (int m = 0; m < 4; ++m) { const int row = row0 + ai * HALF + m * 16; const bool lat = row >= CTXL; const int tl = row - CTXL;
                    const float pos = (wc & 1) ? (float)(tl & 63) : (float)(tl >> 6);
                    float sn[4], cs[4];
#pragma unroll
                    for (int e = 0; e < 4; ++e) { sn[e] = 0.f; cs[e] = 1.f; if (lat) { const float ang = pos * fe[e]; sn[e] = __sinf(ang); cs[e] = __cosf(ang); } }
#pragma unroll
                    for (int bj = 0; bj < 2; ++bj) { const f32x4 v0 = acc[ai][bj][m][0], v1 = acc[ai][bj][m][1]; float o1[4], o2[4];
#pragma unroll
                        for (int e = 0; e < 4; ++e) { o1[e] = (v0[e] * cs[e] - v1[e] * sn[e]) * qs; o2[e] = (v1[e] * cs[e] + v0[e] * sn[e]) * qs; }
                        u32x4 w; w.x = cvtpk(o1[0], o1[1]); w.y = cvtpk(o1[2], o1[3]); w.z = cvtpk(o2[0], o2[1]); w.w = cvtpk(o2[2], o2[3]);
                        *(u32x4*)(dst + (size_t)row * NQD + bj * HALF) = w; } }
            return;
        }
        {
            const bool isq = pn < 16; const float qs = isq ? 0.12751743082459868f : 1.f; const float* g = isq ? gq : gk;
            bf16_t* dst = QDp + (isq ? 1024 + 256 * (pn - 12) : 3072) + 32 * wc + 8 * fq;
            float ss[2][4][2];
#pragma unroll
            for (int ai = 0; ai < 2; ++ai)
#pragma unroll
                for (int m = 0; m < 4; ++m)
#pragma unroll
                    for (int bj = 0; bj < 2; ++bj) { const f32x4 v0 = acc[ai][bj][m][0], v1 = acc[ai][bj][m][1];
                        float q2 = (v0[0] * v0[0] + v0[1] * v0[1]) + (v0[2] * v0[2] + v0[3] * v0[3]) + (v1[0] * v1[0] + v1[1] * v1[1]) + (v1[2] * v1[2] + v1[3] * v1[3]);
                        { auto r = __builtin_amdgcn_permlane16_swap(__float_as_uint(q2), __float_as_uint(q2), false, false); q2 = __uint_as_float(r[0]) + __uint_as_float(r[1]); }
                        { auto r = __builtin_amdgcn_permlane32_swap(__float_as_uint(q2), __float_as_uint(q2), false, false); q2 = __uint_as_float(r[0]) + __uint_as_float(r[1]); }
                        ss[ai][m][bj] = q2; }
            LAS float* mine = xch + (wr * 4 + wc) * 256;
            if (fq == 0) {
#pragma unroll
                for (int ai = 0; ai < 2; ++ai)
#pragma unroll
                    for (int m = 0; m < 4; ++m)
#pragma unroll
                        for (int bj = 0; bj < 2; ++bj) mine[((ai * 4 + m) * 2 + bj) * 16 + fr] = ss[ai][m][bj];
            }
            asm volatile("s_waitcnt lgkmcnt(0)" ::: "memory"); __builtin_amdgcn_s_barrier(); asm volatile("" ::: "memory");
            float fe[4], g1[4], g2[4];
#pragma unroll
            for (int e = 0; e < 4; ++e) { const int i = 16 * wc + 4 * fq + e; fe[e] = __builtin_amdgcn_exp2f(-L2T * (float)(2 * (i & 31)) * (1.f / 64.f)); g1[e] = g[i]; g2[e] = g[64 + i]; }
#pragma unroll
            for (int ai = 0; ai < 2; ++ai)
#pragma unroll
                for (int m = 0; m < 4; ++m) { const int row = row0 + ai * HALF + m * 16; const bool lat = row >= CTXL; const int tl = row - CTXL;
                    const float pos = (wc >= 2) ? (float)(tl & 63) : (float)(tl >> 6);
                    float sn[4], cs[4];
#pragma unroll
                    for (int e = 0; e < 4; ++e) { sn[e] = 0.f; cs[e] = 1.f; if (lat) { const float ang = pos * fe[e]; sn[e] = __sinf(ang); cs[e] = __cosf(ang); } }
#pragma unroll
                    for (int bj = 0; bj < 2; ++bj) { const int xi = ((ai * 4 + m) * 2 + bj) * 16 + fr;
                        const float tot = (xch[(wr * 4 + 0) * 256 + xi] + xch[(wr * 4 + 1) * 256 + xi]) + (xch[(wr * 4 + 2) * 256 + xi] + xch[(wr * 4 + 3) * 256 + xi]);
                        const float r = rsqrtf(tot * (1.f / 128.f) + EPS);
                        const f32x4 v0 = acc[ai][bj][m][0], v1 = acc[ai][bj][m][1]; float o1[4], o2[4];
#pragma unroll
                        for (int e = 0; e < 4; ++e) { const float y1 = v0[e] * r * g1[e], y2 = v1[e] * r * g2[e]; o1[e] = (y1 * cs[e] - y2 * sn[e]) * qs; o2[e] = (y2 * cs[e] + y1 * sn[e]) * qs; }
                        u32x4 w; w.x = cvtpk(o1[0], o1[1]); w.y = cvtpk(o1[2], o1[3]); w.z = cvtpk(o2[0], o2[1]); w.w = cvtpk(o2[2], o2[3]);
                        *(u32x4*)(dst + (size_t)row * NQD + bj * HALF) = w; } }
        }
    }
};
struct EpiSwiGLU {
    static constexpr bool PERM = true;
    bf16_t* O;
    __device__ __forceinline__ void operator()(const f32x4 (&acc)[2][2][4][2], const Unit& u, int wr, int wc, int fr, int fq) const {
        const int row0 = u.pm * BM + wr * 64 + fr, col0 = u.pn * HALF + wc * 32 + 8 * fq;
#pragma unroll
        for (int ai = 0; ai < 2; ++ai)
#pragma unroll
            for (int m = 0; m < 4; ++m) { bf16_t* rowp = O + (size_t)(row0 + ai * HALF + m * 16) * D + col0;
                float h[8];
#pragma unroll
                for (int n = 0; n < 2; ++n)
#pragma unroll
                    for (int j = 0; j < 4; ++j) { const float g = acc[ai][0][m][n][j], up = acc[ai][1][m][n][j]; h[4 * n + j] = g * sigmoidf_(g) * up; }
                u32x4 w; w.x = cvtpk(h[0], h[1]); w.y = cvtpk(h[2], h[3]); w.z = cvtpk(h[4], h[5]); w.w = cvtpk(h[6], h[7]);
                *(u32x4*)rowp = w; }
    }
};
struct EpiDown {
    static constexpr bool PERM = true;
    bf16_t* O; const float* gate; int rpe;
    __device__ __forceinline__ void operator()(const f32x4 (&acc)[2][2][4][2], const Unit& u, int wr, int wc, int fr, int fq) const {
        const int row0 = u.pm * BM + wr * 64 + fr, col0 = u.pn * BM + wc * 32 + 8 * fq;
#pragma unroll
        for (int ai = 0; ai < 2; ++ai)
#pragma unroll
            for (int m = 0; m < 4; ++m) { const int row = row0 + ai * HALF + m * 16; const int e = row / rpe, slot = row - e * rpe;
                const float gs = gate[e * IDXS + slot];
                bf16_t* rowp = O + (size_t)row * D + col0;
#pragma unroll
                for (int bj = 0; bj < 2; ++bj) { const f32x4 v0 = acc[ai][bj][m][0] * gs, v1 = acc[ai][bj][m][1] * gs;
                    u32x4 w; w.x = cvtpk(v0[0], v0[1]); w.y = cvtpk(v0[2], v0[3]); w.z = cvtpk(v1[0], v1[1]); w.w = cvtpk(v1[2], v1[3]);
                    *(u32x4*)(rowp + bj * HALF) = w; } }
    }
};

template <class Epi, class Sched, bool GA = false>
__device__ __forceinline__ void gemm_phase(LAS unsigned char* lds, const Gemm g, const Sched& S, const Epi& E, const int wid) {
    const int lane = lane_fresh(), tid = wid * 64 + lane, wr = wid >> 2, wc = wid & 3, fr = lane & 15, fq = lane >> 4;
    const int K = g.K, nt = K / BK;
    unsigned voffA[2], voffB[2]; int RA[2], CA[2];
#pragma unroll
    for (int i = 0; i < 2; ++i) { int R, C; stage_rc(tid * 16 + i * 8192, R, C); const int Rb = Epi::PERM ? ((R & ~31) + perm32(R & 31)) : R; RA[i] = R; CA[i] = C;
        voffA[i] = (unsigned)(R * K + C) * 2u; voffB[i] = (unsigned)(Rb * K + C) * 2u; }
    const size_t kstep = (size_t)(BK * 2);
    const size_t hstep = (size_t)HALF * K * 2;
    const size_t tstep = 2 * hstep;
    const unsigned ldsw = (unsigned)wid * 1024u;
    const int aoff = lds_byte(wr * 64 + fr, fq * 8), boff = lds_byte(wc * 32 + fr, fq * 8);
#define PG8_SA(b, h) (((b) * 2 + (h)) * HTB)
#define PG8_SB(b, h) ((4 + (b) * 2 + (h)) * HTB)
#define PG8_STAGE(bufoff, gbase, voff) do { _Pragma("unroll") for (int _i = 0; _i < 2; ++_i) \
        __builtin_amdgcn_global_load_lds((const unsigned*)((const char*)(gbase) + (voff)[_i]), (LAS unsigned*)(lds + (bufoff) + ldsw + _i * 8192), 16, 0, 0); } while (0)
#define PG8_LDA(dst, b, h) do { _Pragma("unroll") for (int m = 0; m < 4; ++m) _Pragma("unroll") for (int k = 0; k < 2; ++k) dst[m][k] = *(const LAS bf16x8*)(lds + PG8_SA(b, h) + aoff + m * 2048 + k * 1024); } while (0)
#define PG8_LDB(dst, b, h) do { _Pragma("unroll") for (int n = 0; n < 2; ++n) _Pragma("unroll") for (int k = 0; k < 2; ++k) dst[n][k] = *(const LAS bf16x8*)(lds + PG8_SB(b, h) + boff + n * 2048 + k * 1024); } while (0)
#define PG8_MMA(ai, bj, At, Bt) do { __builtin_amdgcn_s_setprio(1); _Pragma("unroll") for (int m = 0; m < 4; ++m) _Pragma("unroll") for (int n = 0; n < 2; ++n) _Pragma("unroll") for (int k = 0; k < 2; ++k) \
        acc[ai][bj][m][n] = __builtin_amdgcn_mfma_f32_16x16x32_bf16(Bt[n][k], At[m][k], acc[ai][bj][m][n], 0, 0, 0); __builtin_amdgcn_s_setprio(0); } while (0)
#define PG8_WAIT_V(n) asm volatile("s_waitcnt vmcnt(" #n ")" ::: "memory")
#define PG8_WAIT_L(n) asm volatile("s_waitcnt lgkmcnt(" #n ")" ::: "memory")
#define PG8_BAR __builtin_amdgcn_s_barrier()
#define PG8_SCHED __builtin_amdgcn_sched_barrier(0)
#define PG8_GIDX(u_, x0, x1) do { _Pragma("unroll") for (int _i = 0; _i < 2; ++_i) { \
        const int r0_ = (u_).pm * BM + RA[_i], r1_ = r0_ + HALF; const int e0_ = r0_ / g.rpe, e1_ = r1_ / g.rpe; int s0_ = r0_ - e0_ * g.rpe, s1_ = r1_ - e1_ * g.rpe; \
        s0_ = s0_ < g.nvalid ? s0_ : g.nvalid - 1; s1_ = s1_ < g.nvalid ? s1_ : g.nvalid - 1;            \
        (x0)[_i] = g.gidx[e0_ * IDXS + s0_]; (x1)[_i] = g.gidx[e1_ * IDXS + s1_]; } } while (0)
#define PG8_GIDX_DMA(u_) do { _Pragma("unroll") for (int _i = 0; _i < 2; ++_i) { \
        const int r0_ = (u_).pm * BM + RA[_i], r1_ = r0_ + HALF; const int e0_ = r0_ / g.rpe, e1_ = r1_ / g.rpe; int s0_ = r0_ - e0_ * g.rpe, s1_ = r1_ - e1_ * g.rpe; \
        s0_ = s0_ < g.nvalid ? s0_ : g.nvalid - 1; s1_ = s1_ < g.nvalid ? s1_ : g.nvalid - 1; \
        __builtin_amdgcn_global_load_lds((const unsigned*)(g.gidx + e0_ * IDXS + s0_), (LAS unsigned*)(lds + STAGE_BYTES + ((_i) * 8 + wid) * 256), 4, 0, 0); \
        __builtin_amdgcn_global_load_lds((const unsigned*)(g.gidx + e1_ * IDXS + s1_), (LAS unsigned*)(lds + STAGE_BYTES + ((2 + _i) * 8 + wid) * 256), 4, 0, 0); } } while (0)
#define PG8_GOFF(x0, x1, o0, o1) do { _Pragma("unroll") for (int _i = 0; _i < 2; ++_i) { (o0)[_i] = (unsigned)((x0)[_i] * K + CA[_i]) * 2u; (o1)[_i] = (unsigned)((x1)[_i] * K + CA[_i]) * 2u; } } while (0)
    Unit cur, nxt; int ui = 0;
    if (!S.next(0, cur)) return;
    f32x4 acc[2][2][4][2];
#pragma unroll
    for (int a = 0; a < 2; ++a)
#pragma unroll
        for (int b = 0; b < 2; ++b)
#pragma unroll
            for (int m = 0; m < 4; ++m)
#pragma unroll
                for (int n = 0; n < 2; ++n) acc[a][b][m][n] = (f32x4){0.f, 0.f, 0.f, 0.f};
    bf16x8 At[4][2], B0[2][2], B1[2][2];
    unsigned vc0[2], vc1[2];
    unsigned vl0[2] = {0u, 0u}, vl1[2] = {0u, 0u};
    const char *cA0, *cA1, *nA0, *nA1;
    if constexpr (GA) { int ic0[2], ic1[2]; cA0 = cA1 = (const char*)g.A; PG8_GIDX(cur, ic0, ic1); PG8_GOFF(ic0, ic1, vc0, vc1); asm volatile("s_waitcnt vmcnt(0)" ::: "memory"); }
    else { cA0 = (const char*)g.A + (size_t)cur.ta * tstep; cA1 = cA0 + hstep; vc0[0] = vc1[0] = voffA[0]; vc0[1] = vc1[1] = voffA[1]; }
    const char* cB = (const char*)g.Bt + (size_t)cur.tb * tstep;
    PG8_STAGE(PG8_SB(0, 0), cB, voffB); PG8_STAGE(PG8_SB(0, 1), cB + hstep, voffB); PG8_STAGE(PG8_SA(0, 0), cA0, vc0); PG8_STAGE(PG8_SA(0, 1), cA1, vc1);
    if (wr == 1) PG8_BAR;
    PG8_WAIT_V(2); PG8_BAR;
    PG8_STAGE(PG8_SB(1, 0), cB + kstep, voffB); PG8_STAGE(PG8_SA(1, 0), cA0 + kstep, vc0); PG8_STAGE(PG8_SB(1, 1), cB + hstep + kstep, voffB);
    PG8_WAIT_V(6); PG8_BAR;
    for (;;) {
        const bool has_next = S.next(ui + 1, nxt);
        const char* nB = has_next ? (const char*)g.Bt + (size_t)nxt.tb * tstep : cB;
        if constexpr (GA) { nA0 = nA1 = (const char*)g.A; if (has_next) PG8_GIDX_DMA(nxt); }
        else { nA0 = has_next ? (const char*)g.A + (size_t)nxt.ta * tstep : cA0; nA1 = nA0 + hstep; }
        for (int t = 0; t < nt; t += 2) {
            const bool last = (t == nt - 2);
            const char* a1_1 = cA1 + (size_t)(t + 1) * kstep;
            const char* a2_0 = last ? nA0 : cA0 + (size_t)(t + 2) * kstep; const char* a2_1 = last ? nA1 : cA1 + (size_t)(t + 2) * kstep;
            const char* b2 = last ? nB : cB + (size_t)(t + 2) * kstep;
            const char* a3_0 = a2_0 + kstep; const char* b3 = b2 + kstep;
            unsigned w0[2], w1[2];
            if constexpr (GA) {
                if (last && has_next) { int j0[2], j1[2];
                    _Pragma("unroll") for (int _i = 0; _i < 2; ++_i) { j0[_i] = (int)*(const LAS unsigned*)(lds + STAGE_BYTES + ((_i) * 8 + wid) * 256 + lane * 4); j1[_i] = (int)*(const LAS unsigned*)(lds + STAGE_BYTES + ((2 + _i) * 8 + wid) * 256 + lane * 4); }
                    PG8_GOFF(j0, j1, w0, w1); vl0[0] = w0[0]; vl0[1] = w0[1]; vl1[0] = w1[0]; vl1[1] = w1[1]; }
                else { w0[0] = vc0[0]; w0[1] = vc0[1]; w1[0] = vc1[0]; w1[1] = vc1[1]; }
            } else { w0[0] = w1[0] = voffA[0]; w0[1] = w1[1] = voffA[1]; }
            PG8_LDB(B0, 0, 0); PG8_LDB(B1, 0, 1); PG8_SCHED; PG8_LDA(At, 0, 0); PG8_STAGE(PG8_SA(1, 1), a1_1, vc1);
            PG8_WAIT_V(8); PG8_WAIT_L(0); PG8_BAR; PG8_MMA(0, 0, At, B0); PG8_MMA(0, 1, At, B1); PG8_BAR; PG8_SCHED;
            PG8_LDA(At, 0, 1); PG8_STAGE(PG8_SB(0, 0), b2, voffB); PG8_STAGE(PG8_SB(0, 1), b2 + hstep, voffB); PG8_STAGE(PG8_SA(0, 0), a2_0, w0);
            PG8_WAIT_V(8); PG8_WAIT_L(0); PG8_BAR; PG8_MMA(1, 0, At, B0); PG8_MMA(1, 1, At, B1); PG8_BAR; PG8_SCHED;
            PG8_LDB(B0, 1, 0); PG8_LDB(B1, 1, 1); PG8_SCHED; PG8_LDA(At, 1, 0); PG8_STAGE(PG8_SA(0, 1), a2_1, w1);
            PG8_WAIT_V(8); PG8_WAIT_L(0); PG8_BAR; PG8_MMA(0, 0, At, B0); PG8_MMA(0, 1, At, B1); PG8_BAR; PG8_SCHED;
            PG8_LDA(At, 1, 1); PG8_STAGE(PG8_SB(1, 0), b3, voffB); PG8_STAGE(PG8_SB(1, 1), b3 + hstep, voffB); PG8_STAGE(PG8_SA(1, 0), a3_0, w0);
            PG8_WAIT_V(8); PG8_WAIT_L(0); PG8_BAR; PG8_MMA(1, 0, At, B0); PG8_MMA(1, 1, At, B1); PG8_BAR; PG8_SCHED;
        }
        if (wr == 0) PG8_BAR;
        E(acc, cur, wr, wc, fr, fq);
        if (!has_next) break;
#pragma unroll
        for (int a = 0; a < 2; ++a)
#pragma unroll
            for (int b = 0; b < 2; ++b)
#pragma unroll
                for (int m = 0; m < 4; ++m)
#pragma unroll
                    for (int n = 0; n < 2; ++n) acc[a][b][m][n] = (f32x4){0.f, 0.f, 0.f, 0.f};
        cur = nxt; cA0 = nA0; cA1 = nA1; cB = nB; ++ui;
        if constexpr (GA) { vc0[0] = vl0[0]; vc0[1] = vl0[1]; vc1[0] = vl1[0]; vc1[1] = vl1[1]; }
        if (wr == 1) PG8_BAR;
    }
    PG8_WAIT_V(0);
    PG8_BAR;
#undef PG8_GIDX
#undef PG8_GIDX_DMA
#undef PG8_GOFF
#undef PG8_SA
#undef PG8_SB
#undef PG8_STAGE
#undef PG8_LDA
#undef PG8_LDB
#undef PG8_MMA
#undef PG8_WAIT_V
#undef PG8_WAIT_L
#undef PG8_BAR
#undef PG8_SCHED
}
}

namespace att {
using bf16 = unsigned short;
constexpr int   NW = 8, QBLK = 32, KVBLK = 64;
constexpr int   D = 128;
constexpr float THR = 8.f;
constexpr int LDQ = NQD, LDKK = NQD, LDV = NQKV, LDO = NOF;
constexpr size_t SHM_V = KVBLK * D * 2, SHM_K = KVBLK * D * 2, SHM_ATTN = 2 * SHM_V + 2 * SHM_K + NW * 64 * 4;
using bf16x8 = ::bf16x8; using s16x4 = ::s16x4; using f32x16 = ::f32x16; using u32x4 = ::u32x4;
template <int DQK> __device__ __forceinline__ int kswz(int row, int colB) { return DQK == 128 ? row * 256 + (colB ^ ((row & 7) << 4)) : row * 128 + (colB ^ (((row >> 1) & 7) << 4)); }

template <bool FIRST> __device__ __forceinline__ void partialSM(f32x16& p0, f32x16& p1, float& m_reg, float& alpha) {
  constexpr float THR2 = THR * 1.4426950408889634f;
  float pmax = p0[0]; for (int r = 1; r < 16; ++r) pmax = fmaxf(pmax, p0[r]); for (int r = 0; r < 16; ++r) pmax = fmaxf(pmax, p1[r]);
  { auto rr = __builtin_amdgcn_permlane32_swap(__float_as_uint(pmax), __float_as_uint(pmax), false, false);
    pmax = fmaxf(__uint_as_float(rr[0]), __uint_as_float(rr[1])); }
  if (!FIRST && __builtin_expect(__all(pmax <= THR2), 1)) { alpha = 1.f; }
  else { const float sh = FIRST ? pmax : fmaxf(pmax, 0.f); alpha = FIRST ? 1.f : __builtin_amdgcn_exp2f(-sh); m_reg += sh;
    for (int r = 0; r < 16; ++r) p0[r] -= sh; for (int r = 0; r < 16; ++r) p1[r] -= sh; }
  for (int r = 0; r < 16; ++r) p0[r] = __builtin_amdgcn_exp2f(p0[r]);
}
__device__ __forceinline__ void finishSM(f32x16& p0, f32x16& p1, float alpha, float& l_reg, bf16x8& pa0, bf16x8& pa1, bf16x8& pa2, bf16x8& pa3) {
  for (int r = 0; r < 16; ++r) p1[r] = __builtin_amdgcn_exp2f(p1[r]);
  float ps = 0; for (int r = 0; r < 16; ++r) ps += p0[r]; for (int r = 0; r < 16; ++r) ps += p1[r];
  { auto rr = __builtin_amdgcn_permlane32_swap(__float_as_uint(ps), __float_as_uint(ps), false, false);
    ps = __uint_as_float(rr[0]) + __uint_as_float(rr[1]); }
  l_reg = l_reg * alpha + ps;
#define PK4(P, BASE, OUT) do { unsigned a0 = cvtpk_s(P[BASE + 0], P[BASE + 1]), a1 = cvtpk_s(P[BASE + 2], P[BASE + 3]);   \
    unsigned b0 = cvtpk_s(P[BASE + 4], P[BASE + 5]), b1 = cvtpk_s(P[BASE + 6], P[BASE + 7]);                              \
    auto r0 = __builtin_amdgcn_permlane32_swap(a0, b0, false, false); auto r1 = __builtin_amdgcn_permlane32_swap(a1, b1, false, false); \
    u32x4 w = {r0[0], r1[0], r0[1], r1[1]}; OUT = *reinterpret_cast<bf16x8*>(&w); } while (0)
  PK4(p0, 0, pa0); PK4(p0, 8, pa1); PK4(p1, 0, pa2); PK4(p1, 8, pa3);
#undef PK4
}
template <int DQK> __device__ __forceinline__ void qkt(f32x16& p0, f32x16& p1, const bf16* Ks, const bf16x8* qr, int r32, int hi, float negm) {
  for (int r = 0; r < 16; ++r) { p0[r] = negm; p1[r] = negm; }
  for (int d0 = 0; d0 < DQK / 16; ++d0) { int cb = (d0 * 16 + hi * 8) * 2;
    bf16x8 b0 = *reinterpret_cast<const bf16x8*>((const char*)Ks + kswz<DQK>(r32, cb));
    bf16x8 b1 = *reinterpret_cast<const bf16x8*>((const char*)Ks + kswz<DQK>(32 + r32, cb));
    p0 = __builtin_amdgcn_mfma_f32_32x32x16_bf16(b0, qr[d0], p0, 0, 0, 0);
    p1 = __builtin_amdgcn_mfma_f32_32x32x16_bf16(b1, qr[d0], p1, 0, 0, 0); }
}
__device__ __forceinline__ int v_st(int k, int c) { const int kk = (k & ~0xC) | ((k & 4) << 1) | ((k & 8) >> 1); return ((kk >> 3) * 4 + (c >> 5)) * 512 + ((kk & 7) * 32 + (c & 31)) * 2; }
__device__ __forceinline__ int v_rd_base(int lane) { return ((lane & 3) << 3) | (((lane >> 2) & 3) << 6) | (((lane >> 4) & 1) << 5) | (((lane >> 5) & 1) << 8); }
constexpr int v_rd_off(int d0, int ks, int half) { return d0 * 512 + ks * 4096 + half * 2048; }
template <int OFF> __device__ __forceinline__ s16x4 tr_read(int vb) {
  s16x4 r; asm volatile("ds_read_b64_tr_b16 %0, %1 offset:%2" : "=&v"(r) : "v"(vb), "i"(OFF) : "memory"); return r;
}
template <int D0> __device__ __forceinline__ void pv_one(f32x16& od, int vb, bf16x8 pa0, bf16x8 pa1, bf16x8 pa2, bf16x8 pa3) {
  const s16x4 l0 = tr_read<v_rd_off(D0, 0, 0)>(vb), h0 = tr_read<v_rd_off(D0, 0, 1)>(vb), l1 = tr_read<v_rd_off(D0, 1, 0)>(vb), h1 = tr_read<v_rd_off(D0, 1, 1)>(vb);
  const s16x4 l2 = tr_read<v_rd_off(D0, 2, 0)>(vb), h2 = tr_read<v_rd_off(D0, 2, 1)>(vb), l3 = tr_read<v_rd_off(D0, 3, 0)>(vb), h3 = tr_read<v_rd_off(D0, 3, 1)>(vb);
  asm volatile("s_waitcnt lgkmcnt(0)" ::: "memory"); SBAR();
#define PK(L, H) (bf16x8){L[0], L[1], L[2], L[3], H[0], H[1], H[2], H[3]}
  od = __builtin_amdgcn_mfma_f32_32x32x16_bf16(pa0, PK(l0, h0), od, 0, 0, 0);
  od = __builtin_amdgcn_mfma_f32_32x32x16_bf16(pa1, PK(l1, h1), od, 0, 0, 0);
  od = __builtin_amdgcn_mfma_f32_32x32x16_bf16(pa2, PK(l2, h2), od, 0, 0, 0);
  od = __builtin_amdgcn_mfma_f32_32x32x16_bf16(pa3, PK(l3, h3), od, 0, 0, 0);
#undef PK
}
#define PV_READ8(D0, l0, h0, l1, h1, l2, h2, l3, h3) \
  const s16x4 l0 = tr_read<v_rd_off(D0, 0, 0)>(vb), h0 = tr_read<v_rd_off(D0, 0, 1)>(vb), l1 = tr_read<v_rd_off(D0, 1, 0)>(vb), h1 = tr_read<v_rd_off(D0, 1, 1)>(vb); \
  const s16x4 l2 = tr_read<v_rd_off(D0, 2, 0)>(vb), h2 = tr_read<v_rd_off(D0, 2, 1)>(vb), l3 = tr_read<v_rd_off(D0, 3, 0)>(vb), h3 = tr_read<v_rd_off(D0, 3, 1)>(vb);
#define PV_MMA4(od, l0, h0, l1, h1, l2, h2, l3, h3) do { \
  od = __builtin_amdgcn_mfma_f32_32x32x16_bf16(pa0, (bf16x8){l0[0], l0[1], l0[2], l0[3], h0[0], h0[1], h0[2], h0[3]}, od, 0, 0, 0); \
  od = __builtin_amdgcn_mfma_f32_32x32x16_bf16(pa1, (bf16x8){l1[0], l1[1], l1[2], l1[3], h1[0], h1[1], h1[2], h1[3]}, od, 0, 0, 0); \
  od = __builtin_amdgcn_mfma_f32_32x32x16_bf16(pa2, (bf16x8){l2[0], l2[1], l2[2], l2[3], h2[0], h2[1], h2[2], h2[3]}, od, 0, 0, 0); \
  od = __builtin_amdgcn_mfma_f32_32x32x16_bf16(pa3, (bf16x8){l3[0], l3[1], l3[2], l3[3], h3[0], h3[1], h3[2], h3[3]}, od, 0, 0, 0); } while (0)
__device__ __forceinline__ void pv_d0p(f32x16* o, int vb, bf16x8 pa0, bf16x8 pa1, bf16x8 pa2, bf16x8 pa3) {
  SBAR();
  PV_READ8(0, a0, b0, a1, b1, a2, b2, a3, b3)
  PV_READ8(1, c0, d0, c1, d1, c2, d2, c3, d3)
  asm volatile("s_waitcnt lgkmcnt(8)" ::: "memory"); SBAR();
  PV_MMA4(o[0], a0, b0, a1, b1, a2, b2, a3, b3);
  PV_READ8(2, e0, f0, e1, f1, e2, f2, e3, f3)
  asm volatile("s_waitcnt lgkmcnt(8)" ::: "memory"); SBAR();
  PV_MMA4(o[1], c0, d0, c1, d1, c2, d2, c3, d3);
  PV_READ8(3, g0, h0, g1, h1, g2, h2, g3, h3)
  asm volatile("s_waitcnt lgkmcnt(8)" ::: "memory"); SBAR();
  PV_MMA4(o[2], e0, f0, e1, f1, e2, f2, e3, f3);
  asm volatile("s_waitcnt lgkmcnt(0)" ::: "memory"); SBAR();
  PV_MMA4(o[3], g0, h0, g1, h1, g2, h2, g3, h3);
}
__device__ __forceinline__ void pv_d0(f32x16* o, int vb, bf16x8 pa0, bf16x8 pa1, bf16x8 pa2, bf16x8 pa3) {
  pv_one<0>(o[0], vb, pa0, pa1, pa2, pa3); pv_one<1>(o[1], vb, pa0, pa1, pa2, pa3); pv_one<2>(o[2], vb, pa0, pa1, pa2, pa3); pv_one<3>(o[3], vb, pa0, pa1, pa2, pa3);
}

template <int DQK>
__device__ __forceinline__ void attn_dense_body(const bf16* __restrict__ Qb, const bf16* __restrict__ Kh, const bf16* __restrict__ Vh,
                                                float* __restrict__ Ob, int seq, char* lds, int wave_) {
  constexpr int NQ = DQK / 16;
  int tid = tid_fresh(wave_); asm volatile("" : "+v"(tid));
  const int wid = tid >> 6, lane = tid & 63, r32 = lane & 31, hi = lane >> 5;
  bf16* V_lds = (bf16*)lds; bf16* K_lds = (bf16*)(lds + 2 * SHM_V);
  float* ws = (float*)(lds + 2 * SHM_V + 2 * SHM_K) + wid * 64; float* li_l = ws; float* al_l = ws + 32;
  float m_reg = 0.f  , l_reg = 0; f32x16 o[4] = {}; bf16x8 qr[NQ];
  const bf16* Qw = Qb + (long)(wid * QBLK + r32) * LDQ + hi * 8;
#pragma unroll
  for (int d0 = 0; d0 < NQ; ++d0) qr[d0] = *reinterpret_cast<const bf16x8*>(Qw + d0 * 16);
  const int sr = tid >> 4, sc = (tid & 15) * 8, vst0 = v_st(sr, sc), vst1 = v_st(32 + sr, sc);
  const int kr = tid >> 3, kc8 = (tid & 7) * 8;
  const int vb0 = (int)(uintptr_t)V_lds + v_rd_base(lane);
  struct { bf16x8 vs0, vs1, ks0, ks1; } sr_[2];
#define SLOAD(i, k0) do { sr_[i].vs0 = *reinterpret_cast<const bf16x8*>(&Vh[(long)((k0) + sr) * LDV + sc]); sr_[i].vs1 = *reinterpret_cast<const bf16x8*>(&Vh[(long)((k0) + 32 + sr) * LDV + sc]); \
    if constexpr (DQK == 128) { sr_[i].ks0 = *reinterpret_cast<const bf16x8*>(&Kh[(long)((k0) + sr) * LDKK + sc]); sr_[i].ks1 = *reinterpret_cast<const bf16x8*>(&Kh[(long)((k0) + 32 + sr) * LDKK + sc]); } \
    else { sr_[i].ks0 = *reinterpret_cast<const bf16x8*>(&Kh[(long)((k0) + kr) * LDKK + kc8]); } } while (0)
#define SWRITE(b, i) do { *(bf16x8*)((char*)V_lds + (b) * SHM_V + vst0) = sr_[i].vs0;          \
    *(bf16x8*)((char*)V_lds + (b) * SHM_V + vst1) = sr_[i].vs1;               \
    if constexpr (DQK == 128) { *(bf16x8*)((char*)K_lds + (b) * SHM_K + kswz<128>(sr, sc * 2)) = sr_[i].ks0;                       \
    *(bf16x8*)((char*)K_lds + (b) * SHM_K + kswz<128>(32 + sr, sc * 2)) = sr_[i].ks1; } \
    else { *(bf16x8*)((char*)K_lds + (b) * SHM_K + kswz<64>(kr, kc8 * 2)) = sr_[i].ks0; } } while (0)
#define SWAIT() do { if constexpr (DQK == 128) asm volatile("s_waitcnt vmcnt(4)" ::: "memory"); else asm volatile("s_waitcnt vmcnt(3)" ::: "memory"); } while (0)
#define RESC(a) do { if (__any((a) < 1.f)) { if (hi == 0) al_l[r32] = (a); asm volatile("s_waitcnt lgkmcnt(0)" ::: "memory"); \
    for (int d = 0; d < 4; ++d) for (int r = 0; r < 16; ++r) o[d][r] *= al_l[crow(r, hi)]; } } while (0)
  f32x16 pA0, pA1, pB0, pB1; float alA, alB; bf16x8 pa0, pa1, pa2, pa3; const int NT = seq / KVBLK;
  constexpr int SE = 0, SO = 1;
  SLOAD(SE, 0); asm volatile("s_waitcnt vmcnt(0)" ::: "memory"); SWRITE(0, SE); __syncthreads();
  qkt<DQK>(pA0, pA1, K_lds, qr, r32, hi, 0.f); partialSM<true>(pA0, pA1, m_reg, alA);
  SLOAD(SO, KVBLK); SLOAD(SE, 2 * KVBLK);
  SWAIT(); SWRITE(1, SO); __syncthreads();
  for (int j = 1; j + 1 < NT; j += 2) {
    SBAR(); qkt<DQK>(pB0, pB1, (bf16*)((char*)K_lds + SHM_K), qr, r32, hi, -m_reg);
    finishSM(pA0, pA1, alA, l_reg, pa0, pa1, pa2, pa3); SBAR();
    SLOAD(SO, (j + 2) * KVBLK); SBAR();
    pv_d0(o, vb0, pa0, pa1, pa2, pa3); partialSM<false>(pB0, pB1, m_reg, alB);
    __syncthreads(); SWAIT(); SWRITE(0, SE);
    RESC(alB); __syncthreads();
    SBAR(); qkt<DQK>(pA0, pA1, K_lds, qr, r32, hi, -m_reg);
    finishSM(pB0, pB1, alB, l_reg, pa0, pa1, pa2, pa3); SBAR();
    { const int jn = (j + 3 < NT) ? j + 3 : NT - 1; SLOAD(SE, jn * KVBLK); } SBAR();
    pv_d0(o, vb0 + (int)SHM_V, pa0, pa1, pa2, pa3); partialSM<false>(pA0, pA1, m_reg, alA);
    __syncthreads(); SWAIT(); SWRITE(1, SO);
    RESC(alA); __syncthreads();
  }
  SBAR(); qkt<DQK>(pB0, pB1, (bf16*)((char*)K_lds + SHM_K), qr, r32, hi, -m_reg);
  finishSM(pA0, pA1, alA, l_reg, pa0, pa1, pa2, pa3); SBAR();
  pv_d0(o, vb0, pa0, pa1, pa2, pa3); partialSM<false>(pB0, pB1, m_reg, alB);
  __syncthreads(); RESC(alB);
  finishSM(pB0, pB1, alB, l_reg, pa0, pa1, pa2, pa3); SBAR();
  pv_d0(o, vb0 + (int)SHM_V, pa0, pa1, pa2, pa3);
  if (hi == 0) li_l[r32] = l_reg; asm volatile("s_waitcnt lgkmcnt(0)" ::: "memory");
  float rli[16];
#pragma unroll
  for (int r = 0; r < 16; ++r) rli[r] = __builtin_amdgcn_rcpf(li_l[crow(r, hi)]);
  float* Ow = Ob + (long)(wid * QBLK) * LDO;
#pragma unroll
  for (int r = 0; r < 16; ++r) { int orow = crow(r, hi);
    for (int d0 = 0; d0 < 4; ++d0) Ow[(long)orow * LDO + d0 * 32 + r32] = o[d0][r] * rli[r]; }
#undef SLOAD
#undef SWRITE
#undef SWAIT
#undef RESC
}


template <int DQK>
__device__ __forceinline__ void attn_dense_body2(const bf16* __restrict__ Qb, const bf16* __restrict__ Kh, const bf16* __restrict__ Vh,
                                                 float* __restrict__ Ob, int seq, char* lds, int wave_) {
  constexpr int NQ = DQK / 16;
  int tid = tid_fresh(wave_); asm volatile("" : "+v"(tid));
  const int wid = tid >> 6, lane = tid & 63, r32 = lane & 31, hi = lane >> 5;
  const int widu = __builtin_amdgcn_readfirstlane(wid);
  char* V_ring = lds; char* K_ring = lds + 65536;
  float* ws = (float*)(lds + 65536 + 49152) + wid * 64; float* li_l = ws; float* al_l = ws + 32;
  float m_reg = 0.f, l_reg = 0; f32x16 o[4] = {}; bf16x8 qr[NQ];
  const bf16* Qw = Qb + (long)(wid * QBLK + r32) * LDQ + hi * 8;
#pragma unroll
  for (int d0 = 0; d0 < NQ; ++d0) qr[d0] = *reinterpret_cast<const bf16x8*>(Qw + d0 * 16);
  int voff[2], koff[2];
#pragma unroll
  for (int i = 0; i < 2; ++i) { const int o_ = (((wid * 2 + i) * 64 + lane) & 1023) * 16, sub = o_ >> 9, wi = o_ & 511, kk = ((sub >> 2) << 3) | (wi >> 6);
    const int k = (kk & ~0xC) | ((kk & 4) << 1) | ((kk & 8) >> 1), c = ((sub & 3) << 5) | ((wi & 63) >> 1); voff[i] = k * LDV + c;
    if constexpr (DQK == 128) { const int row = o_ >> 8, cB = (o_ & 255) ^ ((row & 7) << 4); koff[i] = row * LDKK + (cB >> 1); }
    else { const int o2 = ((wid * 64 + lane) & 511) * 16, row = o2 >> 7, cB = (o2 & 127) ^ (((row >> 1) & 7) << 4); koff[i] = row * LDKK + (cB >> 1); } }
  const int vrd = (int)(uintptr_t)V_ring + v_rd_base(lane);
#define ADMA(t_, kb_, vb_) do { const long k0_ = (long)(t_) * KVBLK; \
    _Pragma("unroll") for (int i_ = 0; i_ < 2; ++i_) __builtin_amdgcn_global_load_lds((const unsigned*)(Vh + k0_ * LDV + voff[i_]), (__attribute__((address_space(3))) unsigned*)(uintptr_t)((unsigned)(uintptr_t)V_ring + (vb_) * 16384 + (widu * 2 + i_) * 1024), 16, 0, 0); \
    if constexpr (DQK == 128) { _Pragma("unroll") for (int i_ = 0; i_ < 2; ++i_) __builtin_amdgcn_global_load_lds((const unsigned*)(Kh + k0_ * LDKK + koff[i_]), (__attribute__((address_space(3))) unsigned*)(uintptr_t)((unsigned)(uintptr_t)K_ring + (kb_) * 16384 + (widu * 2 + i_) * 1024), 16, 0, 0); } \
    else __builtin_amdgcn_global_load_lds((const unsigned*)(Kh + k0_ * LDKK + koff[0]), (__attribute__((address_space(3))) unsigned*)(uintptr_t)((unsigned)(uintptr_t)K_ring + (kb_) * 16384 + widu * 1024), 16, 0, 0); } while (0)
#define AWAIT() do { if constexpr (DQK == 128) asm volatile("s_waitcnt vmcnt(4) lgkmcnt(0)" ::: "memory"); else asm volatile("s_waitcnt vmcnt(3) lgkmcnt(0)" ::: "memory"); \
    __builtin_amdgcn_s_barrier(); asm volatile("" ::: "memory"); } while (0)
#define RESC(a) do { if (__any((a) < 1.f)) { if (hi == 0) al_l[r32] = (a); asm volatile("s_waitcnt lgkmcnt(0)" ::: "memory"); \
    for (int d = 0; d < 4; ++d) for (int r = 0; r < 16; ++r) o[d][r] *= al_l[crow(r, hi)]; } } while (0)
#define KB3(x) ((x) >= 3 ? (x) - 3 : (x))
#define VB4(x) ((x) & 3)
  f32x16 pA0, pA1, pB0, pB1; float alA, alB; bf16x8 pa0, pa1, pa2, pa3; const int NT = seq / KVBLK;
  asm volatile("s_waitcnt vmcnt(0)" ::: "memory");
  ADMA(0, 0, 0); ADMA(1, 1, 1);
  AWAIT();
  ADMA(2, 2, 2);
  qkt<DQK>(pA0, pA1, (const bf16*)K_ring, qr, r32, hi, 0.f); partialSM<true>(pA0, pA1, m_reg, alA);
  int kb = 1, vb = 1;
  for (int j = 1; j + 1 < NT; j += 2) {
    AWAIT();
    { const int jn = (j + 2 < NT) ? j + 2 : NT - 1; ADMA(jn, KB3(kb + 2), VB4(vb + 2)); }
    SBAR(); __builtin_amdgcn_s_setprio(1); qkt<DQK>(pB0, pB1, (const bf16*)(K_ring + kb * 16384), qr, r32, hi, -m_reg);
    finishSM(pA0, pA1, alA, l_reg, pa0, pa1, pa2, pa3); SBAR();
    pv_d0p(o, vrd + VB4(vb + 3) * 16384, pa0, pa1, pa2, pa3); partialSM<false>(pB0, pB1, m_reg, alB); __builtin_amdgcn_s_setprio(0);
    RESC(alB);
    kb = KB3(kb + 1); vb = VB4(vb + 1);
    AWAIT();
    { const int jn = (j + 3 < NT) ? j + 3 : NT - 1; ADMA(jn, KB3(kb + 2), VB4(vb + 2)); }
    SBAR(); __builtin_amdgcn_s_setprio(1); qkt<DQK>(pA0, pA1, (const bf16*)(K_ring + kb * 16384), qr, r32, hi, -m_reg);
    finishSM(pB0, pB1, alB, l_reg, pa0, pa1, pa2, pa3); SBAR();
    pv_d0p(o, vrd + VB4(vb + 3) * 16384, pa0, pa1, pa2, pa3); partialSM<false>(pA0, pA1, m_reg, alA); __builtin_amdgcn_s_setprio(0);
    RESC(alA);
    kb = KB3(kb + 1); vb = VB4(vb + 1);
  }
  asm volatile("s_waitcnt vmcnt(0) lgkmcnt(0)" ::: "memory"); __builtin_amdgcn_s_barrier(); asm volatile("" ::: "memory");
  SBAR(); __builtin_amdgcn_s_setprio(1); qkt<DQK>(pB0, pB1, (const bf16*)(K_ring + kb * 16384), qr, r32, hi, -m_reg);
  finishSM(pA0, pA1, alA, l_reg, pa0, pa1, pa2, pa3); SBAR();
  pv_d0p(o, vrd + VB4(vb + 3) * 16384, pa0, pa1, pa2, pa3); partialSM<false>(pB0, pB1, m_reg, alB); __builtin_amdgcn_s_setprio(0);
  RESC(alB);
  finishSM(pB0, pB1, alB, l_reg, pa0, pa1, pa2, pa3); SBAR();
  pv_d0p(o, vrd + vb * 16384, pa0, pa1, pa2, pa3);
  if (hi == 0) li_l[r32] = l_reg; asm volatile("s_waitcnt lgkmcnt(0)" ::: "memory");
  float rli[16];
#pragma unroll
  for (int r = 0; r < 16; ++r) rli[r] = __builtin_amdgcn_rcpf(li_l[crow(r, hi)]);
  if constexpr (DQK == 128) {
    bf16_t* Ow = (bf16_t*)Ob + (long)(wid * QBLK) * 2048;
#pragma unroll
    for (int r = 0; r < 16; ++r) { int orow = crow(r, hi);
      for (int d0 = 0; d0 < 4; ++d0) { const float v = o[d0][r] * rli[r]; Ow[(long)orow * 2048 + d0 * 32 + r32] = (bf16_t)(cvtpk(v, v) & 0xffffu); } }
  } else {
    float* Ow = Ob + (long)(wid * QBLK) * LDO;
#pragma unroll
    for (int r = 0; r < 16; ++r) { int orow = crow(r, hi);
      for (int d0 = 0; d0 < 4; ++d0) Ow[(long)orow * LDO + d0 * 32 + r32] = o[d0][r] * rli[r]; }
  }
#undef ADMA
#undef AWAIT
#undef RESC
#undef KB3
#undef VB4
}

__device__ __forceinline__ void attn_diff512(const bf16* __restrict__ Qb, const bf16* __restrict__ Kh, const bf16* __restrict__ Vh,
                                             float* __restrict__ Ob, int seq, char* lds, int wave_) {
  int tid = tid_fresh(wave_); asm volatile("" : "+v"(tid));
  const int wid = tid >> 6, lane = tid & 63, r32 = lane & 31, hi = lane >> 5;
  const int widu = __builtin_amdgcn_readfirstlane(wid);
  char* V_ring = lds; char* K_ring = lds + 65536;
  __attribute__((address_space(3))) float* al_l = (__attribute__((address_space(3))) float*)(uintptr_t)((unsigned)(uintptr_t)lds + 65536 + 49152) + wid * 128 + 64;
  float m0 = 0.f, m1 = 0.f, l0 = 0.f, l1 = 0.f; f32x16 oa[4] = {}, ob[4] = {}; bf16x8 qa[4], qb[4];
  { const bf16* Qw = Qb + (long)(wid * 64 + r32) * LDQ + hi * 8;
#pragma unroll
    for (int d0 = 0; d0 < 4; ++d0) { qa[d0] = *reinterpret_cast<const bf16x8*>(Qw + d0 * 16); qb[d0] = *reinterpret_cast<const bf16x8*>(Qw + (long)32 * LDQ + d0 * 16); } }
#define VOFF(i) ({ const int o_ = (((wid * 2 + (i)) * 64 + lane) & 1023) * 16, sub = o_ >> 9, wi = o_ & 511, kk = ((sub >> 2) << 3) | (wi >> 6); \
    const int k = (kk & ~0xC) | ((kk & 4) << 1) | ((kk & 8) >> 1), c = ((sub & 3) << 5) | ((wi & 63) >> 1); k * LDV + c; })
#define KOFF() ({ const int o2 = ((wid * 64 + lane) & 511) * 16, row = o2 >> 7, cB = (o2 & 127) ^ (((row >> 1) & 7) << 4); row * LDKK + (cB >> 1); })
#define ADMA(t_, kb_, vb_) do { const long k0_ = (long)(t_) * KVBLK; \
    _Pragma("unroll") for (int i_ = 0; i_ < 2; ++i_) __builtin_amdgcn_global_load_lds((const unsigned*)(Vh + k0_ * LDV + VOFF(i_)), (__attribute__((address_space(3))) unsigned*)(uintptr_t)((unsigned)(uintptr_t)V_ring + (vb_) * 16384 + (widu * 2 + i_) * 1024), 16, 0, 0); \
    __builtin_amdgcn_global_load_lds((const unsigned*)(Kh + k0_ * LDKK + KOFF()), (__attribute__((address_space(3))) unsigned*)(uintptr_t)((unsigned)(uintptr_t)K_ring + (kb_) * 16384 + widu * 1024), 16, 0, 0); } while (0)
#define AWAIT() do { asm volatile("s_waitcnt vmcnt(3) lgkmcnt(0)" ::: "memory"); __builtin_amdgcn_s_barrier(); asm volatile("" ::: "memory"); } while (0)
#define KB3(x) ((x) >= 3 ? (x) - 3 : (x))
#define VB4(x) ((x) & 3)
#define SMG(p, mreg, lreg, oacc, G_, FIRST_, q0, q1) do { \
    float pmax = p[0]; _Pragma("unroll") for (int r = 1; r < 16; ++r) pmax = fmaxf(pmax, p[r]); \
    { auto rr = __builtin_amdgcn_permlane32_swap(__float_as_uint(pmax), __float_as_uint(pmax), false, false); pmax = fmaxf(__uint_as_float(rr[0]), __uint_as_float(rr[1])); } \
    float alpha = 1.f; \
    if ((FIRST_) || !__all(pmax <= THR * 1.4426950408889634f)) { const float sh = (FIRST_) ? pmax : fmaxf(pmax, 0.f); alpha = (FIRST_) ? 1.f : __builtin_amdgcn_exp2f(-sh); mreg += sh; \
        _Pragma("unroll") for (int r = 0; r < 16; ++r) p[r] -= sh; \
        if (!(FIRST_) && __any(alpha < 1.f)) { if (hi == 0) al_l[(G_) * 32 + r32] = alpha; asm volatile("s_waitcnt lgkmcnt(0)" ::: "memory"); \
            _Pragma("unroll") for (int d = 0; d < 4; ++d) _Pragma("unroll") for (int r = 0; r < 16; ++r) oacc[d][r] *= al_l[(G_) * 32 + crow(r, hi)]; } } \
    float ps = 0.f; \
    _Pragma("unroll") for (int r = 0; r < 16; ++r) { p[r] = __builtin_amdgcn_exp2f(p[r]); ps += p[r]; } \
    { auto rr = __builtin_amdgcn_permlane32_swap(__float_as_uint(ps), __float_as_uint(ps), false, false); ps = __uint_as_float(rr[0]) + __uint_as_float(rr[1]); } \
    lreg = lreg * alpha + ps; \
    PK4(p, 0, q0); PK4(p, 8, q1); } while (0)
#define PK4(P, BASE, OUT) do { unsigned a0_ = cvtpk_s(P[BASE + 0], P[BASE + 1]), a1_ = cvtpk_s(P[BASE + 2], P[BASE + 3]);   \
    unsigned b0_ = cvtpk_s(P[BASE + 4], P[BASE + 5]), b1_ = cvtpk_s(P[BASE + 6], P[BASE + 7]);                              \
    auto r0_ = __builtin_amdgcn_permlane32_swap(a0_, b0_, false, false); auto r1_ = __builtin_amdgcn_permlane32_swap(a1_, b1_, false, false); \
    u32x4 w_ = {r0_[0], r1_[0], r0_[1], r1_[1]}; OUT = *reinterpret_cast<bf16x8*>(&w_); } while (0)
#define PV_READ4(D0, H, l0, h0, l1, h1) \
  const s16x4 l0 = tr_read<v_rd_off(D0, 2 * (H), 0)>(vb), h0 = tr_read<v_rd_off(D0, 2 * (H), 1)>(vb), l1 = tr_read<v_rd_off(D0, 2 * (H) + 1, 0)>(vb), h1 = tr_read<v_rd_off(D0, 2 * (H) + 1, 1)>(vb);
#define PV_MM4(oA, oB, l0, h0, l1, h1) do { \
  const bf16x8 v0_ = (bf16x8){l0[0], l0[1], l0[2], l0[3], h0[0], h0[1], h0[2], h0[3]}, v1_ = (bf16x8){l1[0], l1[1], l1[2], l1[3], h1[0], h1[1], h1[2], h1[3]}; \
  oA = __builtin_amdgcn_mfma_f32_32x32x16_bf16(fa0, v0_, oA, 0, 0, 0); oB = __builtin_amdgcn_mfma_f32_32x32x16_bf16(fb0, v0_, oB, 0, 0, 0); \
  oA = __builtin_amdgcn_mfma_f32_32x32x16_bf16(fa1, v1_, oA, 0, 0, 0); oB = __builtin_amdgcn_mfma_f32_32x32x16_bf16(fb1, v1_, oB, 0, 0, 0); } while (0)
#define HALF(kb_, vb_, H, FIRST_) do { \
    f32x16 pa_, pb_; \
    _Pragma("unroll") for (int r = 0; r < 16; ++r) { pa_[r] = -m0; pb_[r] = -m1; } \
    if (widu >= 4) __builtin_amdgcn_s_setprio(2); else __builtin_amdgcn_s_setprio(1); \
    { const char* Ks_ = K_ring + (kb_) * 16384; \
      _Pragma("unroll") for (int d0 = 0; d0 < 4; ++d0) { const int cb = (d0 * 16 + hi * 8) * 2; \
        const bf16x8 kf = *reinterpret_cast<const bf16x8*>(Ks_ + kswz<64>(32 * (H) + r32, cb)); \
        pa_ = __builtin_amdgcn_mfma_f32_32x32x16_bf16(kf, qa[d0], pa_, 0, 0, 0); pb_ = __builtin_amdgcn_mfma_f32_32x32x16_bf16(kf, qb[d0], pb_, 0, 0, 0); } } \
    if (widu >= 4) __builtin_amdgcn_s_setprio(1); else __builtin_amdgcn_s_setprio(0); \
    bf16x8 fa0, fa1, fb0, fb1; \
    SMG(pa_, m0, l0, oa, 0, FIRST_, fa0, fa1); \
    SMG(pb_, m1, l1, ob, 1, FIRST_, fb0, fb1); \
    { const int vb = (int)(uintptr_t)V_ring + v_rd_base(lane) + (vb_) * 16384; SBAR(); if (widu >= 4) __builtin_amdgcn_s_setprio(2); else __builtin_amdgcn_s_setprio(1); \
      PV_READ4(0, H, a0, b0, a1, b1) \
      PV_READ4(1, H, c0, d0, c1, d1) \
      asm volatile("s_waitcnt lgkmcnt(4)" ::: "memory"); SBAR(); \
      PV_MM4(oa[0], ob[0], a0, b0, a1, b1); \
      PV_READ4(2, H, e0, f0, e1, f1) \
      asm volatile("s_waitcnt lgkmcnt(4)" ::: "memory"); SBAR(); \
      PV_MM4(oa[1], ob[1], c0, d0, c1, d1); \
      PV_READ4(3, H, g0, h0, g1, h1) \
      asm volatile("s_waitcnt lgkmcnt(4)" ::: "memory"); SBAR(); \
      PV_MM4(oa[2], ob[2], e0, f0, e1, f1); \
      asm volatile("s_waitcnt lgkmcnt(0)" ::: "memory"); SBAR(); \
      PV_MM4(oa[3], ob[3], g0, h0, g1, h1); if (widu >= 4) __builtin_amdgcn_s_setprio(1); else __builtin_amdgcn_s_setprio(0); } } while (0)
#define TILE(kb_, vb_, FIRST_) do { HALF(kb_, vb_, 0, FIRST_); HALF(kb_, vb_, 1, false); } while (0)
  const int NT = seq / KVBLK;
  asm volatile("s_waitcnt vmcnt(0)" ::: "memory");
  ADMA(0, 0, 0); ADMA(1, 1, 1);
  AWAIT();
  ADMA(2, 2, 2);
  TILE(0, 0, true);
  int kb = 1, vb4 = 1;
  for (int j = 1; j < NT; ++j) {
    if (j + 1 < NT) { AWAIT(); } else { asm volatile("s_waitcnt vmcnt(0) lgkmcnt(0)" ::: "memory"); __builtin_amdgcn_s_barrier(); asm volatile("" ::: "memory"); }
    if (j + 1 < NT) { const int jn = (j + 2 < NT) ? j + 2 : NT - 1; ADMA(jn, KB3(kb + 2), VB4(vb4 + 2)); }
    TILE(kb, vb4, false);
    kb = KB3(kb + 1); vb4 = VB4(vb4 + 1);
  }
  __builtin_amdgcn_s_setprio(0);
  if (hi == 0) { al_l[r32 - 64] = l0; al_l[r32 - 32] = l1; } asm volatile("s_waitcnt lgkmcnt(0)" ::: "memory");
  float* Ow = Ob + (long)(wid * 64) * LDO;
#pragma unroll
  for (int r = 0; r < 16; ++r) { const int orow = crow(r, hi); const float ra = __builtin_amdgcn_rcpf(al_l[orow - 64]);
#pragma unroll
    for (int d0 = 0; d0 < 4; ++d0) Ow[(long)orow * LDO + d0 * 32 + r32] = oa[d0][r] * ra; }
  SBAR();
#pragma unroll
  for (int r = 0; r < 16; ++r) { const int orow = crow(r, hi); const float rb = __builtin_amdgcn_rcpf(al_l[orow - 32]);
#pragma unroll
    for (int d0 = 0; d0 < 4; ++d0) Ow[(long)(32 + orow) * LDO + d0 * 32 + r32] = ob[d0][r] * rb; }
#undef ADMA
#undef AWAIT
#undef KB3
#undef VB4
#undef SMG
#undef PK4
#undef TILE
#undef HALF
#undef VOFF
#undef KOFF
#undef PV_MM4
#undef PV_READ4
}

typedef short v4i16_t __attribute__((ext_vector_type(4)));
__device__ __forceinline__ s16x4 vtr(int addr) { return __builtin_bit_cast(s16x4, __builtin_amdgcn_ds_read_tr16_b64_v4i16((__attribute__((address_space(3))) v4i16_t*)(uintptr_t)(unsigned)addr)); }
#define PKF(L, H) (bf16x8){L[0], L[1], L[2], L[3], H[0], H[1], H[2], H[3]}
template <int D0, int KS> __device__ __forceinline__ bf16x8 vfragc(int vb) {
  const s16x4 l = vtr(vb + v_rd_off(D0, KS, 0)), h = vtr(vb + v_rd_off(D0, KS, 1));
  return (bf16x8){l[0], l[1], l[2], l[3], h[0], h[1], h[2], h[3]};
}
template <int D0, int KS> __device__ __forceinline__ bf16x8 vfrag(int vb) {
  const s16x4 l = tr_read<v_rd_off(D0, KS, 0)>(vb), h = tr_read<v_rd_off(D0, KS, 1)>(vb);
  asm volatile("s_waitcnt lgkmcnt(0)" ::: "memory"); SBAR();
  return PKF(l, h);
}
#define PK4(P, BASE, OUT) do { unsigned a0 = cvtpk_s(P[BASE + 0], P[BASE + 1]), a1 = cvtpk_s(P[BASE + 2], P[BASE + 3]);   \
    unsigned b0 = cvtpk_s(P[BASE + 4], P[BASE + 5]), b1 = cvtpk_s(P[BASE + 6], P[BASE + 7]);                              \
    auto r0 = __builtin_amdgcn_permlane32_swap(a0, b0, false, false); auto r1 = __builtin_amdgcn_permlane32_swap(a1, b1, false, false); \
    u32x4 w = {r0[0], r1[0], r0[1], r1[1]}; OUT = *reinterpret_cast<bf16x8*>(&w); } while (0)
}

constexpr int NIN = 39;
constexpr int NPHASE = 24;
struct Args { const float* in[NIN]; float* out; unsigned char* ws; int ph_lo, ph_hi; };
enum { I_X = 0, I_C, I_CTX, I_CCTX,
       I_WMOD0, I_BMOD0, I_GPREMIX0, I_GPOSTMIX0, I_WIN0, I_LQ1, I_LK1, I_LQ2, I_LK2, I_GSUBLN, I_GQ, I_GK, I_WOUT0, I_GPREFFN0, I_GPOSTFFN0, I_WROUTER0, I_WGATE0, I_WUP0, I_WDOWN0,
       I_WMOD1, I_BMOD1, I_GPREMIX1, I_GPOSTMIX1, I_WIN1, I_BGATE1, I_WCONV1, I_BCONV1, I_GHEAD1, I_WOUT1, I_GPREFFN1, I_GPOSTFFN1, I_WROUTER1, I_WGATE1, I_WUP1, I_WDOWN1 };

__device__ __forceinline__ void tr_load(const float* __restrict__ W, int N, int k0, int n0, int lane, float (&v)[32]) {
#pragma unroll
    for (int i = 0; i < 32; ++i) { const int kk = 2 * i + (lane >> 5); v[i] = W[(size_t)(k0 + kk) * N + n0 + (lane & 31)]; }
}
__device__ __forceinline__ int win0_phys(int c) {
    if (c < 2048) { const int l = c & 63, n = l >> 5, i = l & 31; return (c & ~63) + 32 * (i >> 4) + 8 * ((i >> 2) & 3) + 4 * n + (i & 3); }
    if (c >= 3072 && c < 4352) { const int l = (c - 3072) & 127, n = l >> 6, i = l & 63; return 3072 + ((c - 3072) & ~127) + 32 * (i >> 4) + 8 * ((i >> 2) & 3) + 4 * n + (i & 3); }
    return c;
}
template <bool QKPERM = false>
__device__ __forceinline__ void tr_store(const float (&v)[32], int k0, bf16_t* WT, size_t out_row0, LAS float* scr, int lane) {
#pragma unroll
    for (int i = 0; i < 32; ++i) { const int kk = 2 * i + (lane >> 5); scr[kk * 33 + (lane & 31)] = v[i]; }
    LDS_WAIT(); asm volatile("" ::: "memory");
    const int c = lane & 7;
#pragma unroll
    for (int j = 0; j < 4; ++j) { const int n = (lane >> 3) + 8 * j; const LAS float* s = scr + (8 * c) * 33 + n;
        u32x4 o; o.x = cvtpk(s[0 * 33], s[1 * 33]); o.y = cvtpk(s[2 * 33], s[3 * 33]); o.z = cvtpk(s[4 * 33], s[5 * 33]); o.w = cvtpk(s[6 * 33], s[7 * 33]);
        const size_t orow = QKPERM ? (size_t)win0_phys((int)out_row0 + n) : out_row0 + n;
        *(u32x4*)(WT + orow * (size_t)D + k0 + 8 * c) = o; }
    LDS_WAIT(); asm volatile("" ::: "memory");
}
template <bool QKPERM = false>
__device__ __forceinline__ void tr_item(const float* __restrict__ W, int N, int k0, int n0, bf16_t* WT, size_t out_row0, LAS float* scr, int lane) {
    float v[32]; tr_load(W, N, k0, n0, lane, v); tr_store<QKPERM>(v, k0, WT, out_row0, scr, lane);
}
struct ExpItem { const float* W; bf16_t* WT; size_t row0; int k0, n0; };
__device__ __forceinline__ ExpItem exp_item(int it, int kind, const float* wg, const float* wu, const float* wd, bf16_t* WGUp, bf16_t* WDp) {
    const int mat = it >> 11, r = it & 2047, kb = r >> 6, nb = r & 63, n0 = 32 * nb;
    const int e = kind == 0 ? mat / 3 : (kind == 1 ? mat >> 1 : mat), which = kind == 0 ? mat % 3 : (kind == 1 ? (mat & 1) : 2);
    ExpItem x; x.k0 = 64 * kb; x.n0 = n0; const size_t eoff = (size_t)e * D * D;
    if (which == 0) { x.W = wg + eoff; x.WT = WGUp; x.row0 = (size_t)e * 4096 + (n0 >> 7) * 256 + (n0 & 127); }
    else if (which == 1) { x.W = wu + eoff; x.WT = WGUp; x.row0 = (size_t)e * 4096 + (n0 >> 7) * 256 + 128 + (n0 & 127); }
    else { x.W = wd + eoff; x.WT = WDp; x.row0 = (size_t)e * 2048 + n0; }
    return x;
}
__device__ __forceinline__ void conv_dyn(unsigned* counter, int total, int kind, const float* wg, const float* wu, const float* wd, bf16_t* WGUp, bf16_t* WDp,
                                         const unsigned* done, unsigned target, LAS float* scr, int lane) {
    for (;;) {
        if (done && __builtin_amdgcn_readfirstlane((int)__hip_atomic_load(done, __ATOMIC_RELAXED, __HIP_MEMORY_SCOPE_AGENT)) >= (int)target) break;
        int it0 = 0; if (lane == 0) it0 = (int)__hip_atomic_fetch_add(counter, 8u, __ATOMIC_RELAXED, __HIP_MEMORY_SCOPE_AGENT);
        it0 = __builtin_amdgcn_readfirstlane(it0);
        if (it0 >= total) break;
#pragma unroll 1
        for (int p = 0; p < 8; p += 2) {
            const ExpItem xa = exp_item(it0 + p, kind, wg, wu, wd, WGUp, WDp), xb = exp_item(it0 + p + 1, kind, wg, wu, wd, WGUp, WDp);
            float va[32], vb[32];
            tr_load(xa.W, D, xa.k0, xa.n0, lane, va); tr_load(xb.W, D, xb.k0, xb.n0, lane, vb);
            tr_store(va, xa.k0, xa.WT, xa.row0, scr, lane); tr_store(vb, xb.k0, xb.WT, xb.row0, scr, lane);
        }
    }
}
__device__ __forceinline__ int gemm_wgs(int nunits, int G) { const int rounds = (nunits + G - 1) / G; return (nunits + rounds - 1) / rounds; }
template <bool QKPERM = false>
__device__ __forceinline__ void conv_plain(const float* W, int N, bf16_t* WT, int item, LAS float* scr, int lane) {
    const int nblk = N / 32, kb = item / nblk, nb = item % nblk;
    tr_item<QKPERM>(W, N, 64 * kb, 32 * nb, WT, (size_t)32 * nb, scr, lane);
}
struct Row { f32x4 v[8]; };
__device__ __forceinline__ void row_load(Row& r, const float* p, int lane) {
#pragma unroll
    for (int j = 0; j < 8; ++j) r.v[j] = *(const f32x4*)(p + 4 * lane + 256 * j);
}
__device__ __forceinline__ void row_load_bf16(Row& r, const bf16_t* p, int lane) {
#pragma unroll
    for (int j = 0; j < 8; ++j) { const u32x2 w = *(const u32x2*)(p + 4 * lane + 256 * j); r.v[j] = (f32x4){bflo(w.x), bfhi(w.x), bflo(w.y), bfhi(w.y)}; }
}
__device__ __forceinline__ float row_ss(const Row& r) { float s = 0.f;
#pragma unroll
    for (int j = 0; j < 8; ++j) s += (r.v[j].x * r.v[j].x + r.v[j].y * r.v[j].y) + (r.v[j].z * r.v[j].z + r.v[j].w * r.v[j].w);
    return wave_sum(s); }
__device__ __forceinline__ void row_store_bf16(const Row& r, bf16_t* p, int lane) {
#pragma unroll
    for (int j = 0; j < 8; ++j) { u32x2 w; w.x = cvtpk(r.v[j].x, r.v[j].y); w.y = cvtpk(r.v[j].z, r.v[j].w); *(u32x2*)(p + 4 * lane + 256 * j) = w; }
}
__device__ __forceinline__ void row_store_f32(const Row& r, float* p, int lane) {
#pragma unroll
    for (int j = 0; j < 8; ++j) *(f32x4*)(p + 4 * lane + 256 * j) = r.v[j];
}
__device__ __forceinline__ void row_norm_mod(Row& x, const float* g, const float* shift, const float* scale, int lane) {
    const float r = rsqrtf(row_ss(x) * (1.f / D) + EPS);
#pragma unroll
    for (int j = 0; j < 8; ++j) { const f32x4 gg = *(const f32x4*)(g + 4 * lane + 256 * j), sh = *(const f32x4*)(shift + 4 * lane + 256 * j), sc = *(const f32x4*)(scale + 4 * lane + 256 * j);
        x.v[j] = (x.v[j] * r) * gg * (sc + 1.f) + sh; }
}

#define ROUTER_STAGE(W_ROUTER) do { LAS float* wt_ = (LAS float*)lds;        \
        _Pragma("unroll") for (int rb = 0; rb < 2; ++rb) { f32x4 wv[8]; \
            _Pragma("unroll") for (int r = 0; r < 8; ++r) wv[r] = *(const f32x4*)((W_ROUTER) + 4 * (tid + NTHREADS * (rb * 8 + r))); \
            _Pragma("unroll") for (int r = 0; r < 8; ++r) { const int i4 = tid + NTHREADS * (rb * 8 + r); const int k = i4 >> 2, e0 = (i4 & 3) * 4; \
                wt_[(e0 + 0) * D + k] = wv[r].x; wt_[(e0 + 1) * D + k] = wv[r].y; wt_[(e0 + 2) * D + k] = wv[r].z; wt_[(e0 + 3) * D + k] = wv[r].w; } } } while (0)
#define MOD ((float*)(ws + WS_MOD))
#define AFFT ((float*)(ws + WS_AFFT))
#define IDX ((int*)(ws + WS_IDX))
#define GATEV ((float*)(ws + WS_GATEV))
#define INV ((int*)(ws + WS_INV))
#define GATES ((float*)(ws + WS_GATES))
#define GB ((float*)(ws + WS_GB))
#define GI ((float*)(ws + WS_GI))
#define NST ((float*)(ws + WS_NST))
#define WIN0 ((bf16_t*)(ws + WS_WIN0))
#define WOUT0 ((bf16_t*)(ws + WS_WOUT0))
#define WIN1 ((bf16_t*)(ws + WS_WIN1))
#define WOUT1 ((bf16_t*)(ws + WS_WOUT1))
#define WGU ((bf16_t*)(ws + WS_WGU))
#define WD ((bf16_t*)(ws + WS_WD))
#define XC ((bf16_t*)(ws + WS_XC))
#define XC2 ((bf16_t*)(ws + WS_XC2))
#define XN ((bf16_t*)(ws + WS_XN))
#define QKV ((bf16_t*)(ws + WS_QKV))
#define QD ((bf16_t*)(ws + WS_QD))
#define AO ((bf16_t*)(ws + WS_AO))
#define Y ((bf16_t*)(ws + WS_Y))
#define OF ((float*)(ws + WS_OF))
#define XE ((bf16_t*)(ws + WS_XE))
#define HID ((bf16_t*)(ws + WS_HID))
#define YE ((bf16_t*)(ws + WS_YE))
#define PROJ ((bf16_t*)(ws + WS_PROJ))
#define QC ((bf16_t*)(ws + WS_QC))
#define KC ((bf16_t*)(ws + WS_KC))
#define CST ((bf16_t*)(ws + WS_CST))
#define HD ((bf16_t*)(ws + WS_HD))
#define RO ((bf16_t*)(ws + WS_RO))
#define Y1 ((bf16_t*)(ws + WS_Y1))
__global__ void __launch_bounds__(NTHREADS, 2) mega(Args a) {
    extern __shared__ __attribute__((aligned(16))) unsigned char lds_raw[];
    LAS unsigned char* lds = (LAS unsigned char*)lds_raw;
    volatile LAS unsigned* MISC = (volatile LAS unsigned*)(lds + MISC_OFF);
    const int wave = wave_id();
    const int G = gridDim.x, bx = blockIdx.x;
    const int gw = bx * NWAVES + wave, NGW = G * NWAVES;
    { const int t0_ = tid_fresh(wave); if (t0_ < 64) MISC[t0_] = 0u; }
    __syncthreads();
    unsigned char* ws = a.ws;
    unsigned* ctl = (unsigned*)(ws + WS_CTL);
    const int lo = a.ph_lo, hi = a.ph_hi;
    const bool use_bar = (hi - lo) > 1;
    XcdBarrier bar; bar.bar = ctl + CW_BAR; bar.x = 0; bar.st = MISC + 8; bar.wave = wave;
    if (use_bar) bar = xcd_barrier_post(ctl + CW_BAR, MISC + 8, wave);
#ifndef PH_MASK
#define PH_MASK 0xFFFFFFu
#endif
#define IN(k) ((((unsigned)PH_MASK >> (k)) & 1u) && lo <= (k) && (k) < hi)
#define SEAM(k) do { if (IN((k) + 1)) xcd_barrier(bar); } while (0)

    if (IN(0)) { const int lane = lane_fresh(), tid = wave * 64 + lane;
        LAS float* scr = (LAS float*)(lds + wave * 16384);
        {
            constexpr int I0 = 32 * (NQKV / 32), I1 = 32 * 64, I2 = 32 * 257, I3 = 32 * 64;
            for (int it = gw; it < I0 + I1 + I2 + I3; it += NGW) {
                int r = it;
                if (r < I0) { conv_plain<true>(a.in[I_WIN0], NQKV, WIN0, r, scr, lane); continue; } r -= I0;
                if (r < I1) { conv_plain(a.in[I_WOUT0], D, WOUT0, r, scr, lane); continue; } r -= I1;
                if (r < I2) { conv_plain(a.in[I_WIN1], 8224, WIN1, r, scr, lane); continue; } r -= I2;
                conv_plain(a.in[I_WOUT1], D, WOUT1, r, scr, lane);
            }
            for (size_t i = (size_t)bx * NTHREADS + tid; i < (size_t)224 * D / 8; i += (size_t)G * NTHREADS) *(u32x4*)(WIN1 + (size_t)8224 * D + i * 8) = (u32x4){0u, 0u, 0u, 0u};
        }
        __syncthreads();
        LAS float* sv = (LAS float*)lds;
        LAS float* red = (LAS float*)(lds + 16384);
        for (int i = tid; i < D; i += NTHREADS) { const float c0 = a.in[I_C][i], c1 = a.in[I_CCTX][i]; sv[i] = c0 * sigmoidf_(c0); sv[D + i] = c1 * sigmoidf_(c1); }
        __syncthreads();
        for (int cb = bx; cb < 256; cb += G) {
            for (int l = 0; l < 2; ++l) {
                const float* W = a.in[l ? I_WMOD1 : I_WMOD0]; const float* bm = a.in[l ? I_BMOD1 : I_BMOD0];
                const int c4 = tid % 12, kg = tid / 12;
                f32x4 a0 = (f32x4){0.f, 0.f, 0.f, 0.f}, a1 = a0;
                if (tid < 504) {
#pragma unroll 8
                    for (int k = kg; k < D; k += 42) { const f32x4 w = *(const f32x4*)(W + (size_t)k * 12288 + 48 * cb + 4 * c4); a0 += w * sv[k]; a1 += w * sv[D + k]; }
                    LAS float* rp = red + (kg * 12 + c4) * 8;
                    *(LAS f32x4*)rp = a0; *(LAS f32x4*)(rp + 4) = a1;
                }
                __syncthreads();
                if (tid < 96) { const int col = tid % 48, set = tid / 48; float s = 0.f;
                    for (int k2 = 0; k2 < 42; ++k2) s += red[(k2 * 12 + col / 4) * 8 + set * 4 + (col & 3)];
                    MOD[(size_t)(l * 2 + set) * 12288 + 48 * cb + col] = s + bm[48 * cb + col]; }
                __syncthreads();
            }
        }
        SEAM(0);
    }

    if (IN(1)) { const int lane = lane_fresh(), tid = wave * 64 + lane;
        for (int t = gw; t < T; t += NGW) {
            const int set = t < CTXL ? 1 : 0;
            const float* src = t < CTXL ? a.in[I_CTX] + (size_t)t * D : a.in[I_X] + (size_t)(t - CTXL) * D;
            const float* md = MOD + (size_t)(0 * 2 + set) * 12288;
            Row x; row_load(x, src, lane);
            f32x4 gg[8], shv[8], scv[8];
#pragma unroll
            for (int j = 0; j < 8; ++j) { const int c = 4 * lane + 256 * j; gg[j] = *(const f32x4*)(a.in[I_GPREMIX0] + c); shv[j] = *(const f32x4*)(md + c); scv[j] = *(const f32x4*)(md + D + c); }
            __builtin_amdgcn_sched_barrier(0);
            { const float r = rsqrtf(row_ss(x) * (1.f / D) + EPS);
#pragma unroll
              for (int j = 0; j < 8; ++j) x.v[j] = (x.v[j] * r) * gg[j] * (scv[j] + 1.f) + shv[j]; }
            row_store_bf16(x, XN + (size_t)t * D, lane);
        }
        SEAM(1);
    }

    if (IN(2)) { const int lane = lane_fresh(), tid = wave * 64 + lane;
        const int GE = gemm_wgs((T / 256) * (NQKV / 256), G);
        if (bx < GE) {
            pg8::Gemm g{XN, WIN0, D, nullptr, 1, 0}; pg8::StaticOrder S; S.init(T / 256, NQKV / 256, GE, bx);
            pg8::EpiRope E{QKV, QD, a.in[I_GQ], a.in[I_GK], (LAS float*)(lds + pg8::STAGE_BYTES)};
            pg8::gemm_phase<pg8::EpiRope, pg8::StaticOrder>(lds, g, S, E, wave);
            if (tid == 0) __hip_atomic_fetch_add(ctl + CW_DONE2, 1u, __ATOMIC_RELAXED, __HIP_MEMORY_SCOPE_AGENT);
        } else conv_dyn(ctl + CW_C0, NE * 3 * 2048, 0, a.in[I_WGATE0], a.in[I_WUP0], a.in[I_WDOWN0], WGU, WD, ctl + CW_DONE2, (unsigned)GE, (LAS float*)(lds + wave * 16384), lane);
        SEAM(2);
    }


    if (IN(4)) { const int lane = lane_fresh(), tid = wave * 64 + lane;
        float lam;
        { int ln = lane_fresh();
          const float p1 = a.in[I_LQ1][ln] * a.in[I_LK1][ln], p2 = a.in[I_LQ2][ln] * a.in[I_LK2][ln];
          lam = __expf(wave_sum_bp(p1)) - __expf(wave_sum_bp(p2)) + 0.2f; }
        const int vbx = (G % 8 == 0) ? (bx % 8) * (G / 8) + bx / 8 : bx;
        for (int u = vbx; u < 784; u += G) {
            const bool isctx = u >= 768; const bool big = u < 256;
            const int uu = isctx ? u - 768 : (big ? u : u - 256);
            const bool diff = big || (isctx && uu < 8);
            const int h = isctx ? (uu & 7) : (big ? (uu >> 5) : ((uu >> 6) & 7)), qb = isctx ? 0 : (big ? (uu & 31) : (uu & 63));
            const int row0 = isctx ? 0 : CTXL + qb * (big ? 512 : 256), seq = isctx ? CTXL : T;
            const int nm = diff ? 2 : 1;
            for (int m = 0; m < nm; ++m) {
                const int hc = diff ? (2 * h + m) * 128 : 2048 + h * 128;
                const bf16_t* Qb = QD + (size_t)row0 * NQD + (diff ? (2 * h + m) * 64 : 1024 + h * 128);
                const bf16_t* Kh = QD + (diff ? 2048 + (2 * h + m) * 64 : 3072 + (h >> 2) * 128);
                const bf16_t* Vh = QKV + (diff ? 2048 + h * 128 : 4352 + (h >> 2) * 128);
                if (big) att::attn_diff512(Qb, Kh, Vh, OF + (size_t)row0 * NOF + hc, seq, (char*)lds_raw, wave);
                else if (diff) att::attn_dense_body2<64>(Qb, Kh, Vh, OF + (size_t)row0 * NOF + hc, seq, (char*)lds_raw, wave);
                else att::attn_dense_body2<128>(Qb, Kh, Vh, (float*)(AO + (size_t)row0 * D + 1024 + h * 128), seq, (char*)lds_raw, wave);
                __syncthreads();
            }
            if (!diff) continue;
            VM_WAIT();
            int lane = lane_fresh();
            const float g0 = a.in[I_GSUBLN][2 * lane] * 0.8f, g1 = a.in[I_GSUBLN][2 * lane + 1] * 0.8f;
            const int nr = big ? 64 : 32;
            for (int rr = 0; rr < nr; ++rr) {
                const int row = row0 + wave * nr + rr;
                const f32x2 o1 = *(const f32x2*)(OF + (size_t)row * NOF + (2 * h) * 128 + 2 * lane), o2 = *(const f32x2*)(OF + (size_t)row * NOF + (2 * h + 1) * 128 + 2 * lane);
                const float v0 = o1.x - lam * o2.x, v1 = o1.y - lam * o2.y;
                const float rn = rsqrtf(wave_sum_bp(v0 * v0 + v1 * v1) * (1.f / 128.f) + EPS);
                *(unsigned*)(AO + (size_t)row * D + h * 128 + 2 * lane) = cvtpk(v0 * rn * g0, v1 * rn * g1);
            }
        }
        SEAM(4);
    }

    if (IN(5)) { const int lane = lane_fresh(), tid = wave * 64 + lane;
        const int GE = gemm_wgs((T / 256) * (D / 256), G);
        if (bx < GE) {
            pg8::Gemm g{AO, WOUT0, D, nullptr, 1, 0}; pg8::StaticOrder S; S.init(T / 256, D / 256, GE, bx);
            pg8::EpiBf16 E{Y, D, 1 << 30, nullptr};
            pg8::gemm_phase<pg8::EpiBf16, pg8::StaticOrder>(lds, g, S, E, wave);
            if (tid == 0) __hip_atomic_fetch_add(ctl + CW_DONE5, 1u, __ATOMIC_RELAXED, __HIP_MEMORY_SCOPE_AGENT);
        } else conv_dyn(ctl + CW_C0, NE * 3 * 2048, 0, a.in[I_WGATE0], a.in[I_WUP0], a.in[I_WDOWN0], WGU, WD, ctl + CW_DONE5, (unsigned)GE, (LAS float*)(lds + wave * 16384), lane);
        if (use_bar) { __syncthreads(); ROUTER_STAGE(a.in[I_WROUTER0]); }
        SEAM(5);
    }

#define PHASE_POSTMIX(LAYER, YBUF, T0, G_POST, G_PREFFN, W_ROUTER) do { \
        LAS float* wt = (LAS float*)lds;                                    \
        if (!use_bar) ROUTER_STAGE(W_ROUTER); \
        __syncthreads(); \
          \
        int cur_set = -1; f32x4 pg[8], ps[8], sh[8]; \
        for (int t = (T0) + gw; t < T; t += NGW) { \
            const int set = t < CTXL ? 1 : 0; \
            if (set != cur_set) { cur_set = set; const float* md = MOD + (size_t)((LAYER) * 2 + set) * 12288; \
                _Pragma("unroll") for (int j = 0; j < 8; ++j) { const int c = 4 * lane + 256 * j; \
                    pg[j] = *(const f32x4*)((G_POST) + c) * *(const f32x4*)(md + 2 * D + c); ps[j] = *(const f32x4*)((G_PREFFN) + c) * (*(const f32x4*)(md + 4 * D + c) + 1.f); sh[j] = *(const f32x4*)(md + 3 * D + c); } } \
            u32x2 yr[8]; Row x; \
            { const bf16_t* yp = (YBUF) + (size_t)t * D + 4 * lane; _Pragma("unroll") for (int j = 0; j < 8; ++j) yr[j] = *(const u32x2*)(yp + 256 * j); } \
            if ((LAYER) == 0) row_load(x, t < CTXL ? a.in[I_CTX] + (size_t)t * D : a.in[I_X] + (size_t)(t - CTXL) * D, lane); \
            else { u32x2 xr[8]; const bf16_t* xp = XC2 + (size_t)t * D + 4 * lane; _Pragma("unroll") for (int j = 0; j < 8; ++j) xr[j] = *(const u32x2*)(xp + 256 * j); \
                   __builtin_amdgcn_sched_barrier(0); \
                   _Pragma("unroll") for (int j = 0; j < 8; ++j) x.v[j] = (f32x4){bflo(xr[j].x), bfhi(xr[j].x), bflo(xr[j].y), bfhi(xr[j].y)}; } \
            __builtin_amdgcn_sched_barrier(0); \
            Row y; _Pragma("unroll") for (int j = 0; j < 8; ++j) y.v[j] = (f32x4){bflo(yr[j].x), bfhi(yr[j].x), bflo(yr[j].y), bfhi(yr[j].y)}; \
            const float ry = rsqrtf(row_ss(y) * (1.f / D) + EPS); \
            _Pragma("unroll") for (int j = 0; j < 8; ++j) x.v[j] = x.v[j] + pg[j] * (y.v[j] * ry); \
            row_store_bf16(x, XC + (size_t)t * D, lane); \
            { const float r = rsqrtf(row_ss(x) * (1.f / D) + EPS); _Pragma("unroll") for (int j = 0; j < 8; ++j) x.v[j] = (x.v[j] * r) * ps[j] + sh[j]; } \
            row_store_bf16(x, XN + (size_t)t * D, lane); \
            float lg[NE]; \
            {     \
                const LAS float* wl = wt + 4 * lane; f32x4 wA[4], wB[4]; \
                _Pragma("unroll") for (int j = 0; j < 4; ++j) wA[j] = *(const LAS f32x4*)(wl + 256 * j); \
                _Pragma("unroll") for (int e = 0; e < NE; ++e) { float s = 0.f; \
                    _Pragma("unroll") for (int j = 0; j < 4; ++j) wB[j] = *(const LAS f32x4*)(wl + e * D + 256 * (4 + j)); \
                    __builtin_amdgcn_sched_barrier(0); \
                    _Pragma("unroll") for (int j = 0; j < 4; ++j) s += (x.v[j].x * wA[j].x + x.v[j].y * wA[j].y) + (x.v[j].z * wA[j].z + x.v[j].w * wA[j].w); \
                    if (e + 1 < NE) { _Pragma("unroll") for (int j = 0; j < 4; ++j) wA[j] = *(const LAS f32x4*)(wl + (e + 1) * D + 256 * j); } \
                    __builtin_amdgcn_sched_barrier(0); \
                    _Pragma("unroll") for (int j = 0; j < 4; ++j) s += (x.v[4 + j].x * wB[j].x + x.v[4 + j].y * wB[j].y) + (x.v[4 + j].z * wB[j].z + x.v[4 + j].w * wB[j].w); \
                    lg[e] = s; } \
                _Pragma("unroll") for (int e = 0; e < NE; ++e) lg[e] = wave_sum(lg[e]); } \
            float mx = lg[0]; _Pragma("unroll") for (int e = 1; e < NE; ++e) mx = fmaxf(mx, lg[e]); \
            float sm = 0.f; _Pragma("unroll") for (int e = 0; e < NE; ++e) { lg[e] = __expf(lg[e] - mx); sm += lg[e]; } \
            const float inv = 1.f / sm; float mine = 0.f; \
            _Pragma("unroll") for (int e = 0; e < NE; ++e) mine = (lane == e) ? lg[e] * inv : mine; \
            if (lane < NE) AFFT[(size_t)lane * T + t] = mine; \
        } \
        __syncthreads(); \
    } while (0)

#define PHASE_TOPK(NTASK) do { \
        LAS unsigned* shc = (LAS unsigned*)lds;                         \
        for (int task = bx; task < (NTASK); task += G) { \
            const int e = task & 15, set = task >> 4; \
            const int n = set ? CTXL : SEQ, cap = set ? 32 : 2048, tbase = set ? 0 : CTXL, slot0 = set ? 2048 : 0; \
            const bool own = 32 * tid < n; \
            unsigned key[32]; \
            { const float* src = AFFT + (size_t)e * T + tbase + 32 * tid; \
              _Pragma("unroll") for (int j8 = 0; j8 < 8; ++j8) { f32x4 v = (f32x4){0.f, 0.f, 0.f, 0.f}; if (own) v = *(const f32x4*)(src + 4 * j8); \
                  key[4 * j8] = __float_as_uint(v.x); key[4 * j8 + 1] = __float_as_uint(v.y); key[4 * j8 + 2] = __float_as_uint(v.z); key[4 * j8 + 3] = __float_as_uint(v.w); } } \
            unsigned thr = 0u; \
            for (int bit = 30; bit >= 0; --bit) { \
                const unsigned cand = thr | (1u << bit); int cnt = 0; \
                _Pragma("unroll") for (int j = 0; j < 32; ++j) cnt += (key[j] >= cand) ? 1 : 0; \
                cnt = wave_sum_i(cnt); \
                if (lane == 0) shc[(bit & 1) * 8 + wave] = (unsigned)cnt; \
                __syncthreads(); \
                unsigned tot = 0u; _Pragma("unroll") for (int w2 = 0; w2 < NWAVES; ++w2) tot += shc[(bit & 1) * 8 + w2]; \
                if (tot >= (unsigned)cap) thr = cand; \
            } \
            int gtc = 0, eqc = 0; \
            _Pragma("unroll") for (int j = 0; j < 32; ++j) { gtc += (key[j] > thr) ? 1 : 0; eqc += (key[j] == thr) ? 1 : 0; } \
              \
            int inc = eqc, gsum = gtc; \
            _Pragma("unroll") for (int o = 1; o < 64; o <<= 1) { const int v = __shfl_up(inc, o); if (lane >= o) inc += v; gsum += __shfl_xor(gsum, o); } \
            __syncthreads(); \
            if (lane == 63) shc[16 + wave] = (unsigned)inc; if (lane == 0) shc[24 + wave] = (unsigned)gsum; \
            __syncthreads(); \
            int ex_eq = inc - eqc, tot_gt = 0; \
            _Pragma("unroll") for (int w2 = 0; w2 < NWAVES; ++w2) { if (w2 < wave) ex_eq += (int)shc[16 + w2]; tot_gt += (int)shc[24 + w2]; } \
            const int krem = cap - tot_gt;                              \
            int allow = krem - ex_eq; allow = allow < 0 ? 0 : (allow > eqc ? eqc : allow); \
            const int takec = gtc + allow; \
            int inc2 = takec; \
            _Pragma("unroll") for (int o = 1; o < 64; o <<= 1) { const int v = __shfl_up(inc2, o); if (lane >= o) inc2 += v; } \
            if (lane == 63) shc[32 + wave] = (unsigned)inc2; \
            __syncthreads(); \
            int slot = slot0 + inc2 - takec; \
            _Pragma("unroll") for (int w2 = 0; w2 < NWAVES; ++w2) { if (w2 < wave) slot += (int)shc[32 + w2]; } \
            if (own) { int eqs = 0; int invv[32]; \
                _Pragma("unroll") for (int j = 0; j < 32; ++j) { const unsigned k = key[j]; const bool eq = k == thr; const bool take = k > thr || (eq && eqs < allow); eqs += eq ? 1 : 0; \
                    invv[j] = take ? slot : -1; \
                    if (take) { IDX[e * IDXS + slot] = tbase + 32 * tid + j; GATEV[e * IDXS + slot] = __uint_as_float(k); ++slot; } } \
                int* ip = INV + (size_t)e * T + tbase + 32 * tid; \
                _Pragma("unroll") for (int j4 = 0; j4 < 8; ++j4) *(u32x4*)(ip + 4 * j4) = (u32x4){(unsigned)invv[4 * j4], (unsigned)invv[4 * j4 + 1], (unsigned)invv[4 * j4 + 2], (unsigned)invv[4 * j4 + 3]}; } \
            __syncthreads(); \
        } \
    } while (0)

#define PHASE_GATHER(RPE, NVALID) do { \
        for (int r = gw; r < NE * (RPE); r += NGW) { \
            const int e = r / (RPE), slot = r - e * (RPE); \
            u32x4 v0 = {0u, 0u, 0u, 0u}, v1 = v0, v2 = v0, v3 = v0; \
            if (slot < (NVALID)) { const bf16_t* s = XN + (size_t)IDX[e * IDXS + slot] * D; \
                v0 = *(const u32x4*)(s + 8 * lane); v1 = *(const u32x4*)(s + 512 + 8 * lane); v2 = *(const u32x4*)(s + 1024 + 8 * lane); v3 = *(const u32x4*)(s + 1536 + 8 * lane); } \
            bf16_t* dd = XE + (size_t)r * D; \
            *(u32x4*)(dd + 8 * lane) = v0; *(u32x4*)(dd + 512 + 8 * lane) = v1; *(u32x4*)(dd + 1024 + 8 * lane) = v2; *(u32x4*)(dd + 1536 + 8 * lane) = v3; \
        } \
    } while (0)

#define COMBINE_LOOP(LAYER, RPE, G_POSTFFN, T0, BODY) do { \
        int cur_set = -1; f32x4 pq[8]; \
        int slot_n = -1; u32x2 xr_n[8]; \
        { const int t = (T0) + gw; if (t < T) { slot_n = lane < NE ? INV[(size_t)lane * T + t] : -1; \
            const bf16_t* xp = XC + (size_t)t * D + 4 * lane; _Pragma("unroll") for (int j = 0; j < 8; ++j) xr_n[j] = *(const u32x2*)(xp + 256 * j); } } \
        for (int t = (T0) + gw; t < T; t += NGW) { \
            const int slotv = slot_n; u32x2 xr[8]; _Pragma("unroll") for (int j = 0; j < 8; ++j) xr[j] = xr_n[j]; \
            { const int t2 = t + NGW; if (t2 < T) { slot_n = lane < NE ? INV[(size_t)lane * T + t2] : -1; \
                const bf16_t* xp = XC + (size_t)t2 * D + 4 * lane; _Pragma("unroll") for (int j = 0; j < 8; ++j) xr_n[j] = *(const u32x2*)(xp + 256 * j); } } \
            const int set_ = t < CTXL ? 1 : 0; \
            if (set_ != cur_set) { cur_set = set_; const float* md_ = MOD + (size_t)((LAYER) * 2 + set_) * 12288; \
                _Pragma("unroll") for (int j = 0; j < 8; ++j) { const int c = 4 * lane + 256 * j; pq[j] = *(const f32x4*)((G_POSTFFN) + c) * *(const f32x4*)(md_ + 5 * D + c); } } \
            Row mo; _Pragma("unroll") for (int j = 0; j < 8; ++j) mo.v[j] = (f32x4){0.f, 0.f, 0.f, 0.f}; \
            unsigned mask = (unsigned)__ballot(slotv >= 0) & 0xffffu; \
            while (mask) { \
                const int e0 = __builtin_ctz(mask); mask &= mask - 1u; const bool two = mask != 0u; const int e1 = two ? __builtin_ctz(mask) : e0; mask &= mask - 1u; \
                const int s0 = __builtin_amdgcn_readlane(slotv, e0), s1 = __builtin_amdgcn_readlane(slotv, e1); \
                const bf16_t* y0 = YE + ((size_t)e0 * (RPE) + s0) * D + 4 * lane; const bf16_t* y1 = YE + ((size_t)e1 * (RPE) + s1) * D + 4 * lane; \
                u32x2 w0[8], w1[8]; \
                _Pragma("unroll") for (int j = 0; j < 8; ++j) w0[j] = *(const u32x2*)(y0 + 256 * j); \
                _Pragma("unroll") for (int j = 0; j < 8; ++j) w1[j] = *(const u32x2*)(y1 + 256 * j); \
                __builtin_amdgcn_sched_barrier(0); \
                _Pragma("unroll") for (int j = 0; j < 8; ++j) { mo.v[j].x += bflo(w0[j].x); mo.v[j].y += bfhi(w0[j].x); mo.v[j].z += bflo(w0[j].y); mo.v[j].w += bfhi(w0[j].y); } \
                if (two) { _Pragma("unroll") for (int j = 0; j < 8; ++j) { mo.v[j].x += bflo(w1[j].x); mo.v[j].y += bfhi(w1[j].x); mo.v[j].z += bflo(w1[j].y); mo.v[j].w += bfhi(w1[j].y); } } \
            } \
            const float rm = rsqrtf(row_ss(mo) * (1.f / D) + EPS); \
            Row x; _Pragma("unroll") for (int j = 0; j < 8; ++j) { const f32x4 xv = {bflo(xr[j].x), bfhi(xr[j].x), bflo(xr[j].y), bfhi(xr[j].y)}; x.v[j] = xv + pq[j] * (mo.v[j] * rm); } \
            BODY \
        } \
    } while (0)

    if (IN(6)) { const int lane = lane_fresh(), tid = wave * 64 + lane; PHASE_POSTMIX(0, Y, 0, a.in[I_GPOSTMIX0], a.in[I_GPREFFN0], a.in[I_WROUTER0]);
        conv_dyn(ctl + CW_C0, NE * 3 * 2048, 0, a.in[I_WGATE0], a.in[I_WUP0], a.in[I_WDOWN0], WGU, WD, nullptr, 0u, (LAS float*)(lds + wave * 16384), lane);
        SEAM(6); }
    if (IN(7)) { const int lane = lane_fresh(), tid = wave * 64 + lane; PHASE_TOPK(32); SEAM(7); }
    if (IN(9)) { const int lane = lane_fresh(), tid = wave * 64 + lane;
        pg8::Gemm g{XN, WGU, D, IDX, 2304, 2080}; pg8::GroupedOrder S; S.init(9, 16, G, bx);
        pg8::EpiSwiGLU E{HID};
        pg8::gemm_phase<pg8::EpiSwiGLU, pg8::GroupedOrder, true>(lds, g, S, E, wave);
        SEAM(9);
    }
    if (IN(10)) { const int lane = lane_fresh(), tid = wave * 64 + lane;
        const int GE = gemm_wgs(NE * 9 * 8, G);
        if (bx < GE) {
            pg8::Gemm g{HID, WD, D, nullptr, 1, 0}; pg8::GroupedOrder S; S.init(9, 8, GE, bx);
            pg8::EpiDown E{YE, GATEV, 2304};
            pg8::gemm_phase<pg8::EpiDown, pg8::GroupedOrder>(lds, g, S, E, wave);
            if (tid == 0) __hip_atomic_fetch_add(ctl + CW_DONE10, 1u, __ATOMIC_RELAXED, __HIP_MEMORY_SCOPE_AGENT);
        } else conv_dyn(ctl + CW_C1A, NE * 2 * 2048, 1, a.in[I_WGATE1], a.in[I_WUP1], a.in[I_WDOWN1], WGU, WD, ctl + CW_DONE10, (unsigned)GE, (LAS float*)(lds + wave * 16384), lane);
        SEAM(10);
    }
    if (IN(11)) { const int lane = lane_fresh(), tid = wave * 64 + lane;
        int nset = -1; f32x4 ps[8], sh[8];
        COMBINE_LOOP(0, 2304, a.in[I_GPOSTFFN0], 0, {
            row_store_bf16(x, XC2 + (size_t)t * D, lane);
            if (set_ != nset) { nset = set_; const float* md = MOD + (size_t)(1 * 2 + set_) * 12288;
_Pragma("unroll")
                for (int j = 0; j < 8; ++j) { const int c = 4 * lane + 256 * j; ps[j] = *(const f32x4*)(a.in[I_GPREMIX1] + c) * (*(const f32x4*)(md + 1 * D + c) + 1.f); sh[j] = *(const f32x4*)(md + c); } }
            { const float r = rsqrtf(row_ss(x) * (1.f / D) + EPS);
_Pragma("unroll")
              for (int j = 0; j < 8; ++j) x.v[j] = (x.v[j] * r) * ps[j] + sh[j]; }
            row_store_bf16(x, XN + (size_t)t * D, lane); });
        SEAM(11);
    }

    if (IN(12)) { const int lane = lane_fresh(), tid = wave * 64 + lane;
        const int GE = gemm_wgs((T / 256) * (NPROJ_PAD / 256), G);
        if (bx < GE) {
            pg8::Gemm g{XN, WIN1, D, nullptr, 1, 0}; pg8::StaticOrder S; S.init(T / 256, NPROJ_PAD / 256, GE, bx);
            pg8::EpiBf16 E{PROJ, NPROJ, 32, GATES};
            pg8::gemm_phase<pg8::EpiBf16, pg8::StaticOrder>(lds, g, S, E, wave);
            if (tid == 0) __hip_atomic_fetch_add(ctl + CW_DONE12, 1u, __ATOMIC_RELAXED, __HIP_MEMORY_SCOPE_AGENT);
        } else {
            conv_dyn(ctl + CW_C1A, NE * 2 * 2048, 1, a.in[I_WGATE1], a.in[I_WUP1], a.in[I_WDOWN1], WGU, WD, ctl + CW_DONE12, (unsigned)GE, (LAS float*)(lds + wave * 16384), lane);
            conv_dyn(ctl + CW_C1B, NE * 2048, 2, a.in[I_WGATE1], a.in[I_WUP1], a.in[I_WDOWN1], WGU, WD, ctl + CW_DONE12, (unsigned)GE, (LAS float*)(lds + wave * 16384), lane);
        }
        SEAM(12);
    }

    if (IN(13)) { const int lane = lane_fresh(), tid = wave * 64 + lane;
        {
            const int c0 = tid * 8;
            const float* wc = a.in[I_WCONV1] + c0; const float* bc = a.in[I_BCONV1] + c0;
            const f32x4 wma = *(const f32x4*)(wc), wmb = *(const f32x4*)(wc + 4), w0a = *(const f32x4*)(wc + 4096), w0b = *(const f32x4*)(wc + 4100), wpa = *(const f32x4*)(wc + 8192), wpb = *(const f32x4*)(wc + 8196);
            const f32x4 bca = *(const f32x4*)(bc), bcb = *(const f32x4*)(bc + 4);
            const float wm[8] = {wma.x, wma.y, wma.z, wma.w, wmb.x, wmb.y, wmb.z, wmb.w}, w0[8] = {w0a.x, w0a.y, w0a.z, w0a.w, w0b.x, w0b.y, w0b.z, w0b.w};
            const float wp[8] = {wpa.x, wpa.y, wpa.z, wpa.w, wpb.x, wpb.y, wpb.z, wpb.w}, bb[8] = {bca.x, bca.y, bca.z, bca.w, bcb.x, bcb.y, bcb.z, bcb.w};
            const float osc = c0 >= 2048 ? 0.0625f : 1.f;
            bf16_t* dst = c0 < 2048 ? QC + c0 : KC + (c0 - 2048);
            const bf16_t* src = PROJ + c0;
            const int TPW = (T + G - 1) / G; const int t0 = bx * TPW, t1 = (t0 + TPW < T) ? t0 + TPW : T;
            const u32x4 z = {0u, 0u, 0u, 0u};
            u32x4 prev = z, cur = z;
            if (t0 < t1) { if (t0 > 0) prev = *(const u32x4*)(src + (size_t)(t0 - 1) * NPROJ); cur = *(const u32x4*)(src + (size_t)t0 * NPROJ); }
            u32x4 nn[8];
#pragma unroll
            for (int i = 0; i < 8; ++i) { const int row = t0 + 1 + i; nn[i] = (t0 < t1 && row <= t1 && row < T) ? *(const u32x4*)(src + (size_t)row * NPROJ) : z; }
            for (int t = t0; t < t1; t += 8) {
                u32x4 nx[8];
#pragma unroll
                for (int i = 0; i < 8; ++i) nx[i] = nn[i];
                if (t + 8 < t1) {
#pragma unroll
                    for (int i = 0; i < 8; ++i) { const int row = t + 9 + i; nn[i] = (row <= t1 && row < T) ? *(const u32x4*)(src + (size_t)row * NPROJ) : z; }
                }
                __builtin_amdgcn_sched_barrier(0);
#pragma unroll
                for (int i = 0; i < 8; ++i) { const int tt = t + i;
                    if (tt < t1) {
                        const u32x4 xm = (tt == 0 || tt == CTXL) ? z : prev, xp = (tt + 1 == CTXL || tt + 1 == T) ? z : nx[i];
                        const unsigned am[4] = {xm.x, xm.y, xm.z, xm.w}, a0[4] = {cur.x, cur.y, cur.z, cur.w}, ap[4] = {xp.x, xp.y, xp.z, xp.w};
                        float yv[8];
#pragma unroll
                        for (int j = 0; j < 8; ++j) { const int w = j >> 1; const bool hh = j & 1;
                            const float vm = hh ? bfhi(am[w]) : bflo(am[w]), v0 = hh ? bfhi(a0[w]) : bflo(a0[w]), vp = hh ? bfhi(ap[w]) : bflo(ap[w]);
                            float y = wm[j] * vm + w0[j] * v0 + wp[j] * vp + bb[j];
                            y = y * sigmoidf_(y); yv[j] = y * osc; }
                        u32x4 o; o.x = cvtpk(yv[0], yv[1]); o.y = cvtpk(yv[2], yv[3]); o.z = cvtpk(yv[4], yv[5]); o.w = cvtpk(yv[6], yv[7]);
                        *(u32x4*)(dst + (size_t)tt * D) = o;
                        prev = cur; cur = nx[i];
                    } }
            }
        }
        const float* bg = a.in[I_BGATE1];
        for (int it = gw; it < 16 * NCH; it += NGW) {
            const int hd = it / NCH, i = it % NCH, d = hd >> 3, h = hd & 7;
            const int cc = d ? (i < 2 ? 1 - i : 131 - i) : i; const int base = cc * 128;
            const int s0 = 2 * lane, s1 = 2 * lane + 1;
            const int r0 = base + (d ? 127 - s0 : s0), r1 = base + (d ? 127 - s1 : s1);
            const float ig0 = GATES[(size_t)r0 * 32 + d * 16 + h] + bg[d * 16 + h], ig1 = GATES[(size_t)r1 * 32 + d * 16 + h] + bg[d * 16 + h];
            const float f0 = GATES[(size_t)r0 * 32 + d * 16 + 8 + h] + bg[d * 16 + 8 + h], f1 = GATES[(size_t)r1 * 32 + d * 16 + 8 + h] + bg[d * 16 + 8 + h];
            const float lf0 = fminf(f0, 0.f) - log1pf(__expf(-fabsf(f0))), lf1 = fminf(f1, 0.f) - log1pf(__expf(-fabsf(f1)));
            const float c1 = lf0 + lf1; float inc = c1;
#pragma unroll
            for (int ofs = 1; ofs < 64; ofs <<= 1) { const float v = __shfl_up(inc, ofs); if (lane >= ofs) inc += v; }
            const float ex = inc - c1;
            float* gbp = GB + (size_t)it * 128; float* gip = GI + (size_t)it * 128;
            *(f32x2*)(gbp + s0) = (f32x2){ex + lf0, ex + c1}; *(f32x2*)(gip + s0) = (f32x2){ig0, ig1};
        }
        conv_dyn(ctl + CW_C1A, NE * 2 * 2048, 1, a.in[I_WGATE1], a.in[I_WUP1], a.in[I_WDOWN1], WGU, WD, nullptr, 0u, (LAS float*)(lds + wave * 16384), lane);
        conv_dyn(ctl + CW_C1B, NE * 2048, 2, a.in[I_WGATE1], a.in[I_WUP1], a.in[I_WDOWN1], WGU, WD, nullptr, 0u, (LAS float*)(lds + wave * 16384), lane);
        SEAM(13);
    }

    if (IN(14)) { const int lane = lane_fresh(), tid = wave * 64 + lane;
        LAS char* tiles = (LAS char*)lds;
        LAS float* wbuf = (LAS float*)(lds + 131072);
        LAS float* nred = (LAS float*)(lds + 131072 + 2048);
#define M1_BAR() do { asm volatile("s_waitcnt lgkmcnt(0)" ::: "memory"); __builtin_amdgcn_s_barrier(); asm volatile("" ::: "memory"); } while (0)
        for (int vb_ = bx; vb_ < 256; vb_ += G) {
            const int h = vb_ & 7, lx = vb_ >> 3, d = lx >> 4, tile = lx & 15, idk = tile >> 2, idv = tile & 3, hd = d * 8 + h;
            __syncthreads();
            if (wave < 4) {
                const int r32 = lane & 31, hi5 = lane >> 5, tm = wave & 1, tn = wave >> 1;
                f32x16 acc = f32x16{};
                float nacc = 0.f, decay_prev = 0.f;
                float bl_next = GB[((size_t)hd * NCH + 0) * 128 + 127];
                float gb_n = 0.f, gi_n = 0.f, bl_n = 0.f;
                if (tid < 128) { const size_t g0 = ((size_t)hd * NCH + 0) * 128; wbuf[tid] = __expf(GB[g0 + 127] - GB[g0 + tid] + GI[g0 + tid]);
                                 const size_t g1 = g0 + 128; gb_n = GB[g1 + tid]; gi_n = GI[g1 + tid]; bl_n = GB[g1 + 127]; }
                for (int i = 0; i < NCH; ++i) {
                    const int cur = i & 3;
                    const float decay = __expf(bl_next);
                    if (i + 1 < NCH) bl_next = GB[((size_t)hd * NCH + i + 1) * 128 + 127];
                    M1_BAR();
                    if (tid < 128) { if (i + 1 < NCH) wbuf[((i + 1) & 3) * 128 + tid] = __expf(bl_n - gb_n + gi_n);
                                     if (i + 2 < NCH) { const size_t g2 = ((size_t)hd * NCH + i + 2) * 128; gb_n = GB[g2 + tid]; gi_n = GI[g2 + tid]; bl_n = GB[g2 + 127]; } }
                    if (idv == 0 && wave == 0) {
                        if (i > 0) { const LAS float* nr = nred + ((i - 1) & 1) * 256;
                            nacc = decay_prev * nacc + ((nr[lane] + nr[64 + lane]) + (nr[128 + lane] + nr[192 + lane])); }
                        NST[((size_t)hd * NCH + i) * 256 + idk * 64 + lane] = nacc;
                    }
                    decay_prev = decay;
                    if (i >= 2) { bf16_t* cp = CST + (((size_t)hd * NCH + i) * 256 + idk * 64 + 32 * tm) * 256 + idv * 64 + 32 * tn + r32;
#pragma unroll
                        for (int r = 0; r < 16; ++r) cp[(size_t)crow(r, hi5) * 256] = (bf16_t)(cvtpk(acc[r], acc[r]) & 0xffffu); }
#pragma unroll
                    for (int r = 0; r < 16; ++r) acc[r] *= decay;
#pragma unroll
                    for (int kh = 0; kh < 2; ++kh) {
                        const int vbase = (int)(uintptr_t)(tiles + cur * 32768 + kh * 16384) + att::v_rd_base(lane);
                        bf16x8 A[4], B[4];
                        if (tm == 0) { A[0] = att::vfragc<0, 0>(vbase); A[1] = att::vfragc<0, 1>(vbase); A[2] = att::vfragc<0, 2>(vbase); A[3] = att::vfragc<0, 3>(vbase); }
                        else         { A[0] = att::vfragc<1, 0>(vbase); A[1] = att::vfragc<1, 1>(vbase); A[2] = att::vfragc<1, 2>(vbase); A[3] = att::vfragc<1, 3>(vbase); }
                        if (tn == 0) { B[0] = att::vfragc<2, 0>(vbase); B[1] = att::vfragc<2, 1>(vbase); B[2] = att::vfragc<2, 2>(vbase); B[3] = att::vfragc<2, 3>(vbase); }
                        else         { B[0] = att::vfragc<3, 0>(vbase); B[1] = att::vfragc<3, 1>(vbase); B[2] = att::vfragc<3, 2>(vbase); B[3] = att::vfragc<3, 3>(vbase); }
#pragma unroll
                        for (int ks = 0; ks < 4; ++ks) {
                            const LAS float* wp = wbuf + cur * 128 + 64 * kh + 16 * ks + 8 * hi5;
                            const f32x4 wa = *(const LAS f32x4*)wp, wb = *(const LAS f32x4*)(wp + 4);
                            u32x4 aw = *reinterpret_cast<u32x4*>(&A[ks]);
                            aw.x = cvtpk_s(bflo(aw.x) * wa.x, bfhi(aw.x) * wa.y); aw.y = cvtpk_s(bflo(aw.y) * wa.z, bfhi(aw.y) * wa.w);
                            aw.z = cvtpk_s(bflo(aw.z) * wb.x, bfhi(aw.z) * wb.y); aw.w = cvtpk_s(bflo(aw.w) * wb.z, bfhi(aw.w) * wb.w);
                            acc = __builtin_amdgcn_mfma_f32_32x32x16_bf16(*reinterpret_cast<bf16x8*>(&aw), B[ks], acc, 0, 0, 0);
                        }
                    }
                }
            } else {
                const int lw = wave - 4, lt = tid - 256;
                int ps_[8]; const char* pb_[8]; int pp_[8];
#pragma unroll
                for (int j_ = 0; j_ < 8; ++j_) { const int P_ = (lw * 8 + j_) * 64 + lane; const int th_ = P_ >> 10; const int o_ = (P_ & 1023) * 16; const int sub_ = o_ >> 9, wi_ = o_ & 511;
                    const int kk_ = ((sub_ >> 2) << 3) | (wi_ >> 6); const int k_ = (kk_ & ~0xC) | ((kk_ & 4) << 1) | ((kk_ & 8) >> 1); const int c_ = ((sub_ & 3) << 5) | ((wi_ & 63) >> 1);
                    ps_[j_] = 64 * th_ + k_;
                    pb_[j_] = (c_ < 64) ? (const char*)(KC + h * 256 + idk * 64 + c_) : (const char*)(PROJ + 4096 + h * 256 + idv * 64 + (c_ - 64));
                    pp_[j_] = (c_ < 64) ? D * 2 : NPROJ * 2; }
#define M1_DMA(i_) do { const int cc_ = d ? ((i_) < 2 ? 1 - (i_) : 131 - (i_)) : (i_); const int base_ = cc_ * 128; \
                    _Pragma("unroll") for (int j_ = 0; j_ < 8; ++j_) { const int row_ = base_ + (d ? 127 - ps_[j_] : ps_[j_]); \
                        __builtin_amdgcn_global_load_lds((const unsigned*)(pb_[j_] + (size_t)row_ * pp_[j_]), (LAS unsigned*)(lds + ((i_) & 3) * 32768 + (lw * 8 + j_) * 1024), 16, 0, 0); } } while (0)
                M1_DMA(0); M1_DMA(1); M1_DMA(2);
                for (int i = 0; i < NCH; ++i) {
                    const int cur = i & 3;
                    if (i + 2 < NCH) asm volatile("s_waitcnt vmcnt(16)" ::: "memory"); else if (i + 1 < NCH) asm volatile("s_waitcnt vmcnt(8)" ::: "memory"); else asm volatile("s_waitcnt vmcnt(0)" ::: "memory");
                    M1_BAR();
                    if (i + 3 < NCH) M1_DMA(i + 3);
                    if (idv == 0) {
                        const int dk = lt & 63, sg = lt >> 6; float sacc = 0.f;
#pragma unroll 8
                        for (int q = 0; q < 32; ++q) { const int sI = sg * 32 + q;
                            const LAS char* tb_ = tiles + cur * 32768 + (sI >> 6) * 16384;
                            const unsigned short kv = *(const LAS unsigned short*)(tb_ + att::v_st(sI & 63, dk & ~7) + (dk & 7) * 2);
                            sacc += wbuf[cur * 128 + sI] * bf2f(kv); }
                        nred[(i & 1) * 256 + sg * 64 + dk] = sacc;
                    }
                }
#undef M1_DMA
            }
        }
        __syncthreads();
#undef M1_BAR
        SEAM(14);
    }

    if (IN(15)) { const int lane = lane_fresh(), tid = wave * 64 + lane;
        const int tb = wave & 3, vh = wave >> 2;
        LAS float* aS = (LAS float*)(lds + 131072);
        LAS float* nS = (LAS float*)(lds + 131072 + 512);
        LAS float* wsc = (LAS float*)(lds + 131072 + 2048) + wave * 64;
#define KSWZ512(row, colB) ((row) * 512 + ((colB) ^ (((row) & 15) << 4)))
#define M2_LBAR() do { asm volatile("s_waitcnt vmcnt(0) lgkmcnt(0)" ::: "memory"); __builtin_amdgcn_s_barrier(); asm volatile("" ::: "memory"); } while (0)
#define M2_VSLOT(j_, tl_, k_, c_) do { const int P_ = (wave * 4 + (j_)) * 64 + lane; tl_ = P_ >> 10; const int o_ = (P_ & 1023) * 16; const int sub_ = o_ >> 9, wi_ = o_ & 511; \
            const int kk_ = ((sub_ >> 2) << 3) | (wi_ >> 6); k_ = (kk_ & ~0xC) | ((kk_ & 4) << 1) | ((kk_ & 8) >> 1); c_ = ((sub_ & 3) << 5) | ((wi_ & 63) >> 1); } while (0)
#define M2_DMA_C(kt_, b_) do { _Pragma("unroll") for (int j_ = 0; j_ < 4; ++j_) { int tl_, k_, c_; M2_VSLOT(j_, tl_, k_, c_); \
            __builtin_amdgcn_global_load_lds((const unsigned*)(CST + (((size_t)hd * NCH + i) * 256 + 64 * (kt_) + k_) * 256 + 128 * tl_ + c_), (LAS unsigned*)(lds + (b_) * 65536 + (wave * 4 + j_) * 1024), 16, 0, 0); \
            __builtin_amdgcn_global_load_lds((const unsigned*)(CST + (((size_t)hd * NCH + i) * 256 + 64 * ((kt_) + 1) + k_) * 256 + 128 * tl_ + c_), (LAS unsigned*)(lds + (b_) * 65536 + 32768 + (wave * 4 + j_) * 1024), 16, 0, 0); } } while (0)
#define M2_DMA_KV(st_, b_) do { _Pragma("unroll") for (int j_ = 0; j_ < 4; ++j_) { int tl_, k_, c_; M2_VSLOT(j_, tl_, k_, c_); const int sv_ = 64 * (st_) + k_; const int rowv_ = base + (d ? 127 - sv_ : sv_); \
            __builtin_amdgcn_global_load_lds((const unsigned*)(PROJ + (size_t)rowv_ * NPROJ + 4096 + h * 256 + 128 * tl_ + c_), (LAS unsigned*)(lds + (b_) * 65536 + (wave * 4 + j_) * 1024), 16, 0, 0); \
            const int o2_ = ((wave * 4 + j_) * 64 + lane) * 16; const int rk_ = o2_ >> 9; const int cB_ = (o2_ & 511) ^ ((rk_ & 15) << 4); const int sk_ = 64 * (st_) + rk_; const int rowk_ = base + (d ? 127 - sk_ : sk_); \
            __builtin_amdgcn_global_load_lds((const unsigned*)(KC + (size_t)rowk_ * D + h * 256 + (cB_ >> 1)), (LAS unsigned*)(lds + (b_) * 65536 + 32768 + (wave * 4 + j_) * 1024), 16, 0, 0); } } while (0)
        for (int q = 0; ; ++q) {
            const int pr = bx + (q >> 1) * G; if (pr >= 8 * 128) break;
            int tid = tid_fresh(wave); asm volatile("" : "+v"(tid));
            const int lane = tid & 63, r32 = lane & 31, hi5 = lane >> 5;
            const int h = pr >> 7, cc = 2 + (pr & 127), d = q & 1, hd = d * 8 + h;
            const int i = d ? (131 - cc) : cc; const int base = cc * 128;
            const size_t gofs = ((size_t)hd * NCH + i) * 128;
            const int tpos = 32 * tb + r32; const int row_t = base + (d ? 127 - tpos : tpos);
            M2_DMA_C(0, 0);
            bf16x8 qr[16];
#pragma unroll
            for (int k = 0; k < 16; ++k) qr[k] = *(const bf16x8*)(QC + (size_t)row_t * D + h * 256 + 16 * k + 8 * hi5);
            const float bt = GB[gofs + tpos]; const float eb = __expf(bt);
            const float av = (tid < 128) ? GI[gofs + (tid & 127)] - GB[gofs + (tid & 127)] : 0.f;
            const float nv = (tid < 256) ? NST[((size_t)hd * NCH + i) * 256 + (tid & 255)] : 0.f;
            f32x16 o[4];
#pragma unroll
            for (int dd = 0; dd < 4; ++dd) o[dd] = f32x16{};
            const int vbA = (int)(uintptr_t)(lds + vh * 16384) + att::v_rd_base(lane), vbB = vbA + 65536;
            M2_LBAR();
            if (tid < 128) aS[tid] = av;
            if (tid < 256) nS[tid] = nv;
            M2_DMA_C(2, 1);
            att::pv_d0(o, vbA, qr[0], qr[1], qr[2], qr[3]);
            att::pv_d0(o, vbA + 32768, qr[4], qr[5], qr[6], qr[7]);
            M2_LBAR(); M2_DMA_KV(0, 0);
            att::pv_d0(o, vbB, qr[8], qr[9], qr[10], qr[11]);
            att::pv_d0(o, vbB + 32768, qr[12], qr[13], qr[14], qr[15]);
            if (hi5 == 0) wsc[r32] = eb; LDS_WAIT();
#pragma unroll
            for (int dd = 0; dd < 4; ++dd)
#pragma unroll
                for (int r = 0; r < 16; ++r) o[dd][r] *= wsc[crow(r, hi5)];
            float qn = 0.f;
#pragma unroll
            for (int k = 0; k < 16; ++k)
#pragma unroll
                for (int j = 0; j < 8; ++j) qn += bf2f((unsigned short)qr[k][j]) * nS[16 * k + 8 * hi5 + j];
            { auto rr = __builtin_amdgcn_permlane32_swap(__float_as_uint(qn), __float_as_uint(qn), false, false); qn = __uint_as_float(rr[0]) + __uint_as_float(rr[1]); }
            float rs = 0.f;
#pragma unroll 1
            for (int st = 0; st < 2; ++st) {
                M2_LBAR();
                if (st == 0) M2_DMA_KV(1, 1);
                LAS char* KT = (LAS char*)(lds + st * 65536 + 32768);
                const int vb0 = st ? vbB : vbA;
                if (tb >= 2 * st) {
                    f32x16 p0 = f32x16{}, p1 = f32x16{};
#pragma unroll
                    for (int k = 0; k < 16; ++k) { const int cb = (16 * k + 8 * hi5) * 2;
                        const bf16x8 b0 = *(const LAS bf16x8*)(KT + KSWZ512(r32, cb)), b1 = *(const LAS bf16x8*)(KT + KSWZ512(32 + r32, cb));
                        p0 = __builtin_amdgcn_mfma_f32_32x32x16_bf16(b0, qr[k], p0, 0, 0, 0);
                        p1 = __builtin_amdgcn_mfma_f32_32x32x16_bf16(b1, qr[k], p1, 0, 0, 0); }
                    float ps = 0.f;
#pragma unroll
                    for (int r = 0; r < 16; ++r) { const int s0 = 64 * st + crow(r, hi5), s1 = s0 + 32;
                        const float w0 = (s0 <= tpos) ? __expf(bt + aS[s0]) : 0.f, w1 = (s1 <= tpos) ? __expf(bt + aS[s1]) : 0.f;
                        p0[r] = (s0 <= tpos) ? p0[r] * w0 : 0.f; p1[r] = (s1 <= tpos) ? p1[r] * w1 : 0.f; ps += p0[r] + p1[r]; }
                    { auto rr = __builtin_amdgcn_permlane32_swap(__float_as_uint(ps), __float_as_uint(ps), false, false); ps = __uint_as_float(rr[0]) + __uint_as_float(rr[1]); }
                    rs += ps;
                    bf16x8 pa0, pa1, pa2, pa3;
                    PK4(p0, 0, pa0); PK4(p0, 8, pa1); PK4(p1, 0, pa2); PK4(p1, 8, pa3);
                    att::pv_d0(o, vb0, pa0, pa1, pa2, pa3);
                }
            }
            const float den = eb * qn + rs; const float rinv = 1.f / fmaxf(fabsf(den), 1.f);
            if (hi5 == 0) wsc[32 + r32] = rinv; LDS_WAIT();
            bf16_t* hp = HD + ((size_t)d * T + base) * D + h * 256 + 128 * vh + r32;
#pragma unroll
            for (int r = 0; r < 16; ++r) { const int tq = 32 * tb + crow(r, hi5); const int rowq = d ? 127 - tq : tq; const float ri = wsc[32 + crow(r, hi5)];
#pragma unroll
                for (int dd = 0; dd < 4; ++dd) { const float v = o[dd][r] * ri; hp[(size_t)rowq * D + 32 * dd] = (bf16_t)(cvtpk(v, v) & 0xffffu); } }
        }
        __syncthreads();
#undef M2_LBAR
#undef M2_VSLOT
#undef M2_DMA_C
#undef M2_DMA_KV
        SEAM(15);
    }

    if (IN(16)) { const int lane = lane_fresh(), tid = wave * 64 + lane;
        for (int t = CTXL + gw; t < T; t += NGW) {
            Row hrow, hb; row_load_bf16(hrow, HD + (size_t)t * D, lane); row_load_bf16(hb, HD + ((size_t)T + t) * D, lane);
#pragma unroll
            for (int j = 0; j < 8; ++j) {
                f32x4 v = hrow.v[j] + hb.v[j];
                const float ss = wave_sum((v.x * v.x + v.y * v.y) + (v.z * v.z + v.w * v.w));
                const float r = rsqrtf(ss * (1.f / 256.f) + EPS);
                const f32x4 gg = *(const f32x4*)(a.in[I_GHEAD1] + 4 * lane + 256 * j);
                const u32x2 ow = *(const u32x2*)(PROJ + (size_t)t * NPROJ + 6144 + 4 * lane + 256 * j);
                v = v * r * gg;
                v.x *= sigmoidf_(bflo(ow.x)); v.y *= sigmoidf_(bfhi(ow.x)); v.z *= sigmoidf_(bflo(ow.y)); v.w *= sigmoidf_(bfhi(ow.y));
                hrow.v[j] = v;
            }
            row_store_bf16(hrow, RO + (size_t)t * D, lane);
        }
        SEAM(16);
    }

    if (IN(17)) { const int lane = lane_fresh(), tid = wave * 64 + lane;
        pg8::Gemm g{RO + (size_t)CTXL * D, WOUT1, D, nullptr, 1, 0}; pg8::StaticOrder S; S.init(SEQ / 256, D / 256, G, bx);
        pg8::EpiBf16 E{Y1 + (size_t)CTXL * D, D, 1 << 30, nullptr};
        pg8::gemm_phase<pg8::EpiBf16, pg8::StaticOrder>(lds, g, S, E, wave);
        if (use_bar) { __syncthreads(); ROUTER_STAGE(a.in[I_WROUTER1]); }
        SEAM(17);
    }

    if (IN(18)) { const int lane = lane_fresh(), tid = wave * 64 + lane; PHASE_POSTMIX(1, Y1, CTXL, a.in[I_GPOSTMIX1], a.in[I_GPREFFN1], a.in[I_WROUTER1]); SEAM(18); }
    if (IN(19)) { const int lane = lane_fresh(), tid = wave * 64 + lane; PHASE_TOPK(16); SEAM(19); }
    if (IN(21)) { const int lane = lane_fresh(), tid = wave * 64 + lane;
        pg8::Gemm g{XN, WGU, D, IDX, 2048, 2048}; pg8::GroupedOrder S; S.init(8, 16, G, bx);
        pg8::EpiSwiGLU E{HID};
        pg8::gemm_phase<pg8::EpiSwiGLU, pg8::GroupedOrder, true>(lds, g, S, E, wave);
        SEAM(21);
    }
    if (IN(22)) { const int lane = lane_fresh(), tid = wave * 64 + lane;
        pg8::Gemm g{HID, WD, D, nullptr, 1, 0}; pg8::GroupedOrder S; S.init(8, 8, G, bx);
        pg8::EpiDown E{YE, GATEV, 2048};
        pg8::gemm_phase<pg8::EpiDown, pg8::GroupedOrder>(lds, g, S, E, wave);
        SEAM(22);
    }
    if (IN(23)) { const int lane = lane_fresh(), tid = wave * 64 + lane;
        COMBINE_LOOP(1, 2048, a.in[I_GPOSTFFN1], CTXL, { row_store_f32(x, a.out + (size_t)(t - CTXL) * D, lane); });
    }
#undef IN
#undef SEAM
}

#ifndef MK_SINGLE
#define MK_SINGLE 1
#define PROBE_REP 1,1,1,1,1,1,1,1,1,1,1, 1, 1, 1, 1, 1, 1, 1, 1, 1, 1, 1, 1, 1
#endif
extern "C" void kernel_launch(void* const* d_in, const int* in_sizes, int n_in, void* d_out, int out_size, void* d_ws, size_t ws_size, hipStream_t stream) {
    static int grid = 0;
    if (grid == 0) {
        int dev = 0, cus = 0;
        if (hipGetDevice(&dev) != hipSuccess || hipDeviceGetAttribute(&cus, hipDeviceAttributeMultiprocessorCount, dev) != hipSuccess) { grid = -1; return; }
        if (hipFuncSetAttribute((const void*)mega, hipFuncAttributeMaxDynamicSharedMemorySize, LDS_BYTES) != hipSuccess) { fprintf(stderr, "hipFuncSetAttribute failed\n"); grid = -1; return; }
        if (n_in != NIN || ws_size < WS_END) { fprintf(stderr, "kernel_launch: n_in %d ws %zu (need %zu)\n", n_in, ws_size, (size_t)WS_END); grid = -1; return; }
        grid = cus;
    }
    if (grid < 0) return;
    (void)hipMemsetAsync(d_ws, 0, CTL_BYTES, stream);
    Args a{};
    for (int i = 0; i < NIN; ++i) a.in[i] = (const float*)d_in[i];
    a.out = (float*)d_out; a.ws = (unsigned char*)d_ws;
#if MK_SINGLE
    a.ph_lo = 0; a.ph_hi = NPHASE;
    hipLaunchKernelGGL(mega, dim3(grid), dim3(NTHREADS), LDS_BYTES, stream, a);
#else
    static const int REP[NPHASE] = {PROBE_REP};
    for (int p = 0; p < NPHASE; ++p) for (int r = 0; r < REP[p]; ++r) { a.ph_lo = p; a.ph_hi = p + 1; hipLaunchKernelGGL(mega, dim3(grid), dim3(NTHREADS), LDS_BYTES, stream, a); }
#endif
}
```
